# Optimizing an MI355X kernel written in HIP

```python
import jax, jax.numpy as jnp
from jax import lax
import numpy as np

D_MODEL = 1024
BATCH = 16
SEQ = 4096
DEPTH = 4
DEC_BATCH = 16
DEC_SEQ = 16
PAST_LEN = 1024

CHUNK = 64
N_MIXERS = 3
N_GLA_LAYERS = (DEPTH + 2) // 3
N_RET_LAYERS = (DEPTH + 1) // 3
N_SWA_LAYERS = DEPTH // 3

GLA_HEADS = 4
GLA_KEY_DIM = D_MODEL // 2
GLA_DK = GLA_KEY_DIM // GLA_HEADS
GLA_DV = D_MODEL // GLA_HEADS
GLA_GATE_RANK = 16
GLA_TAU = 16.0

RET_HEADS = D_MODEL // 256
RET_DK = D_MODEL // RET_HEADS
RET_VALUE_DIM = 2 * D_MODEL
RET_DV = RET_VALUE_DIM // RET_HEADS

SWA_Q_HEADS = 16
SWA_KV_HEADS = 4
SWA_GROUP = SWA_Q_HEADS // SWA_KV_HEADS
SWA_HEAD_DIM = D_MODEL // SWA_Q_HEADS
WINDOW = 128
SWA_CHUNKS = WINDOW // CHUNK
SWA_CACHE_LEN = min(WINDOW, PAST_LEN)

MLP_HIDDEN = 4 * D_MODEL
ADA_CHUNKS = 6
NORM_EPS = 1e-6
GN_EPS = 1e-5
NEG_INF = -1e30

kernel_name = 'chunk_streaming_hybrid_gla_retnet_swa'


def rms_norm(x, g):
    xf = x.astype(jnp.float32)
    y = xf * lax.rsqrt(jnp.mean(jnp.square(xf), axis=-1, keepdims=True) + NORM_EPS)
    return (y * g.astype(jnp.float32)).astype(x.dtype)


def head_group_norm(x):
    xf = x.astype(jnp.float32)
    mu = jnp.mean(xf, axis=-1, keepdims=True)
    var = jnp.mean(jnp.square(xf - mu), axis=-1, keepdims=True)
    return ((xf - mu) * lax.rsqrt(var + GN_EPS)).astype(x.dtype)


def ada_modulation(c, w, b):
    mod = jax.nn.silu(c) @ w + b
    return jnp.split(mod[:, None, :], ADA_CHUNKS, axis=-1)


def modulate(x, g, shift, scale):
    return rms_norm(x, g) * (1.0 + scale) + shift


def sq_relu_mlp(h, w1, w2):
    return jnp.square(jax.nn.relu(h @ w1)) @ w2


def to_chunks(x, L):
    B, T, H, d = x.shape
    return x.reshape(B, T // L, L, H, d).transpose(1, 0, 3, 2, 4)


def from_chunks(x):
    NC, B, H, L, d = x.shape
    return x.transpose(1, 0, 3, 2, 4).reshape(B, NC * L, H, d)


def gla_recurrence(q, k, v, logg, S0):
    T = q.shape[1]
    L = min(CHUNK, T)
    xs = tuple(to_chunks(a.astype(jnp.float32), L) for a in (q, k, v, logg))
    causal = jnp.tril(jnp.ones((L, L), dtype=bool))

    def step(S, inp):
        qc, kc, vc, gc = inp
        b = jnp.cumsum(gc, axis=-2)
        bL = b[..., -1:, :]
        qd = qc * jnp.exp(b)
        kd = kc * jnp.exp(-b)
        att = jnp.where(causal, jnp.einsum('bhld,bhsd->bhls', qd, kd), 0.0)
        o = jnp.einsum('bhls,bhsv->bhlv', att, vc) + jnp.einsum('bhld,bhdv->bhlv', qd, S)
        S = S * jnp.exp(jnp.swapaxes(bL, -1, -2)) + jnp.einsum('bhsd,bhsv->bhdv', kc * jnp.exp(bL - b), vc)
        return S, o

    S, o = lax.scan(step, S0.astype(jnp.float32), xs)
    return from_chunks(o).astype(q.dtype), S


def gla_mixer(h, S0, wq, wk, wv, wg1, wg2, bg, wr, norm_g, wo):
    B, T, _ = h.shape
    q = (h @ wq).reshape(B, T, GLA_HEADS, GLA_DK) * GLA_DK ** -0.5
    k = (h @ wk).reshape(B, T, GLA_HEADS, GLA_DK)
    v = (h @ wv).reshape(B, T, GLA_HEADS, GLA_DV)
    logg = jax.nn.log_sigmoid(((h @ wg1) @ wg2 + bg).astype(jnp.float32)).reshape(B, T, GLA_HEADS, GLA_DK) / GLA_TAU
    o, S = gla_recurrence(q, k, v, logg, S0)
    o = rms_norm(o, norm_g).reshape(B, T, D_MODEL) * jax.nn.silu(h @ wr)
    return o @ wo, S


def retention_log_decay():
    return jnp.log(1.0 - 2.0 ** (-5.0 - jnp.arange(RET_HEADS, dtype=jnp.float32)))


def retention_recurrence(q, k, v, S0):
    T = q.shape[1]
    L = min(CHUNK, T)
    lg = retention_log_decay()
    pos = jnp.arange(L, dtype=jnp.float32)
    rel = pos[:, None] - pos[None, :]
    decay_intra = jnp.where(rel >= 0, jnp.exp(lg[:, None, None] * jnp.maximum(rel, 0.0)), 0.0)
    decay_query = jnp.exp(lg[:, None] * (pos + 1.0))[None, :, :, None]
    decay_key = jnp.exp(lg[:, None] * (L - 1.0 - pos))[:, :, None]
    decay_chunk = jnp.exp(lg * L)[:, None, None]
    xs = tuple(to_chunks(a.astype(jnp.float32), L) for a in (q, k, v))

    def step(S, inp):
        qc, kc, vc = inp
        att = jnp.einsum('bhld,bhsd->bhls', qc, kc) * decay_intra
        o = jnp.einsum('bhls,bhsv->bhlv', att, vc) + jnp.einsum('bhld,bhdv->bhlv', qc, S) * decay_query
        S = S * decay_chunk + jnp.einsum('bhsd,bhsv->bhdv', kc * decay_key, vc)
        return S, o

    S, o = lax.scan(step, S0.astype(jnp.float32), xs)
    return from_chunks(o).astype(q.dtype), S


def retention_mixer(h, S0, wq, wk, wv, wg, wo):
    B, T, _ = h.shape
    q = (h @ wq).reshape(B, T, RET_HEADS, RET_DK)
    k = (h @ wk).reshape(B, T, RET_HEADS, RET_DK) * RET_DK ** -0.5
    v = (h @ wv).reshape(B, T, RET_HEADS, RET_DV)
    o, S = retention_recurrence(q, k, v, S0)
    o = head_group_norm(o).reshape(B, T, RET_VALUE_DIM) * jax.nn.silu(h @ wg)
    return o @ wo, S


def alibi_slopes():
    hh = jnp.arange(1, SWA_Q_HEADS + 1, dtype=jnp.float32)
    return (2.0 ** (-8.0 * hh / SWA_Q_HEADS)).reshape(SWA_KV_HEADS, SWA_GROUP)


def swa_project(h, wqkv, qn, kn):
    B, T, _ = h.shape
    nq = SWA_Q_HEADS * SWA_HEAD_DIM
    nk = SWA_KV_HEADS * SWA_HEAD_DIM
    qkv = h @ wqkv
    q = rms_norm(qkv[..., :nq].reshape(B, T, SWA_KV_HEADS, SWA_GROUP, SWA_HEAD_DIM), qn)
    k = rms_norm(qkv[..., nq:nq + nk].reshape(B, T, SWA_KV_HEADS, SWA_HEAD_DIM), kn)
    v = qkv[..., nq + nk:].reshape(B, T, SWA_KV_HEADS, SWA_HEAD_DIM)
    return q, k, v


def sink_attention(q, k, v, q_pos, k_pos, k_valid, sinks):
    logits = jnp.einsum('bnqkgd,bnskd->bnkgqs', q, k, preferred_element_type=jnp.float32) * SWA_HEAD_DIM ** -0.5
    dist = jnp.abs(q_pos[:, :, None] - k_pos[:, None, :]).astype(jnp.float32)
    logits = logits - alibi_slopes()[None, :, :, None, None] * dist[:, None, None]
    logits = jnp.where(k_valid[:, None, None, None, :], logits, NEG_INF)
    sink = jnp.broadcast_to(sinks.astype(jnp.float32).reshape(SWA_KV_HEADS, SWA_GROUP)[:, :, None, None],
                            logits.shape[:-1] + (1,))
    probs = jax.nn.softmax(jnp.concatenate([logits, sink], axis=-1), axis=-1)[..., :-1]
    return jnp.einsum('bnkgqs,bnskd->bnqkgd', probs.astype(v.dtype), v)


def swa_prompt(h, wqkv, qn, kn, sinks, wo):
    B, T, _ = h.shape
    q, k, v = swa_project(h, wqkv, qn, kn)
    L = CHUNK
    NC = T // L
    P = SWA_CHUNKS

    def band(a):
        ap = jnp.pad(a, ((0, 0), (P * L, 0), (0, 0), (0, 0))).reshape(B, NC + P, L, SWA_KV_HEADS, SWA_HEAD_DIM)
        return jnp.concatenate([ap[:, j:j + NC] for j in range(P + 1)], axis=2)

    c = jnp.arange(NC, dtype=jnp.int32)[:, None]
    q_pos = c * L + jnp.arange(L, dtype=jnp.int32)[None, :]
    k_pos = (c - P) * L + jnp.arange((P + 1) * L, dtype=jnp.int32)[None, :]
    k_valid = k_pos >= 0
    qb = q.reshape(B, NC, L, SWA_KV_HEADS, SWA_GROUP, SWA_HEAD_DIM)
    o = sink_attention(qb, band(k), band(v), q_pos, k_pos, k_valid, sinks)
    return o.reshape(B, T, D_MODEL) @ wo, k[:, -WINDOW:], v[:, -WINDOW:]


def swa_sample(h, cache_k, cache_v, wqkv, qn, kn, sinks, wo):
    B, T, _ = h.shape
    q, k, v = swa_project(h, wqkv, qn, kn)
    W = cache_k.shape[1]
    kk = jnp.concatenate([cache_k.astype(k.dtype), k], axis=1)[:, None]
    vv = jnp.concatenate([cache_v.astype(v.dtype), v], axis=1)[:, None]
    q_pos = (PAST_LEN + jnp.arange(T, dtype=jnp.int32))[None, :]
    k_pos = jnp.concatenate([PAST_LEN - W + jnp.arange(W, dtype=jnp.int32),
                             PAST_LEN + jnp.arange(T, dtype=jnp.int32)])[None, :]
    k_valid = jnp.ones((1, W + T), dtype=bool)
    o = sink_attention(q[:, None], kk, vv, q_pos, k_pos, k_valid, sinks)
    return o.reshape(B, T, D_MODEL) @ wo, k, v


def setup_inputs(seed: int = 0) -> dict:
    key = jax.random.key(seed)
    ks = iter(jax.random.split(key, 48))
    D = D_MODEL

    def nrm(shape, scale=1.0):
        return jax.random.normal(next(ks), shape, jnp.float32) * scale

    qkv_width = (SWA_Q_HEADS + 2 * SWA_KV_HEADS) * SWA_HEAD_DIM
    return {
        'x_prompt': nrm((BATCH, SEQ, D)),
        'x_sample': nrm((DEC_BATCH, DEC_SEQ, D)),
        'state_gla_l0': nrm((DEC_BATCH, GLA_HEADS, GLA_DK, GLA_DV)),
        'state_ret_l1': nrm((DEC_BATCH, RET_HEADS, RET_DK, RET_DV)),
        'cache_swa_k_l2': nrm((DEC_BATCH, SWA_CACHE_LEN, SWA_KV_HEADS, SWA_HEAD_DIM)),
        'cache_swa_v_l2': nrm((DEC_BATCH, SWA_CACHE_LEN, SWA_KV_HEADS, SWA_HEAD_DIM)),
        'state_gla_l3': nrm((DEC_BATCH, GLA_HEADS, GLA_DK, GLA_DV)),
        'c_prompt': nrm((BATCH, D)),
        'c_sample': nrm((DEC_BATCH, D)),
        'norm_mix': 1.0 + nrm((DEPTH, D), 0.05),
        'norm_mlp': 1.0 + nrm((DEPTH, D), 0.05),
        'ada_w': nrm((DEPTH, D, ADA_CHUNKS * D), 0.5 * D ** -0.5),
        'ada_b': nrm((DEPTH, ADA_CHUNKS * D), 0.02),
        'mlp_w1': nrm((DEPTH, D, MLP_HIDDEN), D ** -0.5),
        'mlp_w2': nrm((DEPTH, MLP_HIDDEN, D), MLP_HIDDEN ** -0.5),
        'gla_wq': nrm((N_GLA_LAYERS, D, GLA_KEY_DIM), D ** -0.5),
        'gla_wk': nrm((N_GLA_LAYERS, D, GLA_KEY_DIM), D ** -0.5),
        'gla_wv': nrm((N_GLA_LAYERS, D, D), D ** -0.5),
        'gla_wg1': nrm((N_GLA_LAYERS, D, GLA_GATE_RANK), D ** -0.5),
        'gla_wg2': nrm((N_GLA_LAYERS, GLA_GATE_RANK, GLA_KEY_DIM), GLA_GATE_RANK ** -0.5),
        'gla_bg': nrm((N_GLA_LAYERS, GLA_KEY_DIM), 0.1),
        'gla_wr': nrm((N_GLA_LAYERS, D, D), D ** -0.5),
        'gla_norm': 1.0 + nrm((N_GLA_LAYERS, GLA_DV), 0.05),
        'gla_wo': nrm((N_GLA_LAYERS, D, D), D ** -0.5),
        'ret_wq': nrm((N_RET_LAYERS, D, D), D ** -0.5),
        'ret_wk': nrm((N_RET_LAYERS, D, D), D ** -0.5),
        'ret_wv': nrm((N_RET_LAYERS, D, RET_VALUE_DIM), D ** -0.5),
        'ret_wg': nrm((N_RET_LAYERS, D, RET_VALUE_DIM), D ** -0.5),
        'ret_wo': nrm((N_RET_LAYERS, RET_VALUE_DIM, D), RET_VALUE_DIM ** -0.5),
        'swa_wqkv': nrm((N_SWA_LAYERS, D, qkv_width), D ** -0.5),
        'swa_qnorm': 1.0 + nrm((N_SWA_LAYERS, SWA_HEAD_DIM), 0.05),
        'swa_knorm': 1.0 + nrm((N_SWA_LAYERS, SWA_HEAD_DIM), 0.05),
        'swa_sinks': nrm((N_SWA_LAYERS, SWA_Q_HEADS), 1.0),
        'swa_wo': nrm((N_SWA_LAYERS, D, D), D ** -0.5),
    }


def reference(x_prompt, x_sample, state_gla_l0, state_ret_l1, cache_swa_k_l2, cache_swa_v_l2, state_gla_l3,
              c_prompt, c_sample, norm_mix, norm_mlp, ada_w, ada_b, mlp_w1, mlp_w2,
              gla_wq, gla_wk, gla_wv, gla_wg1, gla_wg2, gla_bg, gla_wr, gla_norm, gla_wo,
              ret_wq, ret_wk, ret_wv, ret_wg, ret_wo,
              swa_wqkv, swa_qnorm, swa_knorm, swa_sinks, swa_wo):
    gla_states = [state_gla_l0, state_gla_l3]
    ret_states = [state_ret_l1]
    swa_caches = [(cache_swa_k_l2, cache_swa_v_l2)]
    yp, ys = x_prompt, x_sample
    bp = x_prompt.shape[0]
    new_state = []
    for layer in range(DEPTH):
        kind, j = layer % N_MIXERS, layer // N_MIXERS
        sh_mp, sc_mp, g_mp, sh_fp, sc_fp, g_fp = ada_modulation(c_prompt, ada_w[layer], ada_b[layer])
        sh_ms, sc_ms, g_ms, sh_fs, sc_fs, g_fs = ada_modulation(c_sample, ada_w[layer], ada_b[layer])
        hp = modulate(yp, norm_mix[layer], sh_mp, sc_mp)
        hs = modulate(ys, norm_mix[layer], sh_ms, sc_ms)
        if kind == 0:
            w = (gla_wq[j], gla_wk[j], gla_wv[j], gla_wg1[j], gla_wg2[j], gla_bg[j], gla_wr[j], gla_norm[j], gla_wo[j])
            zero_state = jnp.zeros((bp, GLA_HEADS, GLA_DK, GLA_DV), jnp.float32)
            o_p, st_p = gla_mixer(hp, zero_state, *w)
            o_s, st_s = gla_mixer(hs, gla_states[j], *w)
            new_state += [st_p, st_s]
        elif kind == 1:
            w = (ret_wq[j], ret_wk[j], ret_wv[j], ret_wg[j], ret_wo[j])
            zero_state = jnp.zeros((bp, RET_HEADS, RET_DK, RET_DV), jnp.float32)
            o_p, st_p = retention_mixer(hp, zero_state, *w)
            o_s, st_s = retention_mixer(hs, ret_states[j], *w)
            new_state += [st_p, st_s]
        else:
            w = (swa_wqkv[j], swa_qnorm[j], swa_knorm[j], swa_sinks[j], swa_wo[j])
            ck, cv = swa_caches[j]
            o_p, k_p, v_p = swa_prompt(hp, *w)
            o_s, k_s, v_s = swa_sample(hs, ck, cv, *w)
            new_state += [k_p, v_p, k_s, v_s]
        yp = yp + g_mp * o_p
        ys = ys + g_ms * o_s
        yp = yp + g_fp * sq_relu_mlp(modulate(yp, norm_mlp[layer], sh_fp, sc_fp), mlp_w1[layer], mlp_w2[layer])
        ys = ys + g_fs * sq_relu_mlp(modulate(ys, norm_mlp[layer], sh_fs, sc_fs), mlp_w1[layer], mlp_w2[layer])
    return (yp, ys, *new_state)
```

```cpp
#include <hip/hip_runtime.h>
#include <hip/hip_cooperative_groups.h>
#include <cstdio>
#include <cstdint>
namespace cg = cooperative_groups;

#define LAS __attribute__((address_space(3)))
typedef unsigned short bf16_t;
typedef short bf16x8 __attribute__((ext_vector_type(8)));
typedef float f32x4 __attribute__((ext_vector_type(4)));
typedef unsigned u32x4 __attribute__((ext_vector_type(4)));
typedef unsigned u32x2 __attribute__((ext_vector_type(2)));

constexpr int D = 1024, NB = 16, SEQ = 4096, DSEQ = 16, MP = NB * SEQ, MS = NB * DSEQ, MT = MP + MS;
constexpr int HID = 4096, ADA = 6 * D;
constexpr int GLA_H = 4, GLA_DK = 128, GLA_DV = 256, GLA_N = 3584;
constexpr int RET_H = 4, RET_DK = 256, RET_DV = 512, RET_N = 6144;
constexpr int SWA_N = 1536;
constexpr int NTHREADS = 512;
constexpr int LDS_BYTES = 160 * 1024;
constexpr int DBG_LAYER_MASK = 0xF; constexpr bool DBG_MIXER = true, DBG_MLP = true; constexpr int DBG_SKIP = 0; constexpr bool DBG_FRESH_O = false; constexpr int PROBE_DUP_MIXER = 0, PROBE_DUP_GEMM = 0, PROBE_DUP_MOD = 0;

constexpr size_t O_YP = 0, O_YS = O_YP + (size_t)MP * D, O_G0P = O_YS + (size_t)MS * D, O_G0S = O_G0P + (size_t)NB * 4 * 128 * 256,
                 O_RP = O_G0S + (size_t)NB * 4 * 128 * 256, O_RS = O_RP + (size_t)NB * 4 * 256 * 512, O_KP = O_RS + (size_t)NB * 4 * 256 * 512,
                 O_VP = O_KP + (size_t)NB * 128 * 256, O_KS = O_VP + (size_t)NB * 128 * 256, O_VS = O_KS + (size_t)NB * 16 * 256,
                 O_G3P = O_VS + (size_t)NB * 16 * 256, O_G3S = O_G3P + (size_t)NB * 4 * 128 * 256, O_END = O_G3S + (size_t)NB * 4 * 128 * 256;

constexpr size_t WS_W1T = 0;
constexpr size_t WS_W2T = WS_W1T + (size_t)4 * HID * D * 2;
constexpr size_t WS_GIN = WS_W2T + (size_t)4 * HID * D * 2;
constexpr size_t WS_GO  = WS_GIN + (size_t)2 * GLA_N * D * 2;
constexpr size_t WS_RIN = WS_GO + (size_t)2 * D * D * 2;
constexpr size_t WS_RO  = WS_RIN + (size_t)RET_N * D * 2;
constexpr size_t WS_SIN = WS_RO + (size_t)D * 2048 * 2;
constexpr size_t WS_SO  = WS_SIN + (size_t)SWA_N * D * 2;
constexpr size_t WS_MOD = WS_SO + (size_t)D * D * 2;
constexpr size_t WS_H   = WS_MOD + (size_t)4 * 32 * ADA * 4;
constexpr size_t WS_P   = WS_H + (size_t)MT * D * 2;
constexpr size_t WS_AVEC = WS_P + (size_t)MT * RET_N * 2;
constexpr size_t WS_CVEC = WS_AVEC + (size_t)8 * 32 * D * 4;
constexpr int CVEC_TOTAL_N = 2 * GLA_N + RET_N + SWA_N + 4 * HID;
constexpr size_t WS_RSS = WS_CVEC + (size_t)32 * CVEC_TOTAL_N * 4;
constexpr size_t WS_BAR = WS_RSS + (size_t)MP * 16 * 4 + (size_t)MS * 64 * 4;
constexpr size_t WS_BAR_BYTES = 16384;
constexpr size_t WS_END = WS_BAR + WS_BAR_BYTES;

struct TJob { const float* src; bf16_t* dst; int K, N, tile0; float scale; };
constexpr int NJOBS = 25;
struct Params {
    const float* in[34];
    float* out;
    unsigned char* ws;
    TJob jobs[NJOBS];
    int ntiles; int pad0;
};

typedef __bf16 bf16x2_t __attribute__((ext_vector_type(2)));
typedef float f32x2_t __attribute__((ext_vector_type(2)));
__device__ __forceinline__ unsigned cvt_pk_bf16(float lo, float hi) { const f32x2_t v = {lo, hi}; const bf16x2_t r = __builtin_convertvector(v, bf16x2_t); return __builtin_bit_cast(unsigned, r); }
__device__ __forceinline__ float bf_lo(unsigned u) { return __uint_as_float(u << 16); }
__device__ __forceinline__ float bf_hi(unsigned u) { return __uint_as_float(u & 0xffff0000u); }
__device__ __forceinline__ float silu_f(float x) { return x / (1.0f + __expf(-x)); }
__device__ __forceinline__ int seq_of_row(int r) { return r < MP ? (r >> 12) : 16 + ((r - MP) >> 4); }
__device__ __forceinline__ int opaque_tid() { int t = threadIdx.x; asm volatile("" : "+v"(t)); return t; }
__device__ __forceinline__ int opaque_bid() { int t = blockIdx.x; asm volatile("" : "+s"(t)); return t; }
__device__ __forceinline__ int opaque_nwg() { int t = gridDim.x; asm volatile("" : "+s"(t)); return t; }
__device__ __forceinline__ float wave_sum(float v) {
#pragma unroll
    for (int o = 32; o > 0; o >>= 1) v += __shfl_xor(v, o);
    return v;
}

namespace pg8 {
constexpr int BM = 256, BK = 64, HALF = 128, HTB = HALF * BK * 2, STAGE_BYTES = 8 * HTB, NXCD = 8, WGM = 8;
__host__ __device__ __forceinline__ int lds_byte(int r, int c) { const int st = (r >> 4) * 2 + (c >> 5), rr = r & 15, cc = c & 31, ob = rr * 64 + cc * 2; return st * 1024 + (ob ^ (((ob >> 9) & 1) << 5)); }
__host__ __device__ __forceinline__ void stage_rc(int b, int& R, int& C) { const int st = b / 1024, sb = b % 1024, swz = sb ^ (((sb >> 9) & 1) << 5); R = (st >> 1) * 16 + swz / 64; C = (st & 1) * 32 + (swz % 64) / 2; }
__host__ __device__ __forceinline__ int perm32(int rho) { const int n = rho >> 4, i = rho & 15; return 8 * (i >> 2) + 4 * n + (i & 3); }
struct Unit { int pm, pn; };
struct Gemm { const bf16_t* A; const bf16_t* Bt; int M, N, K, lda; };
struct StaticOrder {
    int nM, nN, nwg, G, c;
    __device__ void init(int M, int N, int G_, int c_) { nM = M / BM; nN = N / BM; nwg = nM * nN; G = G_; c = c_; }
    __device__ bool next(int i, Unit& u) const {
        const long L = (long)i * G + c; if (L >= nwg) return false;
        int wgid = (int)L; { const int q = nwg / NXCD, r = nwg % NXCD, xcd = wgid % NXCD, off = wgid / NXCD; wgid = (xcd < r ? xcd * (q + 1) : r * (q + 1) + (xcd - r) * q) + off; }
        const int nig = WGM * nN, gid = wgid / nig, fm = gid * WGM, gsz = (nM - fm) < WGM ? (nM - fm) : WGM;
        u.pm = fm + ((wgid % nig) % gsz); u.pn = (wgid % nig) / gsz; return true;
    }
};

template <class Epi>
__device__ __forceinline__ void gemm_phase(LAS unsigned char* lds, const Gemm g, const StaticOrder& S, const Epi& E) {
    const int tid = opaque_tid(), wid = __builtin_amdgcn_readfirstlane(tid >> 6), lane = tid & 63, wr = wid >> 2, wc = wid & 3, fr = lane & 15, fq = lane >> 4;
    const int K = g.K, nt = K / BK, lda = g.lda;
    unsigned voffA[2], voffB[2];
#pragma unroll
    for (int i = 0; i < 2; ++i) { int R, C; stage_rc(tid * 16 + i * 8192, R, C); const int Rb = Epi::PERM ? ((R & ~31) + perm32(R & 31)) : R;
        voffA[i] = (unsigned)(R * lda + C) * 2u; voffB[i] = (unsigned)(Rb * K + C) * 2u; }
    const size_t kstep = (size_t)(BK * 2);
    const size_t hstepA = (size_t)HALF * lda * 2, hstepB = (size_t)HALF * K * 2;
    const size_t tstepA = 2 * hstepA, tstepB = 2 * hstepB;
    const unsigned ldsw = (unsigned)wid * 1024u;
    const int aoff = lds_byte(wr * 64 + fr, fq * 8), boff = lds_byte(wc * 32 + fr, fq * 8);
#define PG8_SA(b, h) (((b) * 2 + (h)) * HTB)
#define PG8_SB(b, h) ((4 + (b) * 2 + (h)) * HTB)
#define PG8_STAGE(bufoff, gbase, voff) do { _Pragma("unroll") for (int _i = 0; _i < 2; ++_i) \
        __builtin_amdgcn_global_load_lds((const unsigned*)((const char*)(gbase) + (voff)[_i]), (LAS unsigned*)(lds + (bufoff) + ldsw + _i * 8192), 16, 0, 0); } while (0)
#define PG8_LDA(dst, b, h) do { _Pragma("unroll") for (int m = 0; m < 4; ++m) _Pragma("unroll") for (int k = 0; k < 2; ++k) dst[m][k] = *(const LAS bf16x8*)(lds + PG8_SA(b, h) + aoff + m * 2048 + k * 1024); } while (0)
#define PG8_LDB(dst, b, h) do { _Pragma("unroll") for (int n = 0; n < 2; ++n) _Pragma("unroll") for (int k = 0; k < 2; ++k) dst[n][k] = *(const LAS bf16x8*)(lds + PG8_SB(b, h) + boff + n * 2048 + k * 1024); } while (0)
#define PG8_MMA(ai, bj, At, Bt) do { __builtin_amdgcn_s_setprio(1); _Pragma("unroll") for (int m = 0; m < 4; ++m) _Pragma("unroll") for (int n = 0; n < 2; ++n) _Pragma("unroll") for (int k = 0; k < 2; ++k) \
        acc[ai][bj][m][n] = __builtin_amdgcn_mfma_f32_16x16x32_bf16(Bt[n][k], At[m][k], acc[ai][bj][m][n], 0, 0, 0); __builtin_amdgcn_s_setprio(0); } while (0)
#define PG8_WAIT_V(n) asm volatile("s_waitcnt vmcnt(" #n ")" ::: "memory")
#define PG8_WAIT_L(n) asm volatile("s_waitcnt lgkmcnt(" #n ")" ::: "memory")
#define PG8_BAR __builtin_amdgcn_s_barrier()
#define PG8_SCHED __builtin_amdgcn_sched_barrier(0)
    Unit cur, nxt; int ui = 0;
    if (!S.next(0, cur)) return;
    f32x4 acc[2][2][4][2];
#pragma unroll
    for (int a = 0; a < 2; ++a)
#pragma unroll
        for (int b = 0; b < 2; ++b)
#pragma unroll
            for (int m = 0; m < 4; ++m)
#pragma unroll
                for (int n = 0; n < 2; ++n) acc[a][b][m][n] = (f32x4){0.f, 0.f, 0.f, 0.f};
    bf16x8 At[4][2], B0[2][2], B1[2][2];
    const char* cA = (const char*)g.A + (size_t)cur.pm * tstepA; const char* cB = (const char*)g.Bt + (size_t)cur.pn * tstepB;
    PG8_STAGE(PG8_SB(0, 0), cB, voffB); PG8_STAGE(PG8_SA(0, 0), cA, voffA); PG8_STAGE(PG8_SB(0, 1), cB + hstepB, voffB); PG8_STAGE(PG8_SA(0, 1), cA + hstepA, voffA);
    if (wr == 1) PG8_BAR;
    PG8_WAIT_V(4); PG8_BAR;
    PG8_STAGE(PG8_SB(1, 0), cB + kstep, voffB); PG8_STAGE(PG8_SA(1, 0), cA + kstep, voffA); PG8_STAGE(PG8_SB(1, 1), cB + hstepB + kstep, voffB);
    PG8_WAIT_V(6); PG8_BAR;
    for (;;) {
        const bool has_next = S.next(ui + 1, nxt);
        const char* nA = has_next ? (const char*)g.A + (size_t)nxt.pm * tstepA : cA; const char* nB = has_next ? (const char*)g.Bt + (size_t)nxt.pn * tstepB : cB;
        for (int t = 0; t < nt; t += 2) {
            const bool last = (t == nt - 2);
            const char* a1 = cA + (size_t)(t + 1) * kstep;
            const char* a2 = last ? nA : cA + (size_t)(t + 2) * kstep; const char* b2 = last ? nB : cB + (size_t)(t + 2) * kstep;
            const char* a3 = a2 + kstep; const char* b3 = b2 + kstep;
            PG8_LDB(B0, 0, 0); PG8_SCHED; PG8_LDA(At, 0, 0); PG8_STAGE(PG8_SA(1, 1), a1 + hstepA, voffA);
            PG8_WAIT_L(8); PG8_BAR; PG8_WAIT_L(0); PG8_MMA(0, 0, At, B0); PG8_BAR; PG8_SCHED;
            PG8_LDB(B1, 0, 1); PG8_STAGE(PG8_SB(0, 0), b2, voffB);
            PG8_BAR; PG8_WAIT_L(0); PG8_MMA(0, 1, At, B1); PG8_BAR;
            PG8_LDA(At, 0, 1); PG8_STAGE(PG8_SA(0, 0), a2, voffA);
            PG8_BAR; PG8_WAIT_L(0); PG8_MMA(1, 0, At, B0); PG8_BAR; PG8_SCHED;
            PG8_STAGE(PG8_SB(0, 1), b2 + hstepB, voffB);
            PG8_WAIT_V(6); PG8_BAR; PG8_MMA(1, 1, At, B1); PG8_BAR;
            PG8_LDB(B0, 1, 0); PG8_SCHED; PG8_LDA(At, 1, 0); PG8_STAGE(PG8_SA(0, 1), a2 + hstepA, voffA);
            PG8_WAIT_L(8); PG8_BAR; PG8_WAIT_L(0); PG8_MMA(0, 0, At, B0); PG8_BAR; PG8_SCHED;
            PG8_LDB(B1, 1, 1); PG8_STAGE(PG8_SB(1, 0), b3, voffB);
            PG8_BAR; PG8_WAIT_L(0); PG8_MMA(0, 1, At, B1); PG8_BAR;
            PG8_LDA(At, 1, 1); PG8_STAGE(PG8_SA(1, 0), a3, voffA);
            PG8_BAR; PG8_WAIT_L(0); PG8_MMA(1, 0, At, B0); PG8_BAR; PG8_SCHED;
            PG8_STAGE(PG8_SB(1, 1), b3 + hstepB, voffB);
            PG8_WAIT_V(6); PG8_BAR; PG8_MMA(1, 1, At, B1); PG8_BAR;
        }
        E(acc, cur, wr, wc, fr, fq);
        if (!has_next) break;
#pragma unroll
        for (int a = 0; a < 2; ++a)
#pragma unroll
            for (int b = 0; b < 2; ++b)
#pragma unroll
                for (int m = 0; m < 4; ++m)
#pragma unroll
                    for (int n = 0; n < 2; ++n) acc[a][b][m][n] = (f32x4){0.f, 0.f, 0.f, 0.f};
        cur = nxt; cA = nA; cB = nB; ++ui;
    }
    PG8_WAIT_V(0);
    if (wr == 0) PG8_BAR;
    PG8_BAR;
#undef PG8_SA
#undef PG8_SB
#undef PG8_STAGE
#undef PG8_LDA
#undef PG8_LDB
#undef PG8_MMA
#undef PG8_WAIT_V
#undef PG8_WAIT_L
#undef PG8_BAR
#undef PG8_SCHED
}

__device__ __forceinline__ float row_rs(const float* rss, int r) {
    float t;
    if (r < MP) { const f32x4* q = (const f32x4*)(rss + (size_t)r * 16); const f32x4 a = q[0] + q[1] + q[2] + q[3]; t = (a[0] + a[1]) + (a[2] + a[3]); }
    else { const f32x4* q = (const f32x4*)(rss + (size_t)MP * 16 + (size_t)(r - MP) * 64); f32x4 a = q[0];
#pragma unroll
        for (int i = 1; i < 16; ++i) a += q[i];
        t = (a[0] + a[1]) + (a[2] + a[3]); }
    return rsqrtf(t * (1.0f / D) + 1e-6f);
}
__device__ __forceinline__ float logsig16(float x) { return (fminf(x, 0.f) - __logf(1.0f + __expf(-fabsf(x)))) * (1.0f / 16.0f); }
struct EpiBf16 {
    static constexpr bool PERM = true;
    bf16_t* O; int ldc; int mode; int gate_lo; const float* bias; const float* rowss; const float* cvec;
    __device__ __forceinline__ void tile4(int r, int c, f32x4 v) const {
        const float rs = row_rs(rowss, r);
        v = v * rs + *(const f32x4*)(cvec + (size_t)seq_of_row(r) * ldc + c);
        if (mode == 1) {
#pragma unroll
            for (int j = 0; j < 4; ++j) { const float a = fmaxf(v[j], 0.f); v[j] = a * a; } }
        if (c >= gate_lo) { const f32x4 b = *(const f32x4*)(bias + (c - gate_lo));
#pragma unroll
            for (int j = 0; j < 4; ++j) v[j] = logsig16(v[j] + b[j]); }
        u32x2 w; w.x = cvt_pk_bf16(v[0], v[1]); w.y = cvt_pk_bf16(v[2], v[3]);
        *(u32x2*)(O + (size_t)r * ldc + c) = w;
    }
    __device__ __forceinline__ void operator()(const f32x4 (&acc)[2][2][4][2], const Unit& u, int wr, int wc, int fr, int fq) const {
        const int row0 = u.pm * BM + wr * 64 + fr, colt = u.pn * BM, col0 = colt + wc * 32 + 8 * fq;
        const bool gate = colt >= gate_lo;
        const float* cvp = cvec + (size_t)seq_of_row(u.pm * BM) * ldc + col0;
        f32x4 bv[2][2];
#pragma unroll
        for (int bj = 0; bj < 2; ++bj)
#pragma unroll
            for (int n = 0; n < 2; ++n) { bv[bj][n] = *(const f32x4*)(cvp + bj * HALF + 4 * n); if (gate) bv[bj][n] += *(const f32x4*)(bias + (col0 - gate_lo) + bj * HALF + 4 * n); }
#pragma unroll
        for (int ai = 0; ai < 2; ++ai) {
            f32x4 q[4][4];
#pragma unroll
            for (int m = 0; m < 4; ++m) { const f32x4* qp = (const f32x4*)(rowss + (size_t)(row0 + ai * HALF + m * 16) * 16);
#pragma unroll
                for (int i = 0; i < 4; ++i) q[m][i] = qp[i]; }
#pragma unroll
            for (int m = 0; m < 4; ++m) { const int r = row0 + ai * HALF + m * 16; bf16_t* rowp = O + (size_t)r * ldc + col0;
                const f32x4 qs = (q[m][0] + q[m][1]) + (q[m][2] + q[m][3]);
                const float rs = rsqrtf(((qs[0] + qs[1]) + (qs[2] + qs[3])) * (1.0f / D) + 1e-6f);
#pragma unroll
                for (int bj = 0; bj < 2; ++bj) { f32x4 v0 = acc[ai][bj][m][0] * rs + bv[bj][0], v1 = acc[ai][bj][m][1] * rs + bv[bj][1];
                    if (mode == 1) {
#pragma unroll
                        for (int j = 0; j < 4; ++j) { const float a = fmaxf(v0[j], 0.f), b = fmaxf(v1[j], 0.f); v0[j] = a * a; v1[j] = b * b; } }
                    if (gate) {
#pragma unroll
                        for (int j = 0; j < 4; ++j) { v0[j] = logsig16(v0[j]); v1[j] = logsig16(v1[j]); } }
                    u32x4 w; w.x = cvt_pk_bf16(v0[0], v0[1]); w.y = cvt_pk_bf16(v0[2], v0[3]); w.z = cvt_pk_bf16(v1[0], v1[1]); w.w = cvt_pk_bf16(v1[2], v1[3]);
                    *(u32x4*)(rowp + bj * HALF) = w; } } }
    }
};
struct EpiRes {
    static constexpr bool PERM = false;
    const float* yin_p; const float* yin_s; float* yout; const float* gate;
    bf16_t* Hn; const float* av; float* rowss_next;
    __device__ __forceinline__ void tile4(int r, int c, f32x4 v) const {
        const int sq = seq_of_row(r);
        const f32x4 gv = *(const f32x4*)(gate + (size_t)sq * ADA + c), iv = *(const f32x4*)((r < MP ? yin_p + (size_t)r * D : yin_s + (size_t)(r - MP) * D) + c);
        const f32x4 y = iv + gv * v;
        *(f32x4*)(yout + (size_t)r * D + c) = y;
        if (Hn) {
            const f32x4 a = *(const f32x4*)(av + (size_t)sq * D + c);
            u32x2 w; w.x = cvt_pk_bf16(y[0] * a[0], y[1] * a[1]); w.y = cvt_pk_bf16(y[2] * a[2], y[3] * a[3]);
            *(u32x2*)(Hn + (size_t)r * D + c) = w;
            float ss = y[0] * y[0] + y[1] * y[1] + y[2] * y[2] + y[3] * y[3];
            ss += __shfl_xor(ss, 16); ss += __shfl_xor(ss, 32);
            if ((threadIdx.x & 48) == 0) rowss_next[(size_t)MP * 16 + (size_t)(r - MP) * 64 + (c >> 4)] = ss;
        }
    }
    __device__ __forceinline__ void operator()(const f32x4 (&acc)[2][2][4][2], const Unit& u, int wr, int wc, int fr, int fq) const {
        const int row0 = u.pm * BM + wr * 64 + fr, col0 = u.pn * BM + wc * 32 + 4 * fq;
        const int sq = seq_of_row(u.pm * BM);
        const float* gp = gate + (size_t)sq * ADA + col0;
        f32x4 gv[2][2];
        const float* avp = av + (size_t)sq * D + col0;
#pragma unroll
        for (int bj = 0; bj < 2; ++bj)
#pragma unroll
            for (int n = 0; n < 2; ++n) gv[bj][n] = *(const f32x4*)(gp + bj * HALF + n * 16);
#pragma unroll
        for (int ai = 0; ai < 2; ++ai) {
            f32x4 yv[4][2][2];
#pragma unroll
            for (int m = 0; m < 4; ++m) { const float* ip = yin_p + (size_t)(row0 + ai * HALF + m * 16) * D + col0;
#pragma unroll
                for (int bj = 0; bj < 2; ++bj)
#pragma unroll
                    for (int n = 0; n < 2; ++n) yv[m][bj][n] = *(const f32x4*)(ip + bj * HALF + n * 16); }
#pragma unroll
            for (int m = 0; m < 4; ++m) { const int r = row0 + ai * HALF + m * 16;
                float* op = yout + (size_t)r * D + col0;
                float ss = 0.f;
#pragma unroll
                for (int bj = 0; bj < 2; ++bj)
#pragma unroll
                    for (int n = 0; n < 2; ++n) { const int co = bj * HALF + n * 16;
                        const f32x4 y = yv[m][bj][n] + gv[bj][n] * acc[ai][bj][m][n];
                        *(f32x4*)(op + co) = y;
                        if (Hn) { const f32x4 a = *(const f32x4*)(avp + co);
                            u32x2 w; w.x = cvt_pk_bf16(y[0] * a[0], y[1] * a[1]); w.y = cvt_pk_bf16(y[2] * a[2], y[3] * a[3]);
                            *(u32x2*)(Hn + (size_t)r * D + col0 + co) = w;
                            ss += y[0] * y[0] + y[1] * y[1] + y[2] * y[2] + y[3] * y[3]; } }
                if (Hn) { ss += __shfl_xor(ss, 16); ss += __shfl_xor(ss, 32); if (fq == 0) rowss_next[(size_t)r * 16 + u.pn * 4 + wc] = ss; } } }
    }
};

template <class Epi>
__device__ __forceinline__ void gemm_sample(unsigned char* lds, const Gemm g, const Epi& E) {
    const int tid = opaque_tid(), wid = tid >> 6, lane = tid & 63, g4 = lane >> 4, r16 = lane & 15;
    const int K = g.K, CT = g.N >> 8;
    f32x4* red = (f32x4*)lds;
    for (int v = opaque_bid(); v < 256; v += opaque_nwg()) {
        const int row = MP + (v & 15) * 16 + r16, colbase = (v >> 4) * (g.N >> 4);
        const bf16_t* ap = g.A + (size_t)row * g.lda + g4 * 8;
        if (CT == 4) {
            const int ct = wid & 3, kh = wid >> 2, k0 = kh * (K >> 1), k1 = k0 + (K >> 1);
            const bf16_t* bp = g.Bt + (size_t)(colbase + ct * 16 + r16) * K + g4 * 8;
            f32x4 acc = (f32x4){0.f, 0.f, 0.f, 0.f};
#pragma unroll 8
            for (int k = k0; k < k1; k += 32) acc = __builtin_amdgcn_mfma_f32_16x16x32_bf16(*(const bf16x8*)(bp + k), *(const bf16x8*)(ap + k), acc, 0, 0, 0);
            __syncthreads();
            if (kh == 1) red[ct * 64 + lane] = acc;
            __syncthreads();
            if (kh == 0) { acc += red[ct * 64 + lane]; E.tile4(row, colbase + ct * 16 + g4 * 4, acc); }
        } else {
            const int c0 = wid, c1 = wid + 8, c2 = wid + 16;
            const bool h1 = c1 < CT, h2 = c2 < CT;
            if (c0 < CT) {
                const bf16_t* bp0 = g.Bt + (size_t)(colbase + c0 * 16 + r16) * K + g4 * 8;
                const bf16_t* bp1 = g.Bt + (size_t)(colbase + (h1 ? c1 : c0) * 16 + r16) * K + g4 * 8;
                const bf16_t* bp2 = g.Bt + (size_t)(colbase + (h2 ? c2 : c0) * 16 + r16) * K + g4 * 8;
                f32x4 a0 = (f32x4){0.f, 0.f, 0.f, 0.f}, a1 = a0, a2 = a0;
#pragma unroll 4
                for (int k = 0; k < K; k += 32) { const bf16x8 av = *(const bf16x8*)(ap + k);
                    a0 = __builtin_amdgcn_mfma_f32_16x16x32_bf16(*(const bf16x8*)(bp0 + k), av, a0, 0, 0, 0);
                    a1 = __builtin_amdgcn_mfma_f32_16x16x32_bf16(*(const bf16x8*)(bp1 + k), av, a1, 0, 0, 0);
                    a2 = __builtin_amdgcn_mfma_f32_16x16x32_bf16(*(const bf16x8*)(bp2 + k), av, a2, 0, 0, 0); }
                E.tile4(row, colbase + c0 * 16 + g4 * 4, a0);
                if (h1) E.tile4(row, colbase + c1 * 16 + g4 * 4, a1);
                if (h2) E.tile4(row, colbase + c2 * 16 + g4 * 4, a2);
            }
        }
    }
}
}

#define MFMA16(a, b, c) __builtin_amdgcn_mfma_f32_16x16x32_bf16((a), (b), (c), 0, 0, 0)

__device__ __forceinline__ void prep_phase(unsigned char* lds, const Params& p) {
    const int tid = opaque_tid();
    {
        float* sc = (float*)lds;
        float* red = sc + 32 * 512;
        for (int u = opaque_bid(); u < 4 * 48; u += opaque_nwg()) {
            const int l = u / 48, cb = u % 48, col = cb * 128 + (tid & 127), kq = tid >> 7;
            const float* w = p.in[11] + (size_t)l * D * ADA + col;
            float a[32];
#pragma unroll
            for (int s = 0; s < 32; ++s) a[s] = 0.f;
#pragma unroll 1
            for (int half = 0; half < 2; ++half) {
                __syncthreads();
                for (int i = tid; i < 32 * 512; i += NTHREADS) { const int s = i >> 9, k = half * 512 + (i & 511); const float c = s < 16 ? p.in[7][s * D + k] : p.in[8][(s - 16) * D + k]; sc[i] = silu_f(c); }
                __syncthreads();
#pragma unroll 2
                for (int kl = kq * 128; kl < kq * 128 + 128; kl += 4) {
                    const int k = half * 512 + kl;
                    const float w0 = w[(size_t)k * ADA], w1 = w[(size_t)(k + 1) * ADA], w2 = w[(size_t)(k + 2) * ADA], w3 = w[(size_t)(k + 3) * ADA];
#pragma unroll
                    for (int s = 0; s < 32; ++s) { const f32x4 c4 = *(const f32x4*)(sc + s * 512 + kl); a[s] += c4[0] * w0 + c4[1] * w1 + c4[2] * w2 + c4[3] * w3; }
                }
            }
            if (kq > 0) {
#pragma unroll
                for (int s = 0; s < 32; ++s) red[((kq - 1) * 32 + s) * 128 + (tid & 127)] = a[s];
            }
            __syncthreads();
            if (kq == 0) {
                float* mo = (float*)(p.ws + WS_MOD) + (size_t)l * 32 * ADA + col;
                const float bias = p.in[12][(size_t)l * ADA + col];
#pragma unroll
                for (int s = 0; s < 32; ++s) { const int c = tid & 127; mo[(size_t)s * ADA] = a[s] + red[(0 * 32 + s) * 128 + c] + red[(1 * 32 + s) * 128 + c] + red[(2 * 32 + s) * 128 + c] + bias; }
            }
        }
        __syncthreads();
    }
    {
        const int gt = opaque_bid() * NTHREADS + tid, gn = opaque_nwg() * NTHREADS;
        for (int i = gt; i < 2 * 512 * 512; i += gn) {
            const int k2 = (i & 511) * 2, n = (i >> 9) & 511, j = i >> 18;
            const float* w1 = p.in[18] + (size_t)j * D * 16 + (size_t)k2 * 16; const float* w2 = p.in[19] + (size_t)j * 16 * 512 + n;
            float a0 = 0.f, a1 = 0.f;
#pragma unroll
            for (int r = 0; r < 16; ++r) { const float b = w2[r * 512]; a0 += w1[r] * b; a1 += w1[16 + r] * b; }
            bf16_t* dst = (bf16_t*)(p.ws + WS_GIN) + (size_t)j * GLA_N * D + (size_t)(3072 + n) * D + k2;
            *(unsigned*)dst = cvt_pk_bf16(a0, a1);
        }
    }
    {
        float* tl = (float*)lds;
        for (int t = opaque_bid(); t < p.ntiles; t += opaque_nwg()) {
            int j = 0;
#pragma unroll 1
            for (int q = 1; q < NJOBS; ++q) if (t >= p.jobs[q].tile0) j = q;
            const TJob jb = p.jobs[j];
            const int lt = t - jb.tile0, ntn = jb.N >> 7, k0 = (lt / ntn) << 6, n0 = (lt % ntn) << 7;
            __syncthreads();
#pragma unroll
            for (int i = 0; i < 16; ++i) { const int idx = tid + NTHREADS * i, r = idx >> 7, c = idx & 127; tl[c * 65 + r] = jb.src[(size_t)(k0 + r) * jb.N + n0 + c]; }
            __syncthreads();
#pragma unroll
            for (int i = 0; i < 8; ++i) { const int pi = tid + NTHREADS * i, n = pi >> 5, k2 = (pi & 31) * 2;
                *(unsigned*)(jb.dst + (size_t)(n0 + n) * jb.K + k0 + k2) = cvt_pk_bf16(tl[n * 65 + k2] * jb.scale, tl[n * 65 + k2 + 1] * jb.scale); }
        }
    }
}

__device__ __forceinline__ int stage_N(int s) { return (s & 1) ? HID : (s == 2) ? RET_N : (s == 4) ? SWA_N : GLA_N; }
__device__ __forceinline__ int stage_cvoff(int s) { return s == 0 ? 0 : s == 1 ? 3584 : s == 2 ? 7680 : s == 3 ? 13824 : s == 4 ? 17920 : s == 5 ? 19456 : s == 6 ? 23552 : 27136; }
__device__ __forceinline__ const bf16_t* stage_W(const unsigned char* ws, int s) {
    const int layer = s >> 1;
    if (s & 1) return (const bf16_t*)(ws + WS_W1T) + (size_t)layer * HID * D;
    return s == 2 ? (const bf16_t*)(ws + WS_RIN) : s == 4 ? (const bf16_t*)(ws + WS_SIN) : (const bf16_t*)(ws + WS_GIN) + (size_t)(layer / 3) * GLA_N * D;
}
__device__ __forceinline__ void prepb_phase(const Params& p) {
    const int tid = opaque_tid(), lane = tid & 63, wid = tid >> 6, g4 = lane >> 4, r16 = lane & 15;
    const float* mod = (const float*)(p.ws + WS_MOD);
    float* av = (float*)(p.ws + WS_AVEC);
    for (int i = opaque_bid() * NTHREADS + tid; i < 8 * 32 * D; i += opaque_nwg() * NTHREADS) { const int st = i >> 15, sq = (i >> 10) & 31, c = i & 1023, layer = st >> 1;
        const float g = ((st & 1) ? p.in[10] : p.in[9])[layer * D + c];
        av[i] = g * (1.0f + mod[((size_t)layer * 32 + sq) * ADA + ((st & 1) ? 4 : 1) * D + c]); }
    float* cvec = (float*)(p.ws + WS_CVEC);
    for (int it = opaque_bid() * 8 + wid; it < CVEC_TOTAL_N / 16; it += opaque_nwg() * 8) {
        const int ng = it * 16; int st = 0;
#pragma unroll
        for (int q = 1; q < 8; ++q) if (ng >= stage_cvoff(q)) st = q;
        const int n0 = ng - stage_cvoff(st), N = stage_N(st), layer = st >> 1;
        const bf16_t* wp = stage_W(p.ws, st) + (size_t)(n0 + r16) * D + g4 * 8;
        const float* sh0 = mod + ((size_t)layer * 32 + r16) * ADA + ((st & 1) ? 3 : 0) * D + g4 * 8; const float* sh1 = sh0 + (size_t)16 * ADA;
        f32x4 acc0 = (f32x4){0.f, 0.f, 0.f, 0.f}, acc1 = acc0;
#pragma unroll 4
        for (int k = 0; k < D; k += 32) {
            const bf16x8 bw = *(const bf16x8*)(wp + k);
            const f32x4 x0 = *(const f32x4*)(sh0 + k), x1 = *(const f32x4*)(sh0 + k + 4), y0 = *(const f32x4*)(sh1 + k), y1 = *(const f32x4*)(sh1 + k + 4);
            u32x4 a0, a1; a0.x = cvt_pk_bf16(x0[0], x0[1]); a0.y = cvt_pk_bf16(x0[2], x0[3]); a0.z = cvt_pk_bf16(x1[0], x1[1]); a0.w = cvt_pk_bf16(x1[2], x1[3]);
            a1.x = cvt_pk_bf16(y0[0], y0[1]); a1.y = cvt_pk_bf16(y0[2], y0[3]); a1.z = cvt_pk_bf16(y1[0], y1[1]); a1.w = cvt_pk_bf16(y1[2], y1[3]);
            acc0 = MFMA16(bw, __builtin_bit_cast(bf16x8, a0), acc0); acc1 = MFMA16(bw, __builtin_bit_cast(bf16x8, a1), acc1);
        }
        float* cp = cvec + (size_t)32 * stage_cvoff(st) + (size_t)r16 * N + n0 + g4 * 4;
        *(f32x4*)cp = acc0; *(f32x4*)(cp + (size_t)16 * N) = acc1;
    }
    bf16_t* H = (bf16_t*)(p.ws + WS_H); float* rss = (float*)(p.ws + WS_RSS);
    for (int r = opaque_bid() * 8 + wid; r < MT; r += opaque_nwg() * 8) {
        const float* src = r < MP ? p.in[0] + (size_t)r * D : p.in[1] + (size_t)(r - MP) * D;
        const float* mrow = mod + (size_t)seq_of_row(r) * ADA + D;
        float ss = 0.f;
#pragma unroll
        for (int i = 0; i < 4; ++i) { const int c = i * 256 + lane * 4;
            const f32x4 v = *(const f32x4*)(src + c), gv = *(const f32x4*)(p.in[9] + c), sc = *(const f32x4*)(mrow + c);
            ss += v[0] * v[0] + v[1] * v[1] + v[2] * v[2] + v[3] * v[3];
            u32x2 w; w.x = cvt_pk_bf16(v[0] * gv[0] * (1.0f + sc[0]), v[1] * gv[1] * (1.0f + sc[1])); w.y = cvt_pk_bf16(v[2] * gv[2] * (1.0f + sc[2]), v[3] * gv[3] * (1.0f + sc[3]));
            *(u32x2*)(H + (size_t)r * D + c) = w; }
        ss = wave_sum(ss);
        if (r < MP) { if (lane < 16) rss[(size_t)r * 16 + lane] = lane == 0 ? ss : 0.f; } else rss[(size_t)MP * 16 + (size_t)(r - MP) * 64 + lane] = lane == 0 ? ss : 0.f;
    }
}

template <int DK, int DV, bool GLA>
__device__ __forceinline__ void recur_phase(unsigned char* lds, bf16_t* P, int ldp, int qoff, int koff, int voff, int goff, const float* S0s, float* outSp, float* outSs, bool live = true, bf16_t* PO = nullptr, int ldo = 0) {
    constexpr int VS = 64, NVS = DV / VS, NH = 4;
    constexpr int QS = DK + 8, TS = 64 + 8;
    constexpr int CP = DK / 2, NSEG = NTHREADS / CP, RPS = 64 / NSEG, NDT = DK / 128, NKK = DK / 32;
    bf16_t* QD = (bf16_t*)lds;
    bf16_t* KD = QD + 64 * QS;
    bf16_t* KDT = KD + 64 * QS;
    bf16_t* VT = KDT + DK * TS;
    bf16_t* ATT = VT + VS * TS;
    bf16_t* ST = ATT + 64 * TS;
    float* SEG = (float*)(ST + VS * QS);
    float* EBL = SEG + (GLA ? NSEG * DK : 0);
    static_assert((size_t)(64 * QS * 2 + DK * TS + VS * TS + 64 * TS + VS * QS) * 2 + (GLA ? (NSEG + 1) * DK * 4 : 0) <= LDS_BYTES, "recurrence LDS");
    const int tid = opaque_tid(), lane = tid & 63, wid = tid >> 6, g4 = lane >> 4, r16 = lane & 15;
    const int cp = tid % CP, sgm = tid / CP, vcp = tid & 31, vsg = tid >> 5;
    constexpr int NIP = NB * NH * NVS;
    for (int item = opaque_bid(); item < 2 * NIP; item += opaque_nwg()) {
        const bool smp = item >= NIP; const int it = smp ? item - NIP : item;
        const int vs = it % NVS, h = (it / NVS) % NH, b = it / (NVS * NH);
        const int row0 = smp ? MP + b * DSEQ : b * SEQ, nch = smp ? 1 : SEQ / 64, Lc = smp ? DSEQ : 64;
        const float lgam = GLA ? 0.f : __logf(1.0f - exp2f(-5.0f - (float)h));
        f32x4 sacc[NDT][4];
        __syncthreads();
#pragma unroll
        for (int dl = 0; dl < NDT; ++dl)
#pragma unroll
            for (int vt = 0; vt < 4; ++vt) {
                f32x4 s = (f32x4){0.f, 0.f, 0.f, 0.f};
                const int d0 = (wid * NDT + dl) * 16 + g4 * 4, v = vt * 16 + r16;
                if (smp) {
#pragma unroll
                    for (int j = 0; j < 4; ++j) s[j] = S0s[(((size_t)b * NH + h) * DK + d0 + j) * DV + vs * VS + v];
                }
                sacc[dl][vt] = s;
                u32x2 w; w.x = cvt_pk_bf16(s[0], s[1]); w.y = cvt_pk_bf16(s[2], s[3]);
                *(u32x2*)(ST + v * QS + d0) = w;
            }
        unsigned rq[RPS], rk[RPS], rg[RPS], rv[4];
        const bf16_t* Pq = P + qoff + h * DK + 2 * cp; const bf16_t* Pk = P + koff + h * DK + 2 * cp; const bf16_t* Pg = P + goff + h * DK + 2 * cp;
        bf16_t* Pv = P + voff + h * DV + vs * VS;
#define RC_LOAD(c) do { \
        _Pragma("unroll") for (int i = 0; i < RPS; ++i) { const int row = sgm * RPS + i; const size_t go = (size_t)(row0 + (c) * 64 + row) * ldp; const bool ok = row < Lc; \
            rq[i] = ok ? *(const unsigned*)(Pq + go) : 0u; rk[i] = ok ? *(const unsigned*)(Pk + go) : 0u; if (GLA) rg[i] = ok ? *(const unsigned*)(Pg + go) : 0u; } \
        _Pragma("unroll") for (int i = 0; i < 4; ++i) { const int row = vsg * 4 + i; rv[i] = row < Lc ? *(const unsigned*)(Pv + (size_t)(row0 + (c) * 64 + row) * ldp + 2 * vcp) : 0u; } } while (0)
        RC_LOAD(0);
        for (int c = 0; c < nch; ++c) {
            float off0 = 0.f, off1 = 0.f, tot0 = 0.f, tot1 = 0.f;
            float pre0[RPS], pre1[RPS];
            if (GLA) {
                float a0 = 0.f, a1 = 0.f;
#pragma unroll
                for (int i = 0; i < RPS; ++i) { a0 += bf_lo(rg[i]); a1 += bf_hi(rg[i]); pre0[i] = a0; pre1[i] = a1; }
                SEG[sgm * DK + 2 * cp] = a0; SEG[sgm * DK + 2 * cp + 1] = a1;
                __syncthreads();
#pragma unroll
                for (int s = 0; s < NSEG; ++s) { const float t0 = SEG[s * DK + 2 * cp], t1 = SEG[s * DK + 2 * cp + 1]; if (s < sgm) { off0 += t0; off1 += t1; } tot0 += t0; tot1 += t1; }
                if (sgm == 0) { EBL[2 * cp] = __expf(tot0); EBL[2 * cp + 1] = __expf(tot1); }
            }
            {
                float kt0[RPS], kt1[RPS];
#pragma unroll
                for (int i = 0; i < RPS; ++i) { const int row = sgm * RPS + i;
                    const float q0 = bf_lo(rq[i]), q1 = bf_hi(rq[i]), k0 = bf_lo(rk[i]), k1 = bf_hi(rk[i]);
                    if (GLA) {
                        const float b0 = off0 + pre0[i], b1 = off1 + pre1[i];
                        const float e0 = __expf(b0), e1 = __expf(b1);
                        *(unsigned*)(QD + row * QS + 2 * cp) = cvt_pk_bf16(q0 * e0, q1 * e1);
                        *(unsigned*)(KD + row * QS + 2 * cp) = cvt_pk_bf16(k0 * __expf(-b0), k1 * __expf(-b1));
                        kt0[i] = k0 * __expf(tot0 - b0); kt1[i] = k1 * __expf(tot1 - b1);
                    } else {
                        *(unsigned*)(QD + row * QS + 2 * cp) = rq[i];
                        *(unsigned*)(KD + row * QS + 2 * cp) = rk[i];
                        const float dk = __expf(lgam * (float)(Lc - 1 - row));
                        kt0[i] = k0 * dk; kt1[i] = k1 * dk;
                    } }
#pragma unroll
                for (int i = 0; i < RPS; i += 8) {
                    u32x4 w0, w1;
                    w0.x = cvt_pk_bf16(kt0[i], kt0[i + 1]); w0.y = cvt_pk_bf16(kt0[i + 2], kt0[i + 3]); w0.z = cvt_pk_bf16(kt0[i + 4], kt0[i + 5]); w0.w = cvt_pk_bf16(kt0[i + 6], kt0[i + 7]);
                    w1.x = cvt_pk_bf16(kt1[i], kt1[i + 1]); w1.y = cvt_pk_bf16(kt1[i + 2], kt1[i + 3]); w1.z = cvt_pk_bf16(kt1[i + 4], kt1[i + 5]); w1.w = cvt_pk_bf16(kt1[i + 6], kt1[i + 7]);
                    *(u32x4*)(KDT + (2 * cp) * TS + sgm * RPS + i) = w0; *(u32x4*)(KDT + (2 * cp + 1) * TS + sgm * RPS + i) = w1;
                }
                u32x2 v0, v1;
                v0.x = (rv[0] & 0xffffu) | (rv[1] << 16); v0.y = (rv[2] & 0xffffu) | (rv[3] << 16);
                v1.x = (rv[0] >> 16) | (rv[1] & 0xffff0000u); v1.y = (rv[2] >> 16) | (rv[3] & 0xffff0000u);
                *(u32x2*)(VT + (2 * vcp) * TS + vsg * 4) = v0; *(u32x2*)(VT + (2 * vcp + 1) * TS + vsg * 4) = v1;
            }
            __syncthreads();
            if (c + 1 < nch) RC_LOAD(c + 1);
#pragma unroll
            for (int tt = 0; tt < 2; ++tt) { const int t = wid * 2 + tt, lt = t >> 2, st = t & 3;
                f32x4 acc = (f32x4){0.f, 0.f, 0.f, 0.f};
                if (st <= lt) {
#pragma unroll
                    for (int kk = 0; kk < NKK; ++kk) { const bf16x8 a = *(const bf16x8*)(QD + (lt * 16 + r16) * QS + kk * 32 + g4 * 8), bb = *(const bf16x8*)(KD + (st * 16 + r16) * QS + kk * 32 + g4 * 8);
                        acc = MFMA16(bb, a, acc); }
                }
                const int l = lt * 16 + r16, s0 = st * 16 + g4 * 4;
#pragma unroll
                for (int j = 0; j < 4; ++j) { const int s = s0 + j; float v = acc[j]; if (!GLA) v *= __expf(lgam * (float)(l - s)); acc[j] = (s <= l) ? v : 0.f; }
                u32x2 w; w.x = cvt_pk_bf16(acc[0], acc[1]); w.y = cvt_pk_bf16(acc[2], acc[3]);
                *(u32x2*)(ATT + l * TS + s0) = w; }
            __syncthreads();
#pragma unroll
            for (int tt = 0; tt < 2; ++tt) { const int t = wid * 2 + tt, lt = t >> 2, vt = t & 3;
                f32x4 a1 = (f32x4){0.f, 0.f, 0.f, 0.f}, a2 = (f32x4){0.f, 0.f, 0.f, 0.f};
#pragma unroll
                for (int kk = 0; kk < 2; ++kk) { if (kk * 32 <= lt * 16 + 15) { const bf16x8 a = *(const bf16x8*)(ATT + (lt * 16 + r16) * TS + kk * 32 + g4 * 8), bb = *(const bf16x8*)(VT + (vt * 16 + r16) * TS + kk * 32 + g4 * 8);
                        a1 = MFMA16(bb, a, a1); } }
#pragma unroll
                for (int kk = 0; kk < NKK; ++kk) { const bf16x8 a = *(const bf16x8*)(QD + (lt * 16 + r16) * QS + kk * 32 + g4 * 8), bb = *(const bf16x8*)(ST + (vt * 16 + r16) * QS + kk * 32 + g4 * 8);
                    a2 = MFMA16(bb, a, a2); }
                const int l = lt * 16 + r16;
                const float dq = GLA ? 1.0f : __expf(lgam * (float)(l + 1));
                if (l < Lc && live) { u32x2 w; w.x = cvt_pk_bf16(a1[0] + a2[0] * dq, a1[1] + a2[1] * dq); w.y = cvt_pk_bf16(a1[2] + a2[2] * dq, a1[3] + a2[3] * dq);
                    if (PO) *(u32x2*)(PO + (size_t)(row0 + c * 64 + l) * ldo + h * DV + vs * VS + vt * 16 + g4 * 4) = w;
                    else *(u32x2*)(Pv + (size_t)(row0 + c * 64 + l) * ldp + vt * 16 + g4 * 4) = w; } }
            __syncthreads();
#pragma unroll
            for (int dl = 0; dl < NDT; ++dl) { const int dt = wid * NDT + dl;
                f32x4 dec;
                if (GLA) dec = *(const f32x4*)(EBL + dt * 16 + g4 * 4); else { const float dc = __expf(lgam * (float)Lc); dec = (f32x4){dc, dc, dc, dc}; }
                const bf16x8 ka0 = *(const bf16x8*)(KDT + (dt * 16 + r16) * TS + g4 * 8), ka1 = *(const bf16x8*)(KDT + (dt * 16 + r16) * TS + 32 + g4 * 8);
#pragma unroll
                for (int vt = 0; vt < 4; ++vt) {
                    f32x4 acc = sacc[dl][vt] * dec;
                    acc = MFMA16(ka0, *(const bf16x8*)(VT + (vt * 16 + r16) * TS + g4 * 8), acc);
                    acc = MFMA16(ka1, *(const bf16x8*)(VT + (vt * 16 + r16) * TS + 32 + g4 * 8), acc);
                    sacc[dl][vt] = acc;
                    u32x2 w; w.x = cvt_pk_bf16(acc[0], acc[1]); w.y = cvt_pk_bf16(acc[2], acc[3]);
                    *(u32x2*)(ST + (vt * 16 + r16) * QS + dt * 16 + g4 * 4) = w;
                } }
            __syncthreads();
        }
#undef RC_LOAD
        float* So = smp ? outSs : outSp;
#pragma unroll
        for (int dl = 0; dl < NDT; ++dl)
#pragma unroll
            for (int vt = 0; vt < 4; ++vt) { const int d0 = (wid * NDT + dl) * 16 + g4 * 4, v = vt * 16 + r16;
#pragma unroll
                for (int j = 0; j < 4; ++j) if (live) So[(((size_t)b * NH + h) * DK + d0 + j) * DV + vs * VS + v] = sacc[dl][vt][j]; }
    }
}

template <int DV, bool GLA>
__device__ __forceinline__ void post_phase(bf16_t* P, int ldp, int ooff, int goff, const float* normg) {
    constexpr int EPL = DV / 16;
    const int tid = opaque_tid(), lane = tid & 63, wid = tid >> 6;
    for (int r0 = (opaque_bid() * 8 + wid) * 2; r0 < MT; r0 += opaque_nwg() * 16) {
        float o[2][EPL]; u32x4 gw[2][EPL / 8];
#pragma unroll
        for (int rr = 0; rr < 2; ++rr) { const bf16_t* po = P + (size_t)(r0 + rr) * ldp + ooff + lane * EPL; const bf16_t* pg = P + (size_t)(r0 + rr) * ldp + goff + lane * EPL;
#pragma unroll
            for (int i = 0; i < EPL; i += 8) { const u32x4 w = *(const u32x4*)(po + i); gw[rr][i / 8] = *(const u32x4*)(pg + i);
#pragma unroll
                for (int j = 0; j < 4; ++j) { o[rr][i + 2 * j] = bf_lo(w[j]); o[rr][i + 2 * j + 1] = bf_hi(w[j]); } } }
#pragma unroll
        for (int rr = 0; rr < 2; ++rr) {
            float s1 = 0.f, s2 = 0.f;
#pragma unroll
            for (int i = 0; i < EPL; ++i) { s1 += o[rr][i]; s2 += o[rr][i] * o[rr][i]; }
#pragma unroll
            for (int m = 1; m < 16; m <<= 1) { s1 += __shfl_xor(s1, m); s2 += __shfl_xor(s2, m); }
            float mu = 0.f, rs;
            if (GLA) rs = rsqrtf(s2 * (1.0f / DV) + 1e-6f);
            else { mu = s1 * (1.0f / DV); rs = rsqrtf(fmaxf(s2 * (1.0f / DV) - mu * mu, 0.f) + 1e-5f); }
            bf16_t* pg = P + (size_t)(r0 + rr) * ldp + goff + lane * EPL;
#pragma unroll
            for (int i = 0; i < EPL; i += 8) { const u32x4 g = gw[rr][i / 8]; u32x4 w;
#pragma unroll
                for (int j = 0; j < 4; ++j) { float x0 = (o[rr][i + 2 * j] - mu) * rs, x1 = (o[rr][i + 2 * j + 1] - mu) * rs;
                    if (GLA) { const int vc = (lane & 15) * EPL + i + 2 * j; x0 *= normg[vc]; x1 *= normg[vc + 1]; }
                    w[j] = cvt_pk_bf16(x0 * silu_f(bf_lo(g[j])), x1 * silu_f(bf_hi(g[j]))); }
                *(u32x4*)(pg + i) = w; }
        }
    }
}

__device__ __forceinline__ void swa_phase(unsigned char* lds, const Params& p, bf16_t* P, int z) {
    const bool live = true;
    constexpr int KS_S = 72, VT_S = 200, PW_S = 200;
    bf16_t* KS = (bf16_t*)lds;
    bf16_t* VT = KS + 192 * KS_S;
    bf16_t* PW = VT + 64 * VT_S;
    const int tid = opaque_tid(), lane = tid & 63, wid = tid >> 6, g4 = lane >> 4, r16 = lane & 15;
    const float* qn = p.in[30 + z]; const float* kn = p.in[31 + z]; const float* sinks = p.in[32 + z];
    const float* cache_k = p.in[4 + z]; const float* cache_v = p.in[5 + z];
    float* out = p.out + z;
    constexpr int NPI = NB * 64 * 4, NSI = NB * 4;
    {
        const int nwgs = opaque_nwg();
        int item = opaque_bid();
        const int d0 = (tid & 7) * 8;
        const f32x4 kn0 = *(const f32x4*)(kn + d0), kn1 = *(const f32x4*)(kn + d0 + 4);
        u32x4 kw[3], vw[3], qr[2][2];
#define SWA_ISSUE(IT) do { const int kv_ = (IT) & 3, c_ = ((IT) >> 2) & 63, b_ = (IT) >> 8; \
        _Pragma("unroll") for (int i = 0; i < 3; ++i) { const int tok_ = (c_ - 2) * 64 + (tid >> 3) + 64 * i; \
            if (tok_ >= 0) { const bf16_t* pp_ = P + (size_t)(b_ * SEQ + tok_) * SWA_N + kv_ * 64 + d0; kw[i] = *(const u32x4*)(pp_ + 1024); vw[i] = *(const u32x4*)(pp_ + 1280); } \
            else { kw[i] = (u32x4){0u, 0u, 0u, 0u}; vw[i] = (u32x4){0u, 0u, 0u, 0u}; } } \
        _Pragma("unroll") for (int rt = 0; rt < 2; ++rt) { const bf16_t* qp_ = P + (size_t)(b_ * SEQ + c_ * 64 + (wid & 1) * 32 + rt * 16 + r16) * SWA_N + kv_ * 256 + (wid >> 1) * 64 + g4 * 8; \
            qr[rt][0] = *(const u32x4*)qp_; qr[rt][1] = *(const u32x4*)(qp_ + 32); } } while (0)
        if (item < NPI) SWA_ISSUE(item);
        for (; item < NPI; item += nwgs) {
            const int kv = item & 3, c = (item >> 2) & 63, b = item >> 8;
            __syncthreads();
#pragma unroll
            for (int i = 0; i < 3; ++i) { const int s = (tid >> 3) + 64 * i;
                float kf[8], vf[8];
#pragma unroll
                for (int j = 0; j < 4; ++j) { kf[2 * j] = bf_lo(kw[i][j]); kf[2 * j + 1] = bf_hi(kw[i][j]); vf[2 * j] = bf_lo(vw[i][j]); vf[2 * j + 1] = bf_hi(vw[i][j]); }
                float ss = 0.f;
#pragma unroll
                for (int j = 0; j < 8; ++j) ss += kf[j] * kf[j];
                ss += __shfl_xor(ss, 1); ss += __shfl_xor(ss, 2); ss += __shfl_xor(ss, 4);
                const float rs = rsqrtf(ss * (1.0f / 64) + 1e-6f);
#pragma unroll
                for (int j = 0; j < 4; ++j) { kf[j] *= rs * kn0[j]; kf[4 + j] *= rs * kn1[j]; }
                u32x4 w; w.x = cvt_pk_bf16(kf[0], kf[1]); w.y = cvt_pk_bf16(kf[2], kf[3]); w.z = cvt_pk_bf16(kf[4], kf[5]); w.w = cvt_pk_bf16(kf[6], kf[7]);
                *(u32x4*)(KS + s * KS_S + d0) = w;
#pragma unroll
                for (int j = 0; j < 4; ++j) { VT[(d0 + 2 * j) * VT_S + s] = (bf16_t)(vw[i][j] & 0xffffu); VT[(d0 + 2 * j + 1) * VT_S + s] = (bf16_t)(vw[i][j] >> 16); }
                if (c >= 62 && s >= 128) { const int w_ = (c - 62) * 64 + (s - 128);
                    float* ko = out + O_KP + (((size_t)b * 128 + w_) * 4 + kv) * 64 + d0; float* vo = out + O_VP + (((size_t)b * 128 + w_) * 4 + kv) * 64 + d0;
                    *(f32x4*)ko = (f32x4){kf[0], kf[1], kf[2], kf[3]}; *(f32x4*)(ko + 4) = (f32x4){kf[4], kf[5], kf[6], kf[7]};
                    *(f32x4*)vo = (f32x4){vf[0], vf[1], vf[2], vf[3]}; *(f32x4*)(vo + 4) = (f32x4){vf[4], vf[5], vf[6], vf[7]}; }
            }
            const int gq = wid >> 1, hh = kv * 4 + gq;
            bf16x8 qa[2][2];
#pragma unroll
            for (int rt = 0; rt < 2; ++rt) { float qf[2][8]; float ss = 0.f;
#pragma unroll
                for (int kk = 0; kk < 2; ++kk)
#pragma unroll
                    for (int j = 0; j < 4; ++j) { qf[kk][2 * j] = bf_lo(qr[rt][kk][j]); qf[kk][2 * j + 1] = bf_hi(qr[rt][kk][j]); }
#pragma unroll
                for (int kk = 0; kk < 2; ++kk)
#pragma unroll
                    for (int j = 0; j < 8; ++j) ss += qf[kk][j] * qf[kk][j];
                ss += __shfl_xor(ss, 16); ss += __shfl_xor(ss, 32);
                const float rs = rsqrtf(ss * (1.0f / 64) + 1e-6f) * 0.125f;
#pragma unroll
                for (int kk = 0; kk < 2; ++kk) { u32x4 w;
#pragma unroll
                    for (int j = 0; j < 4; ++j) { const int d = kk * 32 + g4 * 8 + 2 * j; w[j] = cvt_pk_bf16(qf[kk][2 * j] * rs * qn[d], qf[kk][2 * j + 1] * rs * qn[d + 1]); }
                    qa[rt][kk] = __builtin_bit_cast(bf16x8, w); } }
            __syncthreads();
            if (item + nwgs < NPI) SWA_ISSUE(item + nwgs);
            const float slope = exp2f(-0.5f * (float)(hh + 1)), sink = sinks[hh];
            bf16_t* pw = PW + wid * 16 * PW_S;
#pragma unroll 1
            for (int rt = 0; rt < 2; ++rt) {
                const int l = (wid & 1) * 32 + rt * 16 + r16;
                bf16_t* qp = P + (size_t)(b * SEQ + c * 64 + l) * SWA_N + kv * 256 + gq * 64;
                const bf16x8 q0 = rt ? qa[1][0] : qa[0][0], q1 = rt ? qa[1][1] : qa[0][1];
                f32x4 sc[12]; float mx = sink;
#pragma unroll
                for (int st = 0; st < 12; ++st) { f32x4 acc = (f32x4){0.f, 0.f, 0.f, 0.f};
                    acc = MFMA16(*(const bf16x8*)(KS + (st * 16 + r16) * KS_S + g4 * 8), q0, acc);
                    acc = MFMA16(*(const bf16x8*)(KS + (st * 16 + r16) * KS_S + 32 + g4 * 8), q1, acc);
#pragma unroll
                    for (int j = 0; j < 4; ++j) { const int s = st * 16 + g4 * 4 + j; const bool kvalid = (c - 2) * 64 + s >= 0;
                        const float v = kvalid ? acc[j] - slope * fabsf((float)(128 + l - s)) : -1e30f; acc[j] = v; mx = fmaxf(mx, v); }
                    sc[st] = acc; }
                mx = fmaxf(mx, __shfl_xor(mx, 16)); mx = fmaxf(mx, __shfl_xor(mx, 32));
                float sum = 0.f;
#pragma unroll
                for (int st = 0; st < 12; ++st)
#pragma unroll
                    for (int j = 0; j < 4; ++j) { const float e = __expf(sc[st][j] - mx); sc[st][j] = e; sum += e; }
                sum += __shfl_xor(sum, 16); sum += __shfl_xor(sum, 32);
                const float inv = 1.0f / (sum + __expf(sink - mx));
#pragma unroll
                for (int st = 0; st < 12; ++st) { u32x2 w; w.x = cvt_pk_bf16(sc[st][0] * inv, sc[st][1] * inv); w.y = cvt_pk_bf16(sc[st][2] * inv, sc[st][3] * inv);
                    *(u32x2*)(pw + r16 * PW_S + st * 16 + g4 * 4) = w; }
                __builtin_amdgcn_fence(__ATOMIC_RELEASE, "wavefront"); __builtin_amdgcn_wave_barrier(); __builtin_amdgcn_fence(__ATOMIC_ACQUIRE, "wavefront");
#pragma unroll
                for (int dt = 0; dt < 4; ++dt) { f32x4 acc = (f32x4){0.f, 0.f, 0.f, 0.f};
#pragma unroll
                    for (int kk = 0; kk < 6; ++kk) acc = MFMA16(*(const bf16x8*)(VT + (dt * 16 + r16) * VT_S + kk * 32 + g4 * 8), *(const bf16x8*)(pw + r16 * PW_S + kk * 32 + g4 * 8), acc);
                    u32x2 w; w.x = cvt_pk_bf16(acc[0], acc[1]); w.y = cvt_pk_bf16(acc[2], acc[3]); *(u32x2*)(qp + dt * 16 + g4 * 4) = w; }
                __builtin_amdgcn_fence(__ATOMIC_RELEASE, "wavefront"); __builtin_amdgcn_wave_barrier(); __builtin_amdgcn_fence(__ATOMIC_ACQUIRE, "wavefront");
            }
        }
#undef SWA_ISSUE
    }
    for (int item = NPI + opaque_bid(); item < NPI + NSI; item += opaque_nwg()) {
        const bool smp = item >= NPI; const int it = smp ? item - NPI : item;
        const int kv = it & 3, c = smp ? 0 : (it >> 2) & 63, b = smp ? it >> 2 : it >> 8;
        const int Lq = smp ? DSEQ : 64;
        __syncthreads();
        const int d0 = (tid & 7) * 8;
        f32x4 kn0 = *(const f32x4*)(kn + d0), kn1 = *(const f32x4*)(kn + d0 + 4);
#pragma unroll
        for (int i = 0; i < 3; ++i) { const int s = (tid >> 3) + 64 * i;
            float kf[8], vf[8]; bool valid, donorm = true; long prow = 0;
            if (!smp) { const int tok = (c - 2) * 64 + s; valid = tok >= 0; prow = (long)b * SEQ + tok; }
            else { valid = s < 128 + DSEQ; donorm = s >= 128; prow = (long)MP + b * DSEQ + (s - 128); }
            if (valid && (!smp || s >= 128)) {
                const u32x4 kw = *(const u32x4*)(P + (size_t)prow * SWA_N + 1024 + kv * 64 + d0), vw = *(const u32x4*)(P + (size_t)prow * SWA_N + 1280 + kv * 64 + d0);
#pragma unroll
                for (int j = 0; j < 4; ++j) { kf[2 * j] = bf_lo(kw[j]); kf[2 * j + 1] = bf_hi(kw[j]); vf[2 * j] = bf_lo(vw[j]); vf[2 * j + 1] = bf_hi(vw[j]); }
            } else if (valid) {
                const float* ck = cache_k + (((size_t)b * 128 + s) * 4 + kv) * 64 + d0; const float* cv = cache_v + (((size_t)b * 128 + s) * 4 + kv) * 64 + d0;
                const f32x4 a0 = *(const f32x4*)ck, a1 = *(const f32x4*)(ck + 4), c0 = *(const f32x4*)cv, c1 = *(const f32x4*)(cv + 4);
#pragma unroll
                for (int j = 0; j < 4; ++j) { kf[j] = a0[j]; kf[4 + j] = a1[j]; vf[j] = c0[j]; vf[4 + j] = c1[j]; }
            } else {
#pragma unroll
                for (int j = 0; j < 8; ++j) { kf[j] = 0.f; vf[j] = 0.f; }
            }
            float ss = 0.f;
#pragma unroll
            for (int j = 0; j < 8; ++j) ss += kf[j] * kf[j];
            ss += __shfl_xor(ss, 1); ss += __shfl_xor(ss, 2); ss += __shfl_xor(ss, 4);
            if (donorm) { const float rs = rsqrtf(ss * (1.0f / 64) + 1e-6f);
#pragma unroll
                for (int j = 0; j < 4; ++j) { kf[j] *= rs * kn0[j]; kf[4 + j] *= rs * kn1[j]; } }
            u32x4 w; w.x = cvt_pk_bf16(kf[0], kf[1]); w.y = cvt_pk_bf16(kf[2], kf[3]); w.z = cvt_pk_bf16(kf[4], kf[5]); w.w = cvt_pk_bf16(kf[6], kf[7]);
            *(u32x4*)(KS + s * KS_S + d0) = w;
#pragma unroll
            for (int j = 0; j < 8; ++j) VT[(d0 + j) * VT_S + s] = (bf16_t)(cvt_pk_bf16(vf[j], 0.f) & 0xffffu);
            float* ko = nullptr; float* vo = nullptr;
            if (!smp && c >= 62 && s >= 128) { const int w_ = (c - 62) * 64 + (s - 128); ko = out + O_KP + (((size_t)b * 128 + w_) * 4 + kv) * 64 + d0; vo = out + O_VP + (((size_t)b * 128 + w_) * 4 + kv) * 64 + d0; }
            if (smp && s >= 128 && s < 128 + DSEQ) { ko = out + O_KS + (((size_t)b * DSEQ + (s - 128)) * 4 + kv) * 64 + d0; vo = out + O_VS + (((size_t)b * DSEQ + (s - 128)) * 4 + kv) * 64 + d0; }
            if (ko && live) { *(f32x4*)ko = (f32x4){kf[0], kf[1], kf[2], kf[3]}; *(f32x4*)(ko + 4) = (f32x4){kf[4], kf[5], kf[6], kf[7]};
                      *(f32x4*)vo = (f32x4){vf[0], vf[1], vf[2], vf[3]}; *(f32x4*)(vo + 4) = (f32x4){vf[4], vf[5], vf[6], vf[7]}; }
        }
        __syncthreads();
        const int gq = wid >> 1, hh = kv * 4 + gq;
        const float slope = exp2f(-0.5f * (float)(hh + 1)), sink = sinks[hh];
        bf16_t* pw = PW + wid * 16 * PW_S;
        for (int rt = 0; rt < 2; ++rt) {
            const int l = (wid & 1) * 32 + rt * 16 + r16;
            if ((wid & 1) * 32 + rt * 16 >= Lq) break;
            const bool lvalid = l < Lq;
            const size_t prow = smp ? (size_t)MP + b * DSEQ + (lvalid ? l : 0) : (size_t)b * SEQ + c * 64 + l;
            bf16_t* qp = P + prow * SWA_N + kv * 256 + gq * 64;
            bf16x8 qa[2];
            {
                float qf[2][8]; float ss = 0.f;
#pragma unroll
                for (int kk = 0; kk < 2; ++kk) { const u32x4 w = *(const u32x4*)(qp + kk * 32 + g4 * 8);
#pragma unroll
                    for (int j = 0; j < 4; ++j) { qf[kk][2 * j] = bf_lo(w[j]); qf[kk][2 * j + 1] = bf_hi(w[j]); } }
#pragma unroll
                for (int kk = 0; kk < 2; ++kk)
#pragma unroll
                    for (int j = 0; j < 8; ++j) ss += qf[kk][j] * qf[kk][j];
                ss += __shfl_xor(ss, 16); ss += __shfl_xor(ss, 32);
                const float rs = rsqrtf(ss * (1.0f / 64) + 1e-6f) * 0.125f;
#pragma unroll
                for (int kk = 0; kk < 2; ++kk) { u32x4 w;
#pragma unroll
                    for (int j = 0; j < 4; ++j) { const int d = kk * 32 + g4 * 8 + 2 * j; w[j] = cvt_pk_bf16(qf[kk][2 * j] * rs * qn[d], qf[kk][2 * j + 1] * rs * qn[d + 1]); }
                    qa[kk] = __builtin_bit_cast(bf16x8, w); }
            }
            f32x4 sc[12]; float mx = sink;
#pragma unroll
            for (int st = 0; st < 12; ++st) { f32x4 acc = (f32x4){0.f, 0.f, 0.f, 0.f};
#pragma unroll
                for (int kk = 0; kk < 2; ++kk) acc = MFMA16(*(const bf16x8*)(KS + (st * 16 + r16) * KS_S + kk * 32 + g4 * 8), qa[kk], acc);
#pragma unroll
                for (int j = 0; j < 4; ++j) { const int s = st * 16 + g4 * 4 + j; const bool kvalid = smp ? (s < 128 + DSEQ) : ((c - 2) * 64 + s >= 0);
                    const float v = kvalid ? acc[j] - slope * fabsf((float)(128 + l - s)) : -1e30f; acc[j] = v; mx = fmaxf(mx, v); }
                sc[st] = acc; }
            mx = fmaxf(mx, __shfl_xor(mx, 16)); mx = fmaxf(mx, __shfl_xor(mx, 32));
            float sum = 0.f;
#pragma unroll
            for (int st = 0; st < 12; ++st)
#pragma unroll
                for (int j = 0; j < 4; ++j) { const float e = __expf(sc[st][j] - mx); sc[st][j] = e; sum += e; }
            sum += __shfl_xor(sum, 16); sum += __shfl_xor(sum, 32);
            const float inv = 1.0f / (sum + __expf(sink - mx));
#pragma unroll
            for (int st = 0; st < 12; ++st) { u32x2 w; w.x = cvt_pk_bf16(sc[st][0] * inv, sc[st][1] * inv); w.y = cvt_pk_bf16(sc[st][2] * inv, sc[st][3] * inv);
                *(u32x2*)(pw + r16 * PW_S + st * 16 + g4 * 4) = w; }
            __builtin_amdgcn_fence(__ATOMIC_RELEASE, "wavefront"); __builtin_amdgcn_wave_barrier(); __builtin_amdgcn_fence(__ATOMIC_ACQUIRE, "wavefront");
#pragma unroll
            for (int dt = 0; dt < 4; ++dt) { f32x4 acc = (f32x4){0.f, 0.f, 0.f, 0.f};
#pragma unroll
                for (int kk = 0; kk < 6; ++kk) acc = MFMA16(*(const bf16x8*)(VT + (dt * 16 + r16) * VT_S + kk * 32 + g4 * 8), *(const bf16x8*)(pw + r16 * PW_S + kk * 32 + g4 * 8), acc);
                if (lvalid && live) { u32x2 w; w.x = cvt_pk_bf16(acc[0], acc[1]); w.y = cvt_pk_bf16(acc[2], acc[3]); *(u32x2*)(qp + dt * 16 + g4 * 4) = w; } }
            __builtin_amdgcn_fence(__ATOMIC_RELEASE, "wavefront"); __builtin_amdgcn_wave_barrier(); __builtin_amdgcn_fence(__ATOMIC_ACQUIRE, "wavefront");
        }
    }
}

#define XB_TMO      128
#define XB_XCNT(j)  (256  + 64 * (j))
#define XB_XSUB(j)  (1280 + 64 * (j))
#define XB_XGEN(j)  (2304 + 64 * (j))
#define XB_TOP      3328
#define XB_TOPGEN   3392
#define XCD_BAR_WORDS 3456
#define XB_SPIN_CAP (1u << 22)
static_assert(XCD_BAR_WORDS * 4 <= WS_BAR_BYTES, "barrier words");
__device__ __forceinline__ unsigned xb_ld(unsigned* p)              { return __hip_atomic_load(p, __ATOMIC_RELAXED, __HIP_MEMORY_SCOPE_AGENT); }
__device__ __forceinline__ unsigned xb_add(unsigned* p, unsigned v) { return __hip_atomic_fetch_add(p, v, __ATOMIC_RELAXED, __HIP_MEMORY_SCOPE_AGENT); }
__device__ __forceinline__ unsigned xb_xcc_id() { return (unsigned)__builtin_amdgcn_s_getreg((3 << 11) | 20) & 0xFu; }
#define XB_SPIN(cond, bar) do { unsigned _sp = 0; while (cond) { __builtin_amdgcn_s_sleep(1); \
    if ((++_sp & 255u) == 0u) { if (xb_ld(&(bar)[XB_TMO])) break; if (_sp > XB_SPIN_CAP) { atomicAdd(&(bar)[XB_TMO], 1u); break; } } } } while (0)
struct XcdBarrier { unsigned* bar; unsigned x; volatile LAS unsigned* st; };
__device__ __forceinline__ XcdBarrier xcd_barrier_post(unsigned* bar, volatile LAS unsigned* st) {
    XcdBarrier b; b.bar = bar; b.x = xb_xcc_id(); b.st = st;
    if (threadIdx.x == 0) (void)xb_add(&bar[XB_XCNT(b.x)], 1u);
    return b;
}
__device__ __forceinline__ void xcd_barrier_complete(unsigned* bar, unsigned x, unsigned& nloc, unsigned& nx) {
    const unsigned G = gridDim.x * gridDim.y * gridDim.z;
    unsigned sum, cnt, mine, sp = 0u;
    for (;;) {
        sum = 0u; cnt = 0u; mine = 0u;
#pragma unroll
        for (unsigned j = 0; j < 16; ++j) { const unsigned c = xb_ld(&bar[XB_XCNT(j)]); sum += c; cnt += (c > 0u) ? 1u : 0u; mine = (j == x) ? c : mine; }
        if (sum == G) break;
        __builtin_amdgcn_s_sleep(1);
        if ((++sp & 255u) == 0u) { if (xb_ld(&bar[XB_TMO])) break; if (sp > XB_SPIN_CAP) { atomicAdd(&bar[XB_TMO], 1u); break; } }
    }
    nloc = mine > 0u ? mine : 1u; nx = cnt > 0u ? cnt : 1u;
}
__device__ __forceinline__ void xcd_barrier(const XcdBarrier& b) {
    asm volatile("s_waitcnt vmcnt(0)" ::: "memory");
    __syncthreads();
    if (opaque_tid() == 0) {
        unsigned* bar = b.bar; asm volatile("" : "+s"(bar));
        __builtin_amdgcn_s_waitcnt(0);
        const unsigned bx = xb_xcc_id();
        unsigned nloc = b.st[0], nx = b.st[1];
        if (nloc == 0u) { xcd_barrier_complete(bar, bx, nloc, nx); b.st[0] = nloc; b.st[1] = nx; }
        const unsigned old = xb_add(&bar[XB_XSUB(bx)], 1u);
        const unsigned gen = old / nloc;
        if (old + 1u == (gen + 1u) * nloc) {
            __builtin_amdgcn_fence(__ATOMIC_RELEASE, "agent");
            asm volatile("s_waitcnt vmcnt(0)" ::: "memory");
            const unsigned og = xb_add(&bar[XB_TOP], 1u);
            const unsigned tg = og / nx;
            if (og + 1u == (tg + 1u) * nx) xb_add(&bar[XB_TOPGEN], 1u);
            else XB_SPIN(xb_ld(&bar[XB_TOPGEN]) == tg, bar);
            __builtin_amdgcn_fence(__ATOMIC_ACQUIRE, "agent");
            xb_add(&bar[XB_XGEN(bx)], 1u);
            asm volatile("s_waitcnt vmcnt(0)" ::: "memory");
        } else {
            XB_SPIN(xb_ld(&bar[XB_XGEN(bx)]) == gen, bar);
            __builtin_amdgcn_fence(__ATOMIC_ACQUIRE, "agent");
            asm volatile("s_waitcnt vmcnt(0)" ::: "memory");
        }
    }
    __syncthreads();
}
__device__ __forceinline__ void gsync_cg(cg::grid_group& g) {
    __builtin_amdgcn_fence(__ATOMIC_RELEASE, "agent");
    asm volatile("s_waitcnt vmcnt(0) lgkmcnt(0)" ::: "memory");
    g.sync();
    __builtin_amdgcn_fence(__ATOMIC_ACQUIRE, "agent");
    asm volatile("s_waitcnt vmcnt(0)" ::: "memory");
}
#define gsync(g) xcd_barrier(xbar)
__global__ void __launch_bounds__(NTHREADS, 2) fwd_megakernel(Params p) {
    extern __shared__ __attribute__((aligned(16))) unsigned char shm[];
    cg::grid_group grid = cg::this_grid();
    LAS unsigned char* shl = (LAS unsigned char*)shm;
    pg8::StaticOrder S;
    volatile LAS unsigned* xst = (volatile LAS unsigned*)(shl + LDS_BYTES - 16);
    if (threadIdx.x == 0) { xst[0] = 0u; xst[1] = 0u; }
    __syncthreads();
    const XcdBarrier xbar = xcd_barrier_post((unsigned*)(p.ws + WS_BAR), xst);

    grid.sync();
    prep_phase(shm, p);
    gsync(grid);
    prepb_phase(p);
    gsync(grid);
#pragma unroll 1
    for (int layer = 0; layer < 4; ++layer) {
        int z = 0; asm volatile("" : "+s"(z));
        unsigned char* ws = p.ws + z; float* yo = p.out + z;
        bf16_t* H = (bf16_t*)(ws + WS_H); bf16_t* P = (bf16_t*)(ws + WS_P);
        const float* mod = (const float*)(ws + WS_MOD);
        float* RS = (float*)(ws + WS_RSS);
        const float* avec = (const float*)(ws + WS_AVEC); const float* cvec = (const float*)(ws + WS_CVEC);
        const int kind = layer % 3, j = layer / 3;
        const float* mod_l = mod + (size_t)layer * 32 * ADA;
        const float* yin_p = layer == 0 ? p.in[0 + z] : yo; const float* yin_s = layer == 0 ? p.in[1 + z] : yo + O_YS;
        const float* cv_mix = cvec + (size_t)32 * stage_cvoff(2 * layer); const float* cv_mlp = cvec + (size_t)32 * stage_cvoff(2 * layer + 1);
        const bf16_t* WoT; int Ko, lda_o; const bf16_t* Ao;
        if (kind == 0) {
            { pg8::Gemm g{H, (const bf16_t*)(ws + WS_GIN) + (size_t)j * GLA_N * D, MP, GLA_N, D, D}; S.init(MP, GLA_N, opaque_nwg(), opaque_bid());
              pg8::EpiBf16 E{P, GLA_N, 0, 3072, p.in[20 + z] + j * 512, RS, cv_mix}; pg8::gemm_phase(shl, g, S, E); pg8::gemm_sample(shm, g, E); }
            gsync(grid);
            recur_phase<GLA_DK, GLA_DV, true>(shm, P, GLA_N, 0, 512, 1024, 3072, layer == 0 ? p.in[2 + z] : p.in[6 + z], yo + (layer == 0 ? O_G0P : O_G3P), yo + (layer == 0 ? O_G0S : O_G3S));
            gsync(grid);
            post_phase<GLA_DV, true>(P, GLA_N, 1024, 2048, p.in[22 + z] + j * GLA_DV);
            WoT = (const bf16_t*)(ws + WS_GO) + (size_t)j * D * D; Ko = D; lda_o = GLA_N; Ao = P + 2048;
        } else if (kind == 1) {
            { pg8::Gemm g{H, (const bf16_t*)(ws + WS_RIN), MP, RET_N, D, D}; S.init(MP, RET_N, opaque_nwg(), opaque_bid());
              pg8::EpiBf16 E{P, RET_N, 0, 1 << 30, nullptr, RS, cv_mix}; pg8::gemm_phase(shl, g, S, E); pg8::gemm_sample(shm, g, E); }
            gsync(grid);
            recur_phase<RET_DK, RET_DV, false>(shm, P, RET_N, 0, 1024, 2048, 0, p.in[3 + z], yo + O_RP, yo + O_RS);
            gsync(grid);
            post_phase<RET_DV, false>(P, RET_N, 2048, 4096, nullptr);
            WoT = (const bf16_t*)(ws + WS_RO); Ko = 2048; lda_o = RET_N; Ao = P + 4096;
        } else {
            { pg8::Gemm g{H, (const bf16_t*)(ws + WS_SIN), MP, SWA_N, D, D}; S.init(MP, SWA_N, opaque_nwg(), opaque_bid());
              pg8::EpiBf16 E{P, SWA_N, 0, 1 << 30, nullptr, RS, cv_mix}; pg8::gemm_phase(shl, g, S, E); pg8::gemm_sample(shm, g, E); }
            gsync(grid);
            swa_phase(shm, p, P, z);
            WoT = (const bf16_t*)(ws + WS_SO); Ko = D; lda_o = SWA_N; Ao = P;
        }
        gsync(grid);
        { pg8::Gemm g{Ao, WoT, MP, D, Ko, lda_o}; S.init(MP, D, opaque_nwg(), opaque_bid());
          pg8::EpiRes E{yin_p, yin_s, yo, mod_l + 2 * D, H, avec + (size_t)(2 * layer + 1) * 32 * D, RS}; pg8::gemm_phase(shl, g, S, E); pg8::gemm_sample(shm, g, E); }
        gsync(grid);
        { pg8::Gemm g{H, (const bf16_t*)(ws + WS_W1T) + (size_t)layer * HID * D, MP, HID, D, D}; S.init(MP, HID, opaque_nwg(), opaque_bid());
          pg8::EpiBf16 E{P, HID, 1, 1 << 30, nullptr, RS, cv_mlp}; pg8::gemm_phase(shl, g, S, E); pg8::gemm_sample(shm, g, E); }
        gsync(grid);
        { pg8::Gemm g{P, (const bf16_t*)(ws + WS_W2T) + (size_t)layer * HID * D, MP, D, HID, HID}; S.init(MP, D, opaque_nwg(), opaque_bid());
          pg8::EpiRes E{yo, yo + O_YS, yo, mod_l + 5 * D, layer < 3 ? H : nullptr, avec + (size_t)(layer < 3 ? 2 * layer + 2 : 0) * 32 * D, RS}; pg8::gemm_phase(shl, g, S, E); pg8::gemm_sample(shm, g, E); }
        gsync(grid);
    }
}

extern "C" void kernel_launch(void* const* d_in, const int* in_sizes, int n_in, void* d_out, int out_size, void* d_ws, size_t ws_size, hipStream_t stream) {
    static int grid_blocks = 0;
    if (grid_blocks == 0) {
        if (n_in != 34 || (size_t)out_size != O_END || ws_size < WS_END) { fprintf(stderr, "kernel_launch: unexpected sizes n_in %d out %d ws %zu (need %zu)\n", n_in, out_size, ws_size, (size_t)WS_END); grid_blocks = -1; return; }
        int dev = 0, cus = 0, per_cu = 0;
        hipGetDevice(&dev);
        hipDeviceGetAttribute(&cus, hipDeviceAttributeMultiprocessorCount, dev);
        if (hipFuncSetAttribute((const void*)fwd_megakernel, hipFuncAttributeMaxDynamicSharedMemorySize, LDS_BYTES) != hipSuccess) { fprintf(stderr, "kernel_launch: hipFuncSetAttribute failed\n"); grid_blocks = -1; return; }
        hipOccupancyMaxActiveBlocksPerMultiprocessor(&per_cu, (const void*)fwd_megakernel, NTHREADS, LDS_BYTES);
        if (per_cu < 1) { fprintf(stderr, "kernel_launch: occupancy query says %d blocks per CU\n", per_cu); grid_blocks = -1; return; }
        grid_blocks = cus * per_cu;
    }
    if (grid_blocks < 0) return;
    Params p{};
    for (int i = 0; i < 34; ++i) p.in[i] = (const float*)d_in[i];
    p.out = (float*)d_out; p.ws = (unsigned char*)d_ws;
    unsigned char* ws = (unsigned char*)d_ws;
    int nj = 0, tiles = 0;
    auto add = [&](const float* src, bf16_t* dst, int K, int N, float scale) { TJob& j = p.jobs[nj++]; j.src = src; j.dst = dst; j.K = K; j.N = N; j.tile0 = tiles; j.scale = scale; tiles += (K / 64) * (N / 128); };
    for (int l = 0; l < 4; ++l) {
        add(p.in[13] + (size_t)l * D * HID, (bf16_t*)(ws + WS_W1T) + (size_t)l * HID * D, D, HID, 1.0f);
        add(p.in[14] + (size_t)l * HID * D, (bf16_t*)(ws + WS_W2T) + (size_t)l * HID * D, HID, D, 1.0f);
    }
    for (int j = 0; j < 2; ++j) {
        bf16_t* gin = (bf16_t*)(ws + WS_GIN) + (size_t)j * GLA_N * D;
        add(p.in[15] + (size_t)j * D * 512, gin, D, 512, 0.08838834764831845f);
        add(p.in[16] + (size_t)j * D * 512, gin + (size_t)512 * D, D, 512, 1.0f);
        add(p.in[17] + (size_t)j * D * D, gin + (size_t)1024 * D, D, D, 1.0f);
        add(p.in[21] + (size_t)j * D * D, gin + (size_t)2048 * D, D, D, 1.0f);
        add(p.in[23] + (size_t)j * D * D, (bf16_t*)(ws + WS_GO) + (size_t)j * D * D, D, D, 1.0f);
    }
    {
        bf16_t* rin = (bf16_t*)(ws + WS_RIN);
        add(p.in[24], rin, D, D, 1.0f);
        add(p.in[25], rin + (size_t)1024 * D, D, D, 0.0625f);
        add(p.in[26], rin + (size_t)2048 * D, D, 2048, 1.0f);
        add(p.in[27], rin + (size_t)4096 * D, D, 2048, 1.0f);
        add(p.in[28], (bf16_t*)(ws + WS_RO), 2048, D, 1.0f);
    }
    add(p.in[29], (bf16_t*)(ws + WS_SIN), D, SWA_N, 1.0f);
    add(p.in[33], (bf16_t*)(ws + WS_SO), D, D, 1.0f);
    p.ntiles = tiles;
    if (hipMemsetAsync(ws + WS_BAR, 0, WS_BAR_BYTES, stream) != hipSuccess) { fprintf(stderr, "kernel_launch: memset of barrier words failed\n"); return; }
    void* args[] = {&p};
    hipError_t e = hipLaunchCooperativeKernel((const void*)fwd_megakernel, dim3(grid_blocks), dim3(NTHREADS), args, LDS_BYTES, stream);
    if (e != hipSuccess) fprintf(stderr, "kernel_launch: cooperative launch failed: %s (grid %d)\n", hipGetErrorString(e), grid_blocks);
}
```

```cpp
#include <hip/hip_runtime.h>
#include <hip/hip_cooperative_groups.h>
#include <cstdio>
#include <cstdint>
namespace cg = cooperative_groups;

#define LAS __attribute__((address_space(3)))
typedef unsigned short bf16_t;
typedef short bf16x8 __attribute__((ext_vector_type(8)));
typedef float f32x4 __attribute__((ext_vector_type(4)));
typedef unsigned u32x4 __attribute__((ext_vector_type(4)));
typedef unsigned u32x2 __attribute__((ext_vector_type(2)));

constexpr int D = 1024, NB = 16, SEQ = 4096, DSEQ = 16, MP = NB * SEQ, MS = NB * DSEQ, MT = MP + MS;
constexpr int HID = 4096, ADA = 6 * D;
constexpr int GLA_H = 4, GLA_DK = 128, GLA_DV = 256, GLA_N = 3584;
constexpr int RET_H = 4, RET_DK = 256, RET_DV = 512, RET_N = 6144;
constexpr int SWA_N = 1536;
constexpr int NTHREADS = 512;
constexpr int LDS_BYTES = 160 * 1024;
constexpr int DBG_LAYER_MASK = 0xF; constexpr bool DBG_MIXER = true, DBG_MLP = true; constexpr int DBG_SKIP = 0; constexpr bool DBG_FRESH_O = false; constexpr int PROBE_DUP_MIXER = 0, PROBE_DUP_GEMM = 0, PROBE_DUP_MOD = 0;

constexpr size_t O_YP = 0, O_YS = O_YP + (size_t)MP * D, O_G0P = O_YS + (size_t)MS * D, O_G0S = O_G0P + (size_t)NB * 4 * 128 * 256,
                 O_RP = O_G0S + (size_t)NB * 4 * 128 * 256, O_RS = O_RP + (size_t)NB * 4 * 256 * 512, O_KP = O_RS + (size_t)NB * 4 * 256 * 512,
                 O_VP = O_KP + (size_t)NB * 128 * 256, O_KS = O_VP + (size_t)NB * 128 * 256, O_VS = O_KS + (size_t)NB * 16 * 256,
                 O_G3P = O_VS + (size_t)NB * 16 * 256, O_G3S = O_G3P + (size_t)NB * 4 * 128 * 256, O_END = O_G3S + (size_t)NB * 4 * 128 * 256;

constexpr size_t WS_W1T = 0;
constexpr size_t WS_W2T = WS_W1T + (size_t)4 * HID * D * 2;
constexpr size_t WS_GIN = WS_W2T + (size_t)4 * HID * D * 2;
constexpr size_t WS_GO  = WS_GIN + (size_t)2 * GLA_N * D * 2;
constexpr size_t WS_RIN = WS_GO + (size_t)2 * D * D * 2;
constexpr size_t WS_RO  = WS_RIN + (size_t)RET_N * D * 2;
constexpr size_t WS_SIN = WS_RO + (size_t)D * 2048 * 2;
constexpr size_t WS_SO  = WS_SIN + (size_t)SWA_N * D * 2;
constexpr size_t WS_MOD = WS_SO + (size_t)D * D * 2;
constexpr size_t WS_H   = WS_MOD + (size_t)4 * 32 * ADA * 4;
constexpr size_t WS_P   = WS_H + (size_t)MT * D * 2;
constexpr size_t WS_AVEC = WS_P + (size_t)MT * RET_N * 2;
constexpr size_t WS_CVEC = WS_AVEC + (size_t)8 * 32 * D * 4;
constexpr int CVEC_TOTAL_N = 2 * GLA_N + RET_N + SWA_N + 4 * HID;
constexpr size_t WS_RSS = WS_CVEC + (size_t)32 * CVEC_TOTAL_N * 4;
constexpr size_t WS_BAR = WS_RSS + (size_t)MP * 16 * 4 + (size_t)MS * 64 * 4;
constexpr size_t WS_BAR_BYTES = 16384;
constexpr size_t WS_END = WS_BAR + WS_BAR_BYTES;

struct TJob { const float* src; bf16_t* dst; int K, N, tile0; float scale; };
constexpr int NJOBS = 25;
struct Params {
    const float* in[34];
    float* out;
    unsigned char* ws;
    TJob jobs[NJOBS];
    int ntiles; int pad0;
};

typedef __bf16 bf16x2_t __attribute__((ext_vector_type(2)));
typedef float f32x2_t __attribute__((ext_vector_type(2)));
__device__ __forceinline__ unsigned cvt_pk_bf16(float lo, float hi) { const f32x2_t v = {lo, hi}; const bf16x2_t r = __builtin_convertvector(v, bf16x2_t); return __builtin_bit_cast(unsigned, r); }
__device__ __forceinline__ float bf_lo(unsigned u) { return __uint_as_float(u << 16); }
__device__ __forceinline__ float bf_hi(unsigned u) { return __uint_as_float(u & 0xffff0000u); }
__device__ __forceinline__ float silu_f(float x) { return x / (1.0f + __expf(-x)); }
__device__ __forceinline__ int seq_of_row(int r) { return r < MP ? (r >> 12) : 16 + ((r - MP) >> 4); }
__device__ __forceinline__ int opaque_tid() { int t = threadIdx.x; asm volatile("" : "+v"(t)); return t; }
__device__ __forceinline__ int opaque_bid() { int t = blockIdx.x; asm volatile("" : "+s"(t)); return t; }
__device__ __forceinline__ int opaque_nwg() { int t = gridDim.x; asm volatile("" : "+s"(t)); return t; }
__device__ __forceinline__ float wave_sum(float v) {
#pragma unroll
    for (int o = 32; o > 0; o >>= 1) v += __shfl_xor(v, o);
    return v;
}

namespace pg8 {
constexpr int BM = 256, BK = 64, HALF = 128, HTB = HALF * BK * 2, STAGE_BYTES = 8 * HTB, NXCD = 8, WGM = 8;
__host__ __device__ __forceinline__ int lds_byte(int r, int c) { const int st = (r >> 4) * 2 + (c >> 5), rr = r & 15, cc = c & 31, ob = rr * 64 + cc * 2; return st * 1024 + (ob ^ (((ob >> 9) & 1) << 5)); }
__host__ __device__ __forceinline__ void stage_rc(int b, int& R, int& C) { const int st = b / 1024, sb = b % 1024, swz = sb ^ (((sb >> 9) & 1) << 5); R = (st >> 1) * 16 + swz / 64; C = (st & 1) * 32 + (swz % 64) / 2; }
__host__ __device__ __forceinline__ int perm32(int rho) { const int n = rho >> 4, i = rho & 15; return 8 * (i >> 2) + 4 * n + (i & 3); }
struct Unit { int pm, pn; };
struct Gemm { const bf16_t* A; const bf16_t* Bt; int M, N, K, lda; };
struct StaticOrder {
    int nM, nN, nwg, G, c;
    __device__ void init(int M, int N, int G_, int c_) { nM = M / BM; nN = N / BM; nwg = nM * nN; G = G_; c = c_; }
    __device__ bool next(int i, Unit& u) const {
        const long L = (long)i * G + c; if (L >= nwg) return false;
        int wgid = (int)L; { const int q = nwg / NXCD, r = nwg % NXCD, xcd = wgid % NXCD, off = wgid / NXCD; wgid = (xcd < r ? xcd * (q + 1) : r * (q + 1) + (xcd - r) * q) + off; }
        const int nig = WGM * nN, gid = wgid / nig, fm = gid * WGM, gsz = (nM - fm) < WGM ? (nM - fm) : WGM;
        u.pm = fm + ((wgid % nig) % gsz); u.pn = (wgid % nig) / gsz; return true;
    }
};

template <class Epi, bool ALIGN_EPI = true, bool SP2 = true>
__device__ __forceinline__ void gemm_phase(LAS unsigned char* lds, const Gemm g, const StaticOrder& S, const Epi& E) {
    const int tid = opaque_tid(), wid = __builtin_amdgcn_readfirstlane(tid >> 6), lane = tid & 63, wr = wid >> 2, wc = wid & 3, fr = lane & 15, fq = lane >> 4;
    const int K = g.K, nt = K / BK, lda = g.lda;
    unsigned voffA[2], voffB[2];
#pragma unroll
    for (int i = 0; i < 2; ++i) { int R, C; stage_rc(tid * 16 + i * 8192, R, C); const int Rb = Epi::PERM ? ((R & ~31) + perm32(R & 31)) : R;
        voffA[i] = (unsigned)(R * lda + C) * 2u; voffB[i] = (unsigned)(Rb * K + C) * 2u; }
    const size_t kstep = (size_t)(BK * 2);
    const size_t hstepA = (size_t)HALF * lda * 2, hstepB = (size_t)HALF * K * 2;
    const size_t tstepA = 2 * hstepA, tstepB = 2 * hstepB;
    const unsigned ldsw = (unsigned)wid * 1024u;
    const int aoff = lds_byte(wr * 64 + fr, fq * 8), boff = lds_byte(wc * 32 + fr, fq * 8);
#define PG8_SA(b, h) (((b) * 2 + (h)) * HTB)
#define PG8_SB(b, h) ((4 + (b) * 2 + (h)) * HTB)
#define PG8_STAGE(bufoff, gbase, voff) do { _Pragma("unroll") for (int _i = 0; _i < 2; ++_i) \
        __builtin_amdgcn_global_load_lds((const unsigned*)((const char*)(gbase) + (voff)[_i]), (LAS unsigned*)(lds + (bufoff) + ldsw + _i * 8192), 16, 0, 0); } while (0)
#define PG8_LDA(dst, b, h) do { _Pragma("unroll") for (int m = 0; m < 4; ++m) _Pragma("unroll") for (int k = 0; k < 2; ++k) dst[m][k] = *(const LAS bf16x8*)(lds + PG8_SA(b, h) + aoff + m * 2048 + k * 1024); } while (0)
#define PG8_LDB(dst, b, h) do { _Pragma("unroll") for (int n = 0; n < 2; ++n) _Pragma("unroll") for (int k = 0; k < 2; ++k) dst[n][k] = *(const LAS bf16x8*)(lds + PG8_SB(b, h) + boff + n * 2048 + k * 1024); } while (0)
#define PG8_MMA(ai, bj, At, Bt) do { __builtin_amdgcn_s_setprio(1); _Pragma("unroll") for (int m = 0; m < 4; ++m) _Pragma("unroll") for (int n = 0; n < 2; ++n) _Pragma("unroll") for (int k = 0; k < 2; ++k) \
        acc[ai][bj][m][n] = __builtin_amdgcn_mfma_f32_16x16x32_bf16(Bt[n][k], At[m][k], acc[ai][bj][m][n], 0, 0, 0); __builtin_amdgcn_s_setprio(0); } while (0)
#define PG8_WAIT_V(n) asm volatile("s_waitcnt vmcnt(" #n ")" ::: "memory")
#define PG8_WAIT_L(n) asm volatile("s_waitcnt lgkmcnt(" #n ")" ::: "memory")
#define PG8_BAR __builtin_amdgcn_s_barrier()
#define PG8_SCHED __builtin_amdgcn_sched_barrier(0)
    Unit cur, nxt; int ui = 0;
    if (!S.next(0, cur)) return;
    f32x4 acc[2][2][4][2];
#pragma unroll
    for (int a = 0; a < 2; ++a)
#pragma unroll
        for (int b = 0; b < 2; ++b)
#pragma unroll
            for (int m = 0; m < 4; ++m)
#pragma unroll
                for (int n = 0; n < 2; ++n) acc[a][b][m][n] = (f32x4){0.f, 0.f, 0.f, 0.f};
    bf16x8 At[4][2], B0[2][2], B1[2][2];
    const char* cA = (const char*)g.A + (size_t)cur.pm * tstepA; const char* cB = (const char*)g.Bt + (size_t)cur.pn * tstepB;
    if constexpr (SP2) {
        PG8_STAGE(PG8_SB(0, 0), cB, voffB); PG8_STAGE(PG8_SB(0, 1), cB + hstepB, voffB); PG8_STAGE(PG8_SA(0, 0), cA, voffA); PG8_STAGE(PG8_SA(0, 1), cA + hstepA, voffA);
        if (wr == 1) PG8_BAR;
        PG8_WAIT_V(2); PG8_BAR;
        PG8_STAGE(PG8_SB(1, 0), cB + kstep, voffB); PG8_STAGE(PG8_SA(1, 0), cA + kstep, voffA); PG8_STAGE(PG8_SB(1, 1), cB + hstepB + kstep, voffB);
        PG8_WAIT_V(6); PG8_BAR;
    } else {
        PG8_STAGE(PG8_SB(0, 0), cB, voffB); PG8_STAGE(PG8_SA(0, 0), cA, voffA); PG8_STAGE(PG8_SB(0, 1), cB + hstepB, voffB); PG8_STAGE(PG8_SA(0, 1), cA + hstepA, voffA);
        if (wr == 1) PG8_BAR;
        PG8_WAIT_V(4); PG8_BAR;
        PG8_STAGE(PG8_SB(1, 0), cB + kstep, voffB); PG8_STAGE(PG8_SA(1, 0), cA + kstep, voffA); PG8_STAGE(PG8_SB(1, 1), cB + hstepB + kstep, voffB);
        PG8_WAIT_V(6); PG8_BAR;
    }
    for (;;) {
        const bool has_next = S.next(ui + 1, nxt);
        const char* nA = has_next ? (const char*)g.A + (size_t)nxt.pm * tstepA : cA; const char* nB = has_next ? (const char*)g.Bt + (size_t)nxt.pn * tstepB : cB;
        for (int t = 0; t < nt; t += 2) {
            const bool last = (t == nt - 2);
            const char* a1 = cA + (size_t)(t + 1) * kstep;
            const char* a2 = last ? nA : cA + (size_t)(t + 2) * kstep; const char* b2 = last ? nB : cB + (size_t)(t + 2) * kstep;
            const char* a3 = a2 + kstep; const char* b3 = b2 + kstep;
            if constexpr (SP2) {
            PG8_LDB(B0, 0, 0); PG8_LDB(B1, 0, 1); PG8_SCHED; PG8_LDA(At, 0, 0); PG8_STAGE(PG8_SA(1, 1), a1 + hstepA, voffA);
            PG8_WAIT_V(8); PG8_WAIT_L(0); PG8_BAR; PG8_MMA(0, 0, At, B0); PG8_MMA(0, 1, At, B1); PG8_BAR; PG8_SCHED;
            PG8_LDA(At, 0, 1); PG8_STAGE(PG8_SB(0, 0), b2, voffB); PG8_STAGE(PG8_SB(0, 1), b2 + hstepB, voffB); PG8_STAGE(PG8_SA(0, 0), a2, voffA);
            PG8_WAIT_V(8); PG8_WAIT_L(0); PG8_BAR; PG8_MMA(1, 0, At, B0); PG8_MMA(1, 1, At, B1); PG8_BAR; PG8_SCHED;
            PG8_LDB(B0, 1, 0); PG8_LDB(B1, 1, 1); PG8_SCHED; PG8_LDA(At, 1, 0); PG8_STAGE(PG8_SA(0, 1), a2 + hstepA, voffA);
            PG8_WAIT_V(8); PG8_WAIT_L(0); PG8_BAR; PG8_MMA(0, 0, At, B0); PG8_MMA(0, 1, At, B1); PG8_BAR; PG8_SCHED;
            PG8_LDA(At, 1, 1); PG8_STAGE(PG8_SB(1, 0), b3, voffB); PG8_STAGE(PG8_SB(1, 1), b3 + hstepB, voffB); PG8_STAGE(PG8_SA(1, 0), a3, voffA);
            PG8_WAIT_V(8); PG8_WAIT_L(0); PG8_BAR; PG8_MMA(1, 0, At, B0); PG8_MMA(1, 1, At, B1); PG8_BAR; PG8_SCHED;
            } else {
            PG8_LDB(B0, 0, 0); PG8_SCHED; PG8_LDA(At, 0, 0); PG8_STAGE(PG8_SA(1, 1), a1 + hstepA, voffA);
            PG8_WAIT_L(8); PG8_BAR; PG8_WAIT_L(0); PG8_MMA(0, 0, At, B0); PG8_BAR; PG8_SCHED;
            PG8_LDB(B1, 0, 1); PG8_STAGE(PG8_SB(0, 0), b2, voffB);
            PG8_BAR; PG8_WAIT_L(0); PG8_MMA(0, 1, At, B1); PG8_BAR;
            PG8_LDA(At, 0, 1); PG8_STAGE(PG8_SA(0, 0), a2, voffA);
            PG8_BAR; PG8_WAIT_L(0); PG8_MMA(1, 0, At, B0); PG8_BAR; PG8_SCHED;
            PG8_STAGE(PG8_SB(0, 1), b2 + hstepB, voffB);
            PG8_WAIT_V(6); PG8_BAR; PG8_MMA(1, 1, At, B1); PG8_BAR;
            PG8_LDB(B0, 1, 0); PG8_SCHED; PG8_LDA(At, 1, 0); PG8_STAGE(PG8_SA(0, 1), a2 + hstepA, voffA);
            PG8_WAIT_L(8); PG8_BAR; PG8_WAIT_L(0); PG8_MMA(0, 0, At, B0); PG8_BAR; PG8_SCHED;
            PG8_LDB(B1, 1, 1); PG8_STAGE(PG8_SB(1, 0), b3, voffB);
            PG8_BAR; PG8_WAIT_L(0); PG8_MMA(0, 1, At, B1); PG8_BAR;
            PG8_LDA(At, 1, 1); PG8_STAGE(PG8_SA(1, 0), a3, voffA);
            PG8_BAR; PG8_WAIT_L(0); PG8_MMA(1, 0, At, B0); PG8_BAR; PG8_SCHED;
            PG8_STAGE(PG8_SB(1, 1), b3 + hstepB, voffB);
            PG8_WAIT_V(6); PG8_BAR; PG8_MMA(1, 1, At, B1); PG8_BAR;
            }
        }
        if constexpr (ALIGN_EPI) { if (wr == 0) PG8_BAR; }
        E(acc, cur, wr, wc, fr, fq);
        if (!has_next) break;
#pragma unroll
        for (int a = 0; a < 2; ++a)
#pragma unroll
            for (int b = 0; b < 2; ++b)
#pragma unroll
                for (int m = 0; m < 4; ++m)
#pragma unroll
                    for (int n = 0; n < 2; ++n) acc[a][b][m][n] = (f32x4){0.f, 0.f, 0.f, 0.f};
        cur = nxt; cA = nA; cB = nB; ++ui;
        if constexpr (ALIGN_EPI) { if (wr == 1) PG8_BAR; }
    }
    PG8_WAIT_V(0);
    if constexpr (!ALIGN_EPI) { if (wr == 0) PG8_BAR; }
    PG8_BAR;
#undef PG8_SA
#undef PG8_SB
#undef PG8_STAGE
#undef PG8_LDA
#undef PG8_LDB
#undef PG8_MMA
#undef PG8_WAIT_V
#undef PG8_WAIT_L
#undef PG8_BAR
#undef PG8_SCHED
}

__device__ __forceinline__ float row_rs(const float* rss, int r) {
    float t;
    if (r < MP) { const f32x4* q = (const f32x4*)(rss + (size_t)r * 16); const f32x4 a = q[0] + q[1] + q[2] + q[3]; t = (a[0] + a[1]) + (a[2] + a[3]); }
    else { const f32x4* q = (const f32x4*)(rss + (size_t)MP * 16 + (size_t)(r - MP) * 64); f32x4 a = q[0];
#pragma unroll
        for (int i = 1; i < 16; ++i) a += q[i];
        t = (a[0] + a[1]) + (a[2] + a[3]); }
    return rsqrtf(t * (1.0f / D) + 1e-6f);
}
__device__ __forceinline__ float logsig16(float x) { return (fminf(x, 0.f) - __logf(1.0f + __expf(-fabsf(x)))) * (1.0f / 16.0f); }
struct EpiBf16 {
    static constexpr bool PERM = true;
    bf16_t* O; int ldc; int mode; int gate_lo; const float* bias; const float* rowss; const float* cvec;
    __device__ __forceinline__ void tile4(int r, int c, f32x4 v) const {
        const float rs = row_rs(rowss, r);
        v = v * rs + *(const f32x4*)(cvec + (size_t)seq_of_row(r) * ldc + c);
        if (mode == 1) {
#pragma unroll
            for (int j = 0; j < 4; ++j) { const float a = fmaxf(v[j], 0.f); v[j] = a * a; } }
        if (c >= gate_lo) { const f32x4 b = *(const f32x4*)(bias + (c - gate_lo));
#pragma unroll
            for (int j = 0; j < 4; ++j) v[j] = logsig16(v[j] + b[j]); }
        u32x2 w; w.x = cvt_pk_bf16(v[0], v[1]); w.y = cvt_pk_bf16(v[2], v[3]);
        *(u32x2*)(O + (size_t)r * ldc + c) = w;
    }
    __device__ __forceinline__ void operator()(const f32x4 (&acc)[2][2][4][2], const Unit& u, int wr, int wc, int fr, int fq) const {
        const int row0 = u.pm * BM + wr * 64 + fr, colt = u.pn * BM, col0 = colt + wc * 32 + 8 * fq;
        const bool gate = colt >= gate_lo;
        const float* cvp = cvec + (size_t)seq_of_row(u.pm * BM) * ldc + col0;
        f32x4 bv[2][2];
#pragma unroll
        for (int bj = 0; bj < 2; ++bj)
#pragma unroll
            for (int n = 0; n < 2; ++n) { bv[bj][n] = *(const f32x4*)(cvp + bj * HALF + 4 * n); if (gate) bv[bj][n] += *(const f32x4*)(bias + (col0 - gate_lo) + bj * HALF + 4 * n); }
#pragma unroll
        for (int ai = 0; ai < 2; ++ai) {
            f32x4 q[4][4];
#pragma unroll
            for (int m = 0; m < 4; ++m) { const f32x4* qp = (const f32x4*)(rowss + (size_t)(row0 + ai * HALF + m * 16) * 16);
#pragma unroll
                for (int i = 0; i < 4; ++i) q[m][i] = qp[i]; }
#pragma unroll
            for (int m = 0; m < 4; ++m) { const int r = row0 + ai * HALF + m * 16; bf16_t* rowp = O + (size_t)r * ldc + col0;
                const f32x4 qs = (q[m][0] + q[m][1]) + (q[m][2] + q[m][3]);
                const float rs = rsqrtf(((qs[0] + qs[1]) + (qs[2] + qs[3])) * (1.0f / D) + 1e-6f);
#pragma unroll
                for (int bj = 0; bj < 2; ++bj) { f32x4 v0 = acc[ai][bj][m][0] * rs + bv[bj][0], v1 = acc[ai][bj][m][1] * rs + bv[bj][1];
                    if (mode == 1) {
#pragma unroll
                        for (int j = 0; j < 4; ++j) { const float a = fmaxf(v0[j], 0.f), b = fmaxf(v1[j], 0.f); v0[j] = a * a; v1[j] = b * b; } }
                    if (gate) {
#pragma unroll
                        for (int j = 0; j < 4; ++j) { v0[j] = logsig16(v0[j]); v1[j] = logsig16(v1[j]); } }
                    u32x4 w; w.x = cvt_pk_bf16(v0[0], v0[1]); w.y = cvt_pk_bf16(v0[2], v0[3]); w.z = cvt_pk_bf16(v1[0], v1[1]); w.w = cvt_pk_bf16(v1[2], v1[3]);
                    *(u32x4*)(rowp + bj * HALF) = w; } } }
    }
};
struct EpiRes {
    static constexpr bool PERM = false;
    const float* yin_p; const float* yin_s; float* yout; const float* gate;
    bf16_t* Hn; const float* av; float* rowss_next;
    __device__ __forceinline__ void tile4(int r, int c, f32x4 v) const {
        const int sq = seq_of_row(r);
        const f32x4 gv = *(const f32x4*)(gate + (size_t)sq * ADA + c), iv = *(const f32x4*)((r < MP ? yin_p + (size_t)r * D : yin_s + (size_t)(r - MP) * D) + c);
        const f32x4 y = iv + gv * v;
        *(f32x4*)(yout + (size_t)r * D + c) = y;
        if (Hn) {
            const f32x4 a = *(const f32x4*)(av + (size_t)sq * D + c);
            u32x2 w; w.x = cvt_pk_bf16(y[0] * a[0], y[1] * a[1]); w.y = cvt_pk_bf16(y[2] * a[2], y[3] * a[3]);
            *(u32x2*)(Hn + (size_t)r * D + c) = w;
            float ss = y[0] * y[0] + y[1] * y[1] + y[2] * y[2] + y[3] * y[3];
            ss += __shfl_xor(ss, 16); ss += __shfl_xor(ss, 32);
            if ((threadIdx.x & 48) == 0) rowss_next[(size_t)MP * 16 + (size_t)(r - MP) * 64 + (c >> 4)] = ss;
        }
    }
    __device__ __forceinline__ void operator()(const f32x4 (&acc)[2][2][4][2], const Unit& u, int wr, int wc, int fr, int fq) const {
        const int row0 = u.pm * BM + wr * 64 + fr, col0 = u.pn * BM + wc * 32 + 4 * fq;
        const int sq = seq_of_row(u.pm * BM);
        const float* gp = gate + (size_t)sq * ADA + col0;
        f32x4 gv[2][2];
        const float* avp = av + (size_t)sq * D + col0;
#pragma unroll
        for (int bj = 0; bj < 2; ++bj)
#pragma unroll
            for (int n = 0; n < 2; ++n) gv[bj][n] = *(const f32x4*)(gp + bj * HALF + n * 16);
#pragma unroll
        for (int ai = 0; ai < 2; ++ai) {
            f32x4 yv[4][2][2];
#pragma unroll
            for (int m = 0; m < 4; ++m) { const float* ip = yin_p + (size_t)(row0 + ai * HALF + m * 16) * D + col0;
#pragma unroll
                for (int bj = 0; bj < 2; ++bj)
#pragma unroll
                    for (int n = 0; n < 2; ++n) yv[m][bj][n] = *(const f32x4*)(ip + bj * HALF + n * 16); }
#pragma unroll
            for (int m = 0; m < 4; ++m) { const int r = row0 + ai * HALF + m * 16;
                float* op = yout + (size_t)r * D + col0;
                float ss = 0.f;
#pragma unroll
                for (int bj = 0; bj < 2; ++bj)
#pragma unroll
                    for (int n = 0; n < 2; ++n) { const int co = bj * HALF + n * 16;
                        const f32x4 y = yv[m][bj][n] + gv[bj][n] * acc[ai][bj][m][n];
                        *(f32x4*)(op + co) = y;
                        if (Hn) { const f32x4 a = *(const f32x4*)(avp + co);
                            u32x2 w; w.x = cvt_pk_bf16(y[0] * a[0], y[1] * a[1]); w.y = cvt_pk_bf16(y[2] * a[2], y[3] * a[3]);
                            *(u32x2*)(Hn + (size_t)r * D + col0 + co) = w;
                            ss += y[0] * y[0] + y[1] * y[1] + y[2] * y[2] + y[3] * y[3]; } }
                if (Hn) { ss += __shfl_xor(ss, 16); ss += __shfl_xor(ss, 32); if (fq == 0) rowss_next[(size_t)r * 16 + u.pn * 4 + wc] = ss; } } }
    }
};

template <class Epi>
__device__ __forceinline__ void gemm_sample(unsigned char* lds, const Gemm g, const Epi& E) {
    const int tid = opaque_tid(), wid = tid >> 6, lane = tid & 63, g4 = lane >> 4, r16 = lane & 15;
    const int K = g.K, CT = g.N >> 8;
    f32x4* red = (f32x4*)lds;
    for (int v = opaque_bid(); v < 256; v += opaque_nwg()) {
        const int row = MP + (v & 15) * 16 + r16, colbase = (v >> 4) * (g.N >> 4);
        const bf16_t* ap = g.A + (size_t)row * g.lda + g4 * 8;
        if (CT == 4) {
            const int ct = wid & 3, kh = wid >> 2, k0 = kh * (K >> 1), k1 = k0 + (K >> 1);
            const bf16_t* bp = g.Bt + (size_t)(colbase + ct * 16 + r16) * K + g4 * 8;
            f32x4 acc = (f32x4){0.f, 0.f, 0.f, 0.f};
#pragma unroll 8
            for (int k = k0; k < k1; k += 32) acc = __builtin_amdgcn_mfma_f32_16x16x32_bf16(*(const bf16x8*)(bp + k), *(const bf16x8*)(ap + k), acc, 0, 0, 0);
            __syncthreads();
            if (kh == 1) red[ct * 64 + lane] = acc;
            __syncthreads();
            if (kh == 0) { acc += red[ct * 64 + lane]; E.tile4(row, colbase + ct * 16 + g4 * 4, acc); }
        } else {
            const int c0 = wid, c1 = wid + 8, c2 = wid + 16;
            const bool h1 = c1 < CT, h2 = c2 < CT;
            if (c0 < CT) {
                const bf16_t* bp0 = g.Bt + (size_t)(colbase + c0 * 16 + r16) * K + g4 * 8;
                const bf16_t* bp1 = g.Bt + (size_t)(colbase + (h1 ? c1 : c0) * 16 + r16) * K + g4 * 8;
                const bf16_t* bp2 = g.Bt + (size_t)(colbase + (h2 ? c2 : c0) * 16 + r16) * K + g4 * 8;
                f32x4 a0 = (f32x4){0.f, 0.f, 0.f, 0.f}, a1 = a0, a2 = a0;
#pragma unroll 4
                for (int k = 0; k < K; k += 32) { const bf16x8 av = *(const bf16x8*)(ap + k);
                    a0 = __builtin_amdgcn_mfma_f32_16x16x32_bf16(*(const bf16x8*)(bp0 + k), av, a0, 0, 0, 0);
                    a1 = __builtin_amdgcn_mfma_f32_16x16x32_bf16(*(const bf16x8*)(bp1 + k), av, a1, 0, 0, 0);
                    a2 = __builtin_amdgcn_mfma_f32_16x16x32_bf16(*(const bf16x8*)(bp2 + k), av, a2, 0, 0, 0); }
                E.tile4(row, colbase + c0 * 16 + g4 * 4, a0);
                if (h1) E.tile4(row, colbase + c1 * 16 + g4 * 4, a1);
                if (h2) E.tile4(row, colbase + c2 * 16 + g4 * 4, a2);
            }
        }
    }
}
}

#define MFMA16(a, b, c) __builtin_amdgcn_mfma_f32_16x16x32_bf16((a), (b), (c), 0, 0, 0)

__device__ __forceinline__ void prep_phase(unsigned char* lds, const Params& p) {
    const int tid = opaque_tid();
    {
        float* sc = (float*)lds;
        float* red = sc + 32 * 512;
        for (int u = opaque_bid(); u < 4 * 48; u += opaque_nwg()) {
            const int l = u / 48, cb = u % 48, col = cb * 128 + (tid & 127), kq = tid >> 7;
            const float* w = p.in[11] + (size_t)l * D * ADA + col;
            float a[32];
#pragma unroll
            for (int s = 0; s < 32; ++s) a[s] = 0.f;
#pragma unroll 1
            for (int half = 0; half < 2; ++half) {
                __syncthreads();
                for (int i = tid; i < 32 * 512; i += NTHREADS) { const int s = i >> 9, k = half * 512 + (i & 511); const float c = s < 16 ? p.in[7][s * D + k] : p.in[8][(s - 16) * D + k]; sc[i] = silu_f(c); }
                __syncthreads();
#pragma unroll 2
                for (int kl = kq * 128; kl < kq * 128 + 128; kl += 4) {
                    const int k = half * 512 + kl;
                    const float w0 = w[(size_t)k * ADA], w1 = w[(size_t)(k + 1) * ADA], w2 = w[(size_t)(k + 2) * ADA], w3 = w[(size_t)(k + 3) * ADA];
#pragma unroll
                    for (int s = 0; s < 32; ++s) { const f32x4 c4 = *(const f32x4*)(sc + s * 512 + kl); a[s] += c4[0] * w0 + c4[1] * w1 + c4[2] * w2 + c4[3] * w3; }
                }
            }
            if (kq > 0) {
#pragma unroll
                for (int s = 0; s < 32; ++s) red[((kq - 1) * 32 + s) * 128 + (tid & 127)] = a[s];
            }
            __syncthreads();
            if (kq == 0) {
                float* mo = (float*)(p.ws + WS_MOD) + (size_t)l * 32 * ADA + col;
                const float bias = p.in[12][(size_t)l * ADA + col];
#pragma unroll
                for (int s = 0; s < 32; ++s) { const int c = tid & 127; mo[(size_t)s * ADA] = a[s] + red[(0 * 32 + s) * 128 + c] + red[(1 * 32 + s) * 128 + c] + red[(2 * 32 + s) * 128 + c] + bias; }
            }
        }
        __syncthreads();
    }
    {
        const int gt = opaque_bid() * NTHREADS + tid, gn = opaque_nwg() * NTHREADS;
        for (int i = gt; i < 2 * 512 * 512; i += gn) {
            const int k2 = (i & 511) * 2, n = (i >> 9) & 511, j = i >> 18;
            const float* w1 = p.in[18] + (size_t)j * D * 16 + (size_t)k2 * 16; const float* w2 = p.in[19] + (size_t)j * 16 * 512 + n;
            float a0 = 0.f, a1 = 0.f;
#pragma unroll
            for (int r = 0; r < 16; ++r) { const float b = w2[r * 512]; a0 += w1[r] * b; a1 += w1[16 + r] * b; }
            bf16_t* dst = (bf16_t*)(p.ws + WS_GIN) + (size_t)j * GLA_N * D + (size_t)(3072 + n) * D + k2;
            *(unsigned*)dst = cvt_pk_bf16(a0, a1);
        }
    }
    {
        float* tl = (float*)lds;
        for (int t = opaque_bid(); t < p.ntiles; t += opaque_nwg()) {
            int j = 0;
#pragma unroll 1
            for (int q = 1; q < NJOBS; ++q) if (t >= p.jobs[q].tile0) j = q;
            const TJob jb = p.jobs[j];
            const int lt = t - jb.tile0, ntn = jb.N >> 7, k0 = (lt / ntn) << 6, n0 = (lt % ntn) << 7;
            __syncthreads();
#pragma unroll
            for (int i = 0; i < 16; ++i) { const int idx = tid + NTHREADS * i, r = idx >> 7, c = idx & 127; tl[c * 65 + r] = jb.src[(size_t)(k0 + r) * jb.N + n0 + c]; }
            __syncthreads();
#pragma unroll
            for (int i = 0; i < 8; ++i) { const int pi = tid + NTHREADS * i, n = pi >> 5, k2 = (pi & 31) * 2;
                *(unsigned*)(jb.dst + (size_t)(n0 + n) * jb.K + k0 + k2) = cvt_pk_bf16(tl[n * 65 + k2] * jb.scale, tl[n * 65 + k2 + 1] * jb.scale); }
        }
    }
}

__device__ __forceinline__ int stage_N(int s) { return (s & 1) ? HID : (s == 2) ? RET_N : (s == 4) ? SWA_N : GLA_N; }
__device__ __forceinline__ int stage_cvoff(int s) { return s == 0 ? 0 : s == 1 ? 3584 : s == 2 ? 7680 : s == 3 ? 13824 : s == 4 ? 17920 : s == 5 ? 19456 : s == 6 ? 23552 : 27136; }
__device__ __forceinline__ const bf16_t* stage_W(const unsigned char* ws, int s) {
    const int layer = s >> 1;
    if (s & 1) return (const bf16_t*)(ws + WS_W1T) + (size_t)layer * HID * D;
    return s == 2 ? (const bf16_t*)(ws + WS_RIN) : s == 4 ? (const bf16_t*)(ws + WS_SIN) : (const bf16_t*)(ws + WS_GIN) + (size_t)(layer / 3) * GLA_N * D;
}
__device__ __forceinline__ void prepb_phase(const Params& p) {
    const int tid = opaque_tid(), lane = tid & 63, wid = tid >> 6, g4 = lane >> 4, r16 = lane & 15;
    const float* mod = (const float*)(p.ws + WS_MOD);
    float* av = (float*)(p.ws + WS_AVEC);
    for (int i = opaque_bid() * NTHREADS + tid; i < 8 * 32 * D; i += opaque_nwg() * NTHREADS) { const int st = i >> 15, sq = (i >> 10) & 31, c = i & 1023, layer = st >> 1;
        const float g = ((st & 1) ? p.in[10] : p.in[9])[layer * D + c];
        av[i] = g * (1.0f + mod[((size_t)layer * 32 + sq) * ADA + ((st & 1) ? 4 : 1) * D + c]); }
    float* cvec = (float*)(p.ws + WS_CVEC);
    for (int it = opaque_bid() * 8 + wid; it < CVEC_TOTAL_N / 16; it += opaque_nwg() * 8) {
        const int ng = it * 16; int st = 0;
#pragma unroll
        for (int q = 1; q < 8; ++q) if (ng >= stage_cvoff(q)) st = q;
        const int n0 = ng - stage_cvoff(st), N = stage_N(st), layer = st >> 1;
        const bf16_t* wp = stage_W(p.ws, st) + (size_t)(n0 + r16) * D + g4 * 8;
        const float* sh0 = mod + ((size_t)layer * 32 + r16) * ADA + ((st & 1) ? 3 : 0) * D + g4 * 8; const float* sh1 = sh0 + (size_t)16 * ADA;
        f32x4 acc0 = (f32x4){0.f, 0.f, 0.f, 0.f}, acc1 = acc0;
#pragma unroll 4
        for (int k = 0; k < D; k += 32) {
            const bf16x8 bw = *(const bf16x8*)(wp + k);
            const f32x4 x0 = *(const f32x4*)(sh0 + k), x1 = *(const f32x4*)(sh0 + k + 4), y0 = *(const f32x4*)(sh1 + k), y1 = *(const f32x4*)(sh1 + k + 4);
            u32x4 a0, a1; a0.x = cvt_pk_bf16(x0[0], x0[1]); a0.y = cvt_pk_bf16(x0[2], x0[3]); a0.z = cvt_pk_bf16(x1[0], x1[1]); a0.w = cvt_pk_bf16(x1[2], x1[3]);
            a1.x = cvt_pk_bf16(y0[0], y0[1]); a1.y = cvt_pk_bf16(y0[2], y0[3]); a1.z = cvt_pk_bf16(y1[0], y1[1]); a1.w = cvt_pk_bf16(y1[2], y1[3]);
            acc0 = MFMA16(bw, __builtin_bit_cast(bf16x8, a0), acc0); acc1 = MFMA16(bw, __builtin_bit_cast(bf16x8, a1), acc1);
        }
        float* cp = cvec + (size_t)32 * stage_cvoff(st) + (size_t)r16 * N + n0 + g4 * 4;
        *(f32x4*)cp = acc0; *(f32x4*)(cp + (size_t)16 * N) = acc1;
    }
    bf16_t* H = (bf16_t*)(p.ws + WS_H); float* rss = (float*)(p.ws + WS_RSS);
    for (int r = opaque_bid() * 8 + wid; r < MT; r += opaque_nwg() * 8) {
        const float* src = r < MP ? p.in[0] + (size_t)r * D : p.in[1] + (size_t)(r - MP) * D;
        const float* mrow = mod + (size_t)seq_of_row(r) * ADA + D;
        float ss = 0.f;
#pragma unroll
        for (int i = 0; i < 4; ++i) { const int c = i * 256 + lane * 4;
            const f32x4 v = *(const f32x4*)(src + c), gv = *(const f32x4*)(p.in[9] + c), sc = *(const f32x4*)(mrow + c);
            ss += v[0] * v[0] + v[1] * v[1] + v[2] * v[2] + v[3] * v[3];
            u32x2 w; w.x = cvt_pk_bf16(v[0] * gv[0] * (1.0f + sc[0]), v[1] * gv[1] * (1.0f + sc[1])); w.y = cvt_pk_bf16(v[2] * gv[2] * (1.0f + sc[2]), v[3] * gv[3] * (1.0f + sc[3]));
            *(u32x2*)(H + (size_t)r * D + c) = w; }
        ss = wave_sum(ss);
        if (r < MP) { if (lane < 16) rss[(size_t)r * 16 + lane] = lane == 0 ? ss : 0.f; } else rss[(size_t)MP * 16 + (size_t)(r - MP) * 64 + lane] = lane == 0 ? ss : 0.f;
    }
}

template <int DK, int DV, bool GLA>
__device__ __forceinline__ void recur_phase(unsigned char* lds, bf16_t* P, int ldp, int qoff, int koff, int voff, int goff, const float* S0s, float* outSp, float* outSs, bool live = true, bf16_t* PO = nullptr, int ldo = 0) {
    constexpr int VS = 64, NVS = DV / VS, NH = 4;
    constexpr int QS = DK + 8, TS = 64 + 8;
    constexpr int CP = DK / 2, NSEG = NTHREADS / CP, RPS = 64 / NSEG, NDT = DK / 128, NKK = DK / 32;
    bf16_t* QD = (bf16_t*)lds;
    bf16_t* KD = QD + 64 * QS;
    bf16_t* KDT = KD + 64 * QS;
    bf16_t* VT = KDT + DK * TS;
    bf16_t* ATT = VT + VS * TS;
    bf16_t* ST = ATT + 64 * TS;
    float* SEG = (float*)(ST + VS * QS);
    float* EBL = SEG + (GLA ? NSEG * DK : 0);
    static_assert((size_t)(64 * QS * 2 + DK * TS + VS * TS + 64 * TS + VS * QS) * 2 + (GLA ? (NSEG + 1) * DK * 4 : 0) <= LDS_BYTES, "recurrence LDS");
    const int tid = opaque_tid(), lane = tid & 63, wid = tid >> 6, g4 = lane >> 4, r16 = lane & 15;
    const int cp = tid % CP, sgm = tid / CP, vcp = tid & 31, vsg = tid >> 5;
    constexpr int NIP = NB * NH * NVS;
    for (int item = opaque_bid(); item < 2 * NIP; item += opaque_nwg()) {
        const bool smp = item >= NIP; const int it = smp ? item - NIP : item;
        const int vs = it % NVS, h = (it / NVS) % NH, b = it / (NVS * NH);
        const int row0 = smp ? MP + b * DSEQ : b * SEQ, nch = smp ? 1 : SEQ / 64, Lc = smp ? DSEQ : 64;
        const float lgam = GLA ? 0.f : __logf(1.0f - exp2f(-5.0f - (float)h));
        f32x4 sacc[NDT][4];
        __syncthreads();
#pragma unroll
        for (int dl = 0; dl < NDT; ++dl)
#pragma unroll
            for (int vt = 0; vt < 4; ++vt) {
                f32x4 s = (f32x4){0.f, 0.f, 0.f, 0.f};
                const int d0 = (wid * NDT + dl) * 16 + g4 * 4, v = vt * 16 + r16;
                if (smp) {
#pragma unroll
                    for (int j = 0; j < 4; ++j) s[j] = S0s[(((size_t)b * NH + h) * DK + d0 + j) * DV + vs * VS + v];
                }
                sacc[dl][vt] = s;
                u32x2 w; w.x = cvt_pk_bf16(s[0], s[1]); w.y = cvt_pk_bf16(s[2], s[3]);
                *(u32x2*)(ST + v * QS + d0) = w;
            }
        unsigned rq[RPS], rk[RPS], rg[RPS], rv[4];
        const bf16_t* Pq = P + qoff + h * DK + 2 * cp; const bf16_t* Pk = P + koff + h * DK + 2 * cp; const bf16_t* Pg = P + goff + h * DK + 2 * cp;
        bf16_t* Pv = P + voff + h * DV + vs * VS;
#define RC_LOAD(c) do { \
        _Pragma("unroll") for (int i = 0; i < RPS; ++i) { const int row = sgm * RPS + i; const size_t go = (size_t)(row0 + (c) * 64 + row) * ldp; const bool ok = row < Lc; \
            rq[i] = ok ? *(const unsigned*)(Pq + go) : 0u; rk[i] = ok ? *(const unsigned*)(Pk + go) : 0u; if (GLA) rg[i] = ok ? *(const unsigned*)(Pg + go) : 0u; } \
        _Pragma("unroll") for (int i = 0; i < 4; ++i) { const int row = vsg * 4 + i; rv[i] = row < Lc ? *(const unsigned*)(Pv + (size_t)(row0 + (c) * 64 + row) * ldp + 2 * vcp) : 0u; } } while (0)
        RC_LOAD(0);
        for (int c = 0; c < nch; ++c) {
            float off0 = 0.f, off1 = 0.f, tot0 = 0.f, tot1 = 0.f;
            float pre0[RPS], pre1[RPS];
            if (GLA) {
                float a0 = 0.f, a1 = 0.f;
#pragma unroll
                for (int i = 0; i < RPS; ++i) { a0 += bf_lo(rg[i]); a1 += bf_hi(rg[i]); pre0[i] = a0; pre1[i] = a1; }
                SEG[sgm * DK + 2 * cp] = a0; SEG[sgm * DK + 2 * cp + 1] = a1;
                __syncthreads();
#pragma unroll
                for (int s = 0; s < NSEG; ++s) { const float t0 = SEG[s * DK + 2 * cp], t1 = SEG[s * DK + 2 * cp + 1]; if (s < sgm) { off0 += t0; off1 += t1; } tot0 += t0; tot1 += t1; }
                if (sgm == 0) { EBL[2 * cp] = __expf(tot0); EBL[2 * cp + 1] = __expf(tot1); }
            }
            {
                float kt0[RPS], kt1[RPS];
#pragma unroll
                for (int i = 0; i < RPS; ++i) { const int row = sgm * RPS + i;
                    const float q0 = bf_lo(rq[i]), q1 = bf_hi(rq[i]), k0 = bf_lo(rk[i]), k1 = bf_hi(rk[i]);
                    if (GLA) {
                        const float b0 = off0 + pre0[i], b1 = off1 + pre1[i];
                        const float e0 = __expf(b0), e1 = __expf(b1);
                        *(unsigned*)(QD + row * QS + 2 * cp) = cvt_pk_bf16(q0 * e0, q1 * e1);
                        *(unsigned*)(KD + row * QS + 2 * cp) = cvt_pk_bf16(k0 * __expf(-b0), k1 * __expf(-b1));
                        kt0[i] = k0 * __expf(tot0 - b0); kt1[i] = k1 * __expf(tot1 - b1);
                    } else {
                        *(unsigned*)(QD + row * QS + 2 * cp) = rq[i];
                        *(unsigned*)(KD + row * QS + 2 * cp) = rk[i];
                        const float dk = __expf(lgam * (float)(Lc - 1 - row));
                        kt0[i] = k0 * dk; kt1[i] = k1 * dk;
                    } }
#pragma unroll
                for (int i = 0; i < RPS; i += 8) {
                    u32x4 w0, w1;
                    w0.x = cvt_pk_bf16(kt0[i], kt0[i + 1]); w0.y = cvt_pk_bf16(kt0[i + 2], kt0[i + 3]); w0.z = cvt_pk_bf16(kt0[i + 4], kt0[i + 5]); w0.w = cvt_pk_bf16(kt0[i + 6], kt0[i + 7]);
                    w1.x = cvt_pk_bf16(kt1[i], kt1[i + 1]); w1.y = cvt_pk_bf16(kt1[i + 2], kt1[i + 3]); w1.z = cvt_pk_bf16(kt1[i + 4], kt1[i + 5]); w1.w = cvt_pk_bf16(kt1[i + 6], kt1[i + 7]);
                    *(u32x4*)(KDT + (2 * cp) * TS + sgm * RPS + i) = w0; *(u32x4*)(KDT + (2 * cp + 1) * TS + sgm * RPS + i) = w1;
                }
                u32x2 v0, v1;
                v0.x = (rv[0] & 0xffffu) | (rv[1] << 16); v0.y = (rv[2] & 0xffffu) | (rv[3] << 16);
                v1.x = (rv[0] >> 16) | (rv[1] & 0xffff0000u); v1.y = (rv[2] >> 16) | (rv[3] & 0xffff0000u);
                *(u32x2*)(VT + (2 * vcp) * TS + vsg * 4) = v0; *(u32x2*)(VT + (2 * vcp + 1) * TS + vsg * 4) = v1;
            }
            __syncthreads();
            if (c + 1 < nch) RC_LOAD(c + 1);
#pragma unroll
            for (int tt = 0; tt < 2; ++tt) { const int t = wid * 2 + tt, lt = t >> 2, st = t & 3;
                f32x4 acc = (f32x4){0.f, 0.f, 0.f, 0.f};
                if (st <= lt) {
#pragma unroll
                    for (int kk = 0; kk < NKK; ++kk) { const bf16x8 a = *(const bf16x8*)(QD + (lt * 16 + r16) * QS + kk * 32 + g4 * 8), bb = *(const bf16x8*)(KD + (st * 16 + r16) * QS + kk * 32 + g4 * 8);
                        acc = MFMA16(bb, a, acc); }
                }
                const int l = lt * 16 + r16, s0 = st * 16 + g4 * 4;
#pragma unroll
                for (int j = 0; j < 4; ++j) { const int s = s0 + j; float v = acc[j]; if (!GLA) v *= __expf(lgam * (float)(l - s)); acc[j] = (s <= l) ? v : 0.f; }
                u32x2 w; w.x = cvt_pk_bf16(acc[0], acc[1]); w.y = cvt_pk_bf16(acc[2], acc[3]);
                *(u32x2*)(ATT + l * TS + s0) = w; }
            __syncthreads();
#pragma unroll
            for (int tt = 0; tt < 2; ++tt) { const int t = wid * 2 + tt, lt = t >> 2, vt = t & 3;
                f32x4 a1 = (f32x4){0.f, 0.f, 0.f, 0.f}, a2 = (f32x4){0.f, 0.f, 0.f, 0.f};
#pragma unroll
                for (int kk = 0; kk < 2; ++kk) { if (kk * 32 <= lt * 16 + 15) { const bf16x8 a = *(const bf16x8*)(ATT + (lt * 16 + r16) * TS + kk * 32 + g4 * 8), bb = *(const bf16x8*)(VT + (vt * 16 + r16) * TS + kk * 32 + g4 * 8);
                        a1 = MFMA16(bb, a, a1); } }
#pragma unroll
                for (int kk = 0; kk < NKK; ++kk) { const bf16x8 a = *(const bf16x8*)(QD + (lt * 16 + r16) * QS + kk * 32 + g4 * 8), bb = *(const bf16x8*)(ST + (vt * 16 + r16) * QS + kk * 32 + g4 * 8);
                    a2 = MFMA16(bb, a, a2); }
                const int l = lt * 16 + r16;
                const float dq = GLA ? 1.0f : __expf(lgam * (float)(l + 1));
                if (l < Lc && live) { u32x2 w; w.x = cvt_pk_bf16(a1[0] + a2[0] * dq, a1[1] + a2[1] * dq); w.y = cvt_pk_bf16(a1[2] + a2[2] * dq, a1[3] + a2[3] * dq);
                    if (PO) *(u32x2*)(PO + (size_t)(row0 + c * 64 + l) * ldo + h * DV + vs * VS + vt * 16 + g4 * 4) = w;
                    else *(u32x2*)(Pv + (size_t)(row0 + c * 64 + l) * ldp + vt * 16 + g4 * 4) = w; } }
            __syncthreads();
#pragma unroll
            for (int dl = 0; dl < NDT; ++dl) { const int dt = wid * NDT + dl;
                f32x4 dec;
                if (GLA) dec = *(const f32x4*)(EBL + dt * 16 + g4 * 4); else { const float dc = __expf(lgam * (float)Lc); dec = (f32x4){dc, dc, dc, dc}; }
                const bf16x8 ka0 = *(const bf16x8*)(KDT + (dt * 16 + r16) * TS + g4 * 8), ka1 = *(const bf16x8*)(KDT + (dt * 16 + r16) * TS + 32 + g4 * 8);
#pragma unroll
                for (int vt = 0; vt < 4; ++vt) {
                    f32x4 acc = sacc[dl][vt] * dec;
                    acc = MFMA16(ka0, *(const bf16x8*)(VT + (vt * 16 + r16) * TS + g4 * 8), acc);
                    acc = MFMA16(ka1, *(const bf16x8*)(VT + (vt * 16 + r16) * TS + 32 + g4 * 8), acc);
                    sacc[dl][vt] = acc;
                    u32x2 w; w.x = cvt_pk_bf16(acc[0], acc[1]); w.y = cvt_pk_bf16(acc[2], acc[3]);
                    *(u32x2*)(ST + (vt * 16 + r16) * QS + dt * 16 + g4 * 4) = w;
                } }
            __syncthreads();
        }
#undef RC_LOAD
        float* So = smp ? outSs : outSp;
#pragma unroll
        for (int dl = 0; dl < NDT; ++dl)
#pragma unroll
            for (int vt = 0; vt < 4; ++vt) { const int d0 = (wid * NDT + dl) * 16 + g4 * 4, v = vt * 16 + r16;
#pragma unroll
                for (int j = 0; j < 4; ++j) if (live) So[(((size_t)b * NH + h) * DK + d0 + j) * DV + vs * VS + v] = sacc[dl][vt][j]; }
    }
}

template <int DV, bool GLA>
__device__ __forceinline__ void post_phase(bf16_t* P, int ldp, int ooff, int goff, const float* normg) {
    constexpr int EPL = DV / 16;
    const int tid = opaque_tid(), lane = tid & 63, wid = tid >> 6;
    for (int r0 = (opaque_bid() * 8 + wid) * 2; r0 < MT; r0 += opaque_nwg() * 16) {
        float o[2][EPL]; u32x4 gw[2][EPL / 8];
#pragma unroll
        for (int rr = 0; rr < 2; ++rr) { const bf16_t* po = P + (size_t)(r0 + rr) * ldp + ooff + lane * EPL; const bf16_t* pg = P + (size_t)(r0 + rr) * ldp + goff + lane * EPL;
#pragma unroll
            for (int i = 0; i < EPL; i += 8) { const u32x4 w = *(const u32x4*)(po + i); gw[rr][i / 8] = *(const u32x4*)(pg + i);
#pragma unroll
                for (int j = 0; j < 4; ++j) { o[rr][i + 2 * j] = bf_lo(w[j]); o[rr][i + 2 * j + 1] = bf_hi(w[j]); } } }
#pragma unroll
        for (int rr = 0; rr < 2; ++rr) {
            float s1 = 0.f, s2 = 0.f;
#pragma unroll
            for (int i = 0; i < EPL; ++i) { s1 += o[rr][i]; s2 += o[rr][i] * o[rr][i]; }
#pragma unroll
            for (int m = 1; m < 16; m <<= 1) { s1 += __shfl_xor(s1, m); s2 += __shfl_xor(s2, m); }
            float mu = 0.f, rs;
            if (GLA) rs = rsqrtf(s2 * (1.0f / DV) + 1e-6f);
            else { mu = s1 * (1.0f / DV); rs = rsqrtf(fmaxf(s2 * (1.0f / DV) - mu * mu, 0.f) + 1e-5f); }
            bf16_t* pg = P + (size_t)(r0 + rr) * ldp + goff + lane * EPL;
#pragma unroll
            for (int i = 0; i < EPL; i += 8) { const u32x4 g = gw[rr][i / 8]; u32x4 w;
#pragma unroll
                for (int j = 0; j < 4; ++j) { float x0 = (o[rr][i + 2 * j] - mu) * rs, x1 = (o[rr][i + 2 * j + 1] - mu) * rs;
                    if (GLA) { const int vc = (lane & 15) * EPL + i + 2 * j; x0 *= normg[vc]; x1 *= normg[vc + 1]; }
                    w[j] = cvt_pk_bf16(x0 * silu_f(bf_lo(g[j])), x1 * silu_f(bf_hi(g[j]))); }
                *(u32x4*)(pg + i) = w; }
        }
    }
}

__device__ __forceinline__ void swa_phase(unsigned char* lds, const Params& p, bf16_t* P, int z) {
    const bool live = true;
    constexpr int KS_S = 72, VT_S = 200, PW_S = 200;
    bf16_t* KS = (bf16_t*)lds;
    bf16_t* VT = KS + 192 * KS_S;
    bf16_t* PW = VT + 64 * VT_S;
    const int tid = opaque_tid(), lane = tid & 63, wid = tid >> 6, g4 = lane >> 4, r16 = lane & 15;
    const float* qn = p.in[30 + z]; const float* kn = p.in[31 + z]; const float* sinks = p.in[32 + z];
    const float* cache_k = p.in[4 + z]; const float* cache_v = p.in[5 + z];
    float* out = p.out + z;
    constexpr int NPI = NB * 64 * 4, NSI = NB * 4;
    for (int item = opaque_bid(); item < NPI + NSI; item += opaque_nwg()) {
        const bool smp = item >= NPI; const int it = smp ? item - NPI : item;
        const int kv = it & 3, c = smp ? 0 : (it >> 2) & 63, b = smp ? it >> 2 : it >> 8;
        const int Lq = smp ? DSEQ : 64;
        __syncthreads();
        const int d0 = (tid & 7) * 8;
        f32x4 kn0 = *(const f32x4*)(kn + d0), kn1 = *(const f32x4*)(kn + d0 + 4);
#pragma unroll
        for (int i = 0; i < 3; ++i) { const int s = (tid >> 3) + 64 * i;
            float kf[8], vf[8]; bool valid, donorm = true; long prow = 0;
            if (!smp) { const int tok = (c - 2) * 64 + s; valid = tok >= 0; prow = (long)b * SEQ + tok; }
            else { valid = s < 128 + DSEQ; donorm = s >= 128; prow = (long)MP + b * DSEQ + (s - 128); }
            if (valid && (!smp || s >= 128)) {
                const u32x4 kw = *(const u32x4*)(P + (size_t)prow * SWA_N + 1024 + kv * 64 + d0), vw = *(const u32x4*)(P + (size_t)prow * SWA_N + 1280 + kv * 64 + d0);
#pragma unroll
                for (int j = 0; j < 4; ++j) { kf[2 * j] = bf_lo(kw[j]); kf[2 * j + 1] = bf_hi(kw[j]); vf[2 * j] = bf_lo(vw[j]); vf[2 * j + 1] = bf_hi(vw[j]); }
            } else if (valid) {
                const float* ck = cache_k + (((size_t)b * 128 + s) * 4 + kv) * 64 + d0; const float* cv = cache_v + (((size_t)b * 128 + s) * 4 + kv) * 64 + d0;
                const f32x4 a0 = *(const f32x4*)ck, a1 = *(const f32x4*)(ck + 4), c0 = *(const f32x4*)cv, c1 = *(const f32x4*)(cv + 4);
#pragma unroll
                for (int j = 0; j < 4; ++j) { kf[j] = a0[j]; kf[4 + j] = a1[j]; vf[j] = c0[j]; vf[4 + j] = c1[j]; }
            } else {
#pragma unroll
                for (int j = 0; j < 8; ++j) { kf[j] = 0.f; vf[j] = 0.f; }
            }
            float ss = 0.f;
#pragma unroll
            for (int j = 0; j < 8; ++j) ss += kf[j] * kf[j];
            ss += __shfl_xor(ss, 1); ss += __shfl_xor(ss, 2); ss += __shfl_xor(ss, 4);
            if (donorm) { const float rs = rsqrtf(ss * (1.0f / 64) + 1e-6f);
#pragma unroll
                for (int j = 0; j < 4; ++j) { kf[j] *= rs * kn0[j]; kf[4 + j] *= rs * kn1[j]; } }
            u32x4 w; w.x = cvt_pk_bf16(kf[0], kf[1]); w.y = cvt_pk_bf16(kf[2], kf[3]); w.z = cvt_pk_bf16(kf[4], kf[5]); w.w = cvt_pk_bf16(kf[6], kf[7]);
            *(u32x4*)(KS + s * KS_S + d0) = w;
#pragma unroll
            for (int j = 0; j < 8; ++j) VT[(d0 + j) * VT_S + s] = (bf16_t)(cvt_pk_bf16(vf[j], 0.f) & 0xffffu);
            float* ko = nullptr; float* vo = nullptr;
            if (!smp && c >= 62 && s >= 128) { const int w_ = (c - 62) * 64 + (s - 128); ko = out + O_KP + (((size_t)b * 128 + w_) * 4 + kv) * 64 + d0; vo = out + O_VP + (((size_t)b * 128 + w_) * 4 + kv) * 64 + d0; }
            if (smp && s >= 128 && s < 128 + DSEQ) { ko = out + O_KS + (((size_t)b * DSEQ + (s - 128)) * 4 + kv) * 64 + d0; vo = out + O_VS + (((size_t)b * DSEQ + (s - 128)) * 4 + kv) * 64 + d0; }
            if (ko && live) { *(f32x4*)ko = (f32x4){kf[0], kf[1], kf[2], kf[3]}; *(f32x4*)(ko + 4) = (f32x4){kf[4], kf[5], kf[6], kf[7]};
                      *(f32x4*)vo = (f32x4){vf[0], vf[1], vf[2], vf[3]}; *(f32x4*)(vo + 4) = (f32x4){vf[4], vf[5], vf[6], vf[7]}; }
        }
        __syncthreads();
        const int gq = wid >> 1, hh = kv * 4 + gq;
        const float slope = exp2f(-0.5f * (float)(hh + 1)), sink = sinks[hh];
        bf16_t* pw = PW + wid * 16 * PW_S;
        for (int rt = 0; rt < 2; ++rt) {
            const int l = (wid & 1) * 32 + rt * 16 + r16;
            if ((wid & 1) * 32 + rt * 16 >= Lq) break;
            const bool lvalid = l < Lq;
            const size_t prow = smp ? (size_t)MP + b * DSEQ + (lvalid ? l : 0) : (size_t)b * SEQ + c * 64 + l;
            bf16_t* qp = P + prow * SWA_N + kv * 256 + gq * 64;
            bf16x8 qa[2];
            {
                float qf[2][8]; float ss = 0.f;
#pragma unroll
                for (int kk = 0; kk < 2; ++kk) { const u32x4 w = *(const u32x4*)(qp + kk * 32 + g4 * 8);
#pragma unroll
                    for (int j = 0; j < 4; ++j) { qf[kk][2 * j] = bf_lo(w[j]); qf[kk][2 * j + 1] = bf_hi(w[j]); } }
#pragma unroll
                for (int kk = 0; kk < 2; ++kk)
#pragma unroll
                    for (int j = 0; j < 8; ++j) ss += qf[kk][j] * qf[kk][j];
                ss += __shfl_xor(ss, 16); ss += __shfl_xor(ss, 32);
                const float rs = rsqrtf(ss * (1.0f / 64) + 1e-6f) * 0.125f;
#pragma unroll
                for (int kk = 0; kk < 2; ++kk) { u32x4 w;
#pragma unroll
                    for (int j = 0; j < 4; ++j) { const int d = kk * 32 + g4 * 8 + 2 * j; w[j] = cvt_pk_bf16(qf[kk][2 * j] * rs * qn[d], qf[kk][2 * j + 1] * rs * qn[d + 1]); }
                    qa[kk] = __builtin_bit_cast(bf16x8, w); }
            }
            f32x4 sc[12]; float mx = sink;
#pragma unroll
            for (int st = 0; st < 12; ++st) { f32x4 acc = (f32x4){0.f, 0.f, 0.f, 0.f};
#pragma unroll
                for (int kk = 0; kk < 2; ++kk) acc = MFMA16(*(const bf16x8*)(KS + (st * 16 + r16) * KS_S + kk * 32 + g4 * 8), qa[kk], acc);
#pragma unroll
                for (int j = 0; j < 4; ++j) { const int s = st * 16 + g4 * 4 + j; const bool kvalid = smp ? (s < 128 + DSEQ) : ((c - 2) * 64 + s >= 0);
                    const float v = kvalid ? acc[j] - slope * fabsf((float)(128 + l - s)) : -1e30f; acc[j] = v; mx = fmaxf(mx, v); }
                sc[st] = acc; }
            mx = fmaxf(mx, __shfl_xor(mx, 16)); mx = fmaxf(mx, __shfl_xor(mx, 32));
            float sum = 0.f;
#pragma unroll
            for (int st = 0; st < 12; ++st)
#pragma unroll
                for (int j = 0; j < 4; ++j) { const float e = __expf(sc[st][j] - mx); sc[st][j] = e; sum += e; }
            sum += __shfl_xor(sum, 16); sum += __shfl_xor(sum, 32);
            const float inv = 1.0f / (sum + __expf(sink - mx));
#pragma unroll
            for (int st = 0; st < 12; ++st) { u32x2 w; w.x = cvt_pk_bf16(sc[st][0] * inv, sc[st][1] * inv); w.y = cvt_pk_bf16(sc[st][2] * inv, sc[st][3] * inv);
                *(u32x2*)(pw + r16 * PW_S + st * 16 + g4 * 4) = w; }
            __builtin_amdgcn_fence(__ATOMIC_RELEASE, "wavefront"); __builtin_amdgcn_wave_barrier(); __builtin_amdgcn_fence(__ATOMIC_ACQUIRE, "wavefront");
#pragma unroll
            for (int dt = 0; dt < 4; ++dt) { f32x4 acc = (f32x4){0.f, 0.f, 0.f, 0.f};
#pragma unroll
                for (int kk = 0; kk < 6; ++kk) acc = MFMA16(*(const bf16x8*)(VT + (dt * 16 + r16) * VT_S + kk * 32 + g4 * 8), *(const bf16x8*)(pw + r16 * PW_S + kk * 32 + g4 * 8), acc);
                if (lvalid && live) { u32x2 w; w.x = cvt_pk_bf16(acc[0], acc[1]); w.y = cvt_pk_bf16(acc[2], acc[3]); *(u32x2*)(qp + dt * 16 + g4 * 4) = w; } }
            __builtin_amdgcn_fence(__ATOMIC_RELEASE, "wavefront"); __builtin_amdgcn_wave_barrier(); __builtin_amdgcn_fence(__ATOMIC_ACQUIRE, "wavefront");
        }
    }
}

#define XB_TMO      128
#define XB_XCNT(j)  (256  + 64 * (j))
#define XB_XSUB(j)  (1280 + 64 * (j))
#define XB_XGEN(j)  (2304 + 64 * (j))
#define XB_TOP      3328
#define XB_TOPGEN   3392
#define XCD_BAR_WORDS 3456
#define XB_SPIN_CAP (1u << 22)
static_assert(XCD_BAR_WORDS * 4 <= WS_BAR_BYTES, "barrier words");
__device__ __forceinline__ unsigned xb_ld(unsigned* p)              { return __hip_atomic_load(p, __ATOMIC_RELAXED, __HIP_MEMORY_SCOPE_AGENT); }
__device__ __forceinline__ unsigned xb_add(unsigned* p, unsigned v) { return __hip_atomic_fetch_add(p, v, __ATOMIC_RELAXED, __HIP_MEMORY_SCOPE_AGENT); }
__device__ __forceinline__ unsigned xb_xcc_id() { return (unsigned)__builtin_amdgcn_s_getreg((3 << 11) | 20) & 0xFu; }
#define XB_SPIN(cond, bar) do { unsigned _sp = 0; while (cond) { __builtin_amdgcn_s_sleep(1); \
    if ((++_sp & 255u) == 0u) { if (xb_ld(&(bar)[XB_TMO])) break; if (_sp > XB_SPIN_CAP) { atomicAdd(&(bar)[XB_TMO], 1u); break; } } } } while (0)
struct XcdBarrier { unsigned* bar; unsigned x; volatile LAS unsigned* st; };
__device__ __forceinline__ XcdBarrier xcd_barrier_post(unsigned* bar, volatile LAS unsigned* st) {
    XcdBarrier b; b.bar = bar; b.x = xb_xcc_id(); b.st = st;
    if (threadIdx.x == 0) (void)xb_add(&bar[XB_XCNT(b.x)], 1u);
    return b;
}
__device__ __forceinline__ void xcd_barrier_complete(unsigned* bar, unsigned x, unsigned& nloc, unsigned& nx) {
    const unsigned G = gridDim.x * gridDim.y * gridDim.z;
    unsigned sum, cnt, mine, sp = 0u;
    for (;;) {
        sum = 0u; cnt = 0u; mine = 0u;
#pragma unroll
        for (unsigned j = 0; j < 16; ++j) { const unsigned c = xb_ld(&bar[XB_XCNT(j)]); sum += c; cnt += (c > 0u) ? 1u : 0u; mine = (j == x) ? c : mine; }
        if (sum == G) break;
        __builtin_amdgcn_s_sleep(1);
        if ((++sp & 255u) == 0u) { if (xb_ld(&bar[XB_TMO])) break; if (sp > XB_SPIN_CAP) { atomicAdd(&bar[XB_TMO], 1u); break; } }
    }
    nloc = mine > 0u ? mine : 1u; nx = cnt > 0u ? cnt : 1u;
}
__device__ __forceinline__ void xcd_barrier(const XcdBarrier& b) {
    asm volatile("s_waitcnt vmcnt(0)" ::: "memory");
    __syncthreads();
    if (opaque_tid() == 0) {
        unsigned* bar = b.bar; asm volatile("" : "+s"(bar));
        __builtin_amdgcn_s_waitcnt(0);
        const unsigned bx = xb_xcc_id();
        unsigned nloc = b.st[0], nx = b.st[1];
        if (nloc == 0u) { xcd_barrier_complete(bar, bx, nloc, nx); b.st[0] = nloc; b.st[1] = nx; }
        const unsigned old = xb_add(&bar[XB_XSUB(bx)], 1u);
        const unsigned gen = old / nloc;
        if (old + 1u == (gen + 1u) * nloc) {
            __builtin_amdgcn_fence(__ATOMIC_RELEASE, "agent");
            asm volatile("s_waitcnt vmcnt(0)" ::: "memory");
            const unsigned og = xb_add(&bar[XB_TOP], 1u);
            const unsigned tg = og / nx;
            if (og + 1u == (tg + 1u) * nx) xb_add(&bar[XB_TOPGEN], 1u);
            else XB_SPIN(xb_ld(&bar[XB_TOPGEN]) == tg, bar);
            __builtin_amdgcn_fence(__ATOMIC_ACQUIRE, "agent");
            xb_add(&bar[XB_XGEN(bx)], 1u);
            asm volatile("s_waitcnt vmcnt(0)" ::: "memory");
        } else {
            XB_SPIN(xb_ld(&bar[XB_XGEN(bx)]) == gen, bar);
            __builtin_amdgcn_fence(__ATOMIC_ACQUIRE, "agent");
            asm volatile("s_waitcnt vmcnt(0)" ::: "memory");
        }
    }
    __syncthreads();
}
__device__ __forceinline__ void gsync_cg(cg::grid_group& g) {
    __builtin_amdgcn_fence(__ATOMIC_RELEASE, "agent");
    asm volatile("s_waitcnt vmcnt(0) lgkmcnt(0)" ::: "memory");
    g.sync();
    __builtin_amdgcn_fence(__ATOMIC_ACQUIRE, "agent");
    asm volatile("s_waitcnt vmcnt(0)" ::: "memory");
}
#define gsync(g) xcd_barrier(xbar)
__global__ void __launch_bounds__(NTHREADS, 2) fwd_megakernel(Params p) {
    extern __shared__ __attribute__((aligned(16))) unsigned char shm[];
    cg::grid_group grid = cg::this_grid();
    LAS unsigned char* shl = (LAS unsigned char*)shm;
    pg8::StaticOrder S;
    volatile LAS unsigned* xst = (volatile LAS unsigned*)(shl + LDS_BYTES - 16);
    if (threadIdx.x == 0) { xst[0] = 0u; xst[1] = 0u; }
    __syncthreads();
    const XcdBarrier xbar = xcd_barrier_post((unsigned*)(p.ws + WS_BAR), xst);

    grid.sync();
    prep_phase(shm, p);
    gsync(grid);
    prepb_phase(p);
    gsync(grid);
#pragma unroll 1
    for (int layer = 0; layer < 4; ++layer) {
        int z = 0; asm volatile("" : "+s"(z));
        unsigned char* ws = p.ws + z; float* yo = p.out + z;
        bf16_t* H = (bf16_t*)(ws + WS_H); bf16_t* P = (bf16_t*)(ws + WS_P);
        const float* mod = (const float*)(ws + WS_MOD);
        float* RS = (float*)(ws + WS_RSS);
        const float* avec = (const float*)(ws + WS_AVEC); const float* cvec = (const float*)(ws + WS_CVEC);
        const int kind = layer % 3, j = layer / 3;
        const float* mod_l = mod + (size_t)layer * 32 * ADA;
        const float* yin_p = layer == 0 ? p.in[0 + z] : yo; const float* yin_s = layer == 0 ? p.in[1 + z] : yo + O_YS;
        const float* cv_mix = cvec + (size_t)32 * stage_cvoff(2 * layer); const float* cv_mlp = cvec + (size_t)32 * stage_cvoff(2 * layer + 1);
        const bf16_t* WoT; int Ko, lda_o; const bf16_t* Ao;
        if (kind == 0) {
            { pg8::Gemm g{H, (const bf16_t*)(ws + WS_GIN) + (size_t)j * GLA_N * D, MP, GLA_N, D, D}; S.init(MP, GLA_N, opaque_nwg(), opaque_bid());
              pg8::EpiBf16 E{P, GLA_N, 0, 3072, p.in[20 + z] + j * 512, RS, cv_mix}; pg8::gemm_phase(shl, g, S, E); pg8::gemm_sample(shm, g, E); }
            gsync(grid);
            recur_phase<GLA_DK, GLA_DV, true>(shm, P, GLA_N, 0, 512, 1024, 3072, layer == 0 ? p.in[2 + z] : p.in[6 + z], yo + (layer == 0 ? O_G0P : O_G3P), yo + (layer == 0 ? O_G0S : O_G3S));
            gsync(grid);
            post_phase<GLA_DV, true>(P, GLA_N, 1024, 2048, p.in[22 + z] + j * GLA_DV);
            WoT = (const bf16_t*)(ws + WS_GO) + (size_t)j * D * D; Ko = D; lda_o = GLA_N; Ao = P + 2048;
        } else if (kind == 1) {
            { pg8::Gemm g{H, (const bf16_t*)(ws + WS_RIN), MP, RET_N, D, D}; S.init(MP, RET_N, opaque_nwg(), opaque_bid());
              pg8::EpiBf16 E{P, RET_N, 0, 1 << 30, nullptr, RS, cv_mix}; pg8::gemm_phase(shl, g, S, E); pg8::gemm_sample(shm, g, E); }
            gsync(grid);
            recur_phase<RET_DK, RET_DV, false>(shm, P, RET_N, 0, 1024, 2048, 0, p.in[3 + z], yo + O_RP, yo + O_RS);
            gsync(grid);
            post_phase<RET_DV, false>(P, RET_N, 2048, 4096, nullptr);
            WoT = (const bf16_t*)(ws + WS_RO); Ko = 2048; lda_o = RET_N; Ao = P + 4096;
        } else {
            { pg8::Gemm g{H, (const bf16_t*)(ws + WS_SIN), MP, SWA_N, D, D}; S.init(MP, SWA_N, opaque_nwg(), opaque_bid());
              pg8::EpiBf16 E{P, SWA_N, 0, 1 << 30, nullptr, RS, cv_mix}; pg8::gemm_phase(shl, g, S, E); pg8::gemm_sample(shm, g, E); }
            gsync(grid);
            swa_phase(shm, p, P, z);
            WoT = (const bf16_t*)(ws + WS_SO); Ko = D; lda_o = SWA_N; Ao = P;
        }
        gsync(grid);
        { pg8::Gemm g{Ao, WoT, MP, D, Ko, lda_o}; S.init(MP, D, opaque_nwg(), opaque_bid());
          pg8::EpiRes E{yin_p, yin_s, yo, mod_l + 2 * D, H, avec + (size_t)(2 * layer + 1) * 32 * D, RS}; pg8::gemm_phase(shl, g, S, E); pg8::gemm_sample(shm, g, E); }
        gsync(grid);
        { pg8::Gemm g{H, (const bf16_t*)(ws + WS_W1T) + (size_t)layer * HID * D, MP, HID, D, D}; S.init(MP, HID, opaque_nwg(), opaque_bid());
          pg8::EpiBf16 E{P, HID, 1, 1 << 30, nullptr, RS, cv_mlp}; pg8::gemm_phase(shl, g, S, E); pg8::gemm_sample(shm, g, E); }
        gsync(grid);
        { pg8::Gemm g{P, (const bf16_t*)(ws + WS_W2T) + (size_t)layer * HID * D, MP, D, HID, HID}; S.init(MP, D, opaque_nwg(), opaque_bid());
          pg8::EpiRes E{yo, yo + O_YS, yo, mod_l + 5 * D, layer < 3 ? H : nullptr, avec + (size_t)(layer < 3 ? 2 * layer + 2 : 0) * 32 * D, RS}; pg8::gemm_phase(shl, g, S, E); pg8::gemm_sample(shm, g, E); }
        gsync(grid);
    }
}

extern "C" void kernel_launch(void* const* d_in, const int* in_sizes, int n_in, void* d_out, int out_size, void* d_ws, size_t ws_size, hipStream_t stream) {
    static int grid_blocks = 0;
    if (grid_blocks == 0) {
        if (n_in != 34 || (size_t)out_size != O_END || ws_size < WS_END) { fprintf(stderr, "kernel_launch: unexpected sizes n_in %d out %d ws %zu (need %zu)\n", n_in, out_size, ws_size, (size_t)WS_END); grid_blocks = -1; return; }
        int dev = 0, cus = 0, per_cu = 0;
        hipGetDevice(&dev);
        hipDeviceGetAttribute(&cus, hipDeviceAttributeMultiprocessorCount, dev);
        if (hipFuncSetAttribute((const void*)fwd_megakernel, hipFuncAttributeMaxDynamicSharedMemorySize, LDS_BYTES) != hipSuccess) { fprintf(stderr, "kernel_launch: hipFuncSetAttribute failed\n"); grid_blocks = -1; return; }
        hipOccupancyMaxActiveBlocksPerMultiprocessor(&per_cu, (const void*)fwd_megakernel, NTHREADS, LDS_BYTES);
        if (per_cu < 1) { fprintf(stderr, "kernel_launch: occupancy query says %d blocks per CU\n", per_cu); grid_blocks = -1; return; }
        grid_blocks = cus * per_cu;
    }
    if (grid_blocks < 0) return;
    Params p{};
    for (int i = 0; i < 34; ++i) p.in[i] = (const float*)d_in[i];
    p.out = (float*)d_out; p.ws = (unsigned char*)d_ws;
    unsigned char* ws = (unsigned char*)d_ws;
    int nj = 0, tiles = 0;
    auto add = [&](const float* src, bf16_t* dst, int K, int N, float scale) { TJob& j = p.jobs[nj++]; j.src = src; j.dst = dst; j.K = K; j.N = N; j.tile0 = tiles; j.scale = scale; tiles += (K / 64) * (N / 128); };
    for (int l = 0; l < 4; ++l) {
        add(p.in[13] + (size_t)l * D * HID, (bf16_t*)(ws + WS_W1T) + (size_t)l * HID * D, D, HID, 1.0f);
        add(p.in[14] + (size_t)l * HID * D, (bf16_t*)(ws + WS_W2T) + (size_t)l * HID * D, HID, D, 1.0f);
    }
    for (int j = 0; j < 2; ++j) {
        bf16_t* gin = (bf16_t*)(ws + WS_GIN) + (size_t)j * GLA_N * D;
        add(p.in[15] + (size_t)j * D * 512, gin, D, 512, 0.08838834764831845f);
        add(p.in[16] + (size_t)j * D * 512, gin + (size_t)512 * D, D, 512, 1.0f);
        add(p.in[17] + (size_t)j * D * D, gin + (size_t)1024 * D, D, D, 1.0f);
        add(p.in[21] + (size_t)j * D * D, gin + (size_t)2048 * D, D, D, 1.0f);
        add(p.in[23] + (size_t)j * D * D, (bf16_t*)(ws + WS_GO) + (size_t)j * D * D, D, D, 1.0f);
    }
    {
        bf16_t* rin = (bf16_t*)(ws + WS_RIN);
        add(p.in[24], rin, D, D, 1.0f);
        add(p.in[25], rin + (size_t)1024 * D, D, D, 0.0625f);
        add(p.in[26], rin + (size_t)2048 * D, D, 2048, 1.0f);
        add(p.in[27], rin + (size_t)4096 * D, D, 2048, 1.0f);
        add(p.in[28], (bf16_t*)(ws + WS_RO), 2048, D, 1.0f);
    }
    add(p.in[29], (bf16_t*)(ws + WS_SIN), D, SWA_N, 1.0f);
    add(p.in[33], (bf16_t*)(ws + WS_SO), D, D, 1.0f);
    p.ntiles = tiles;
    if (hipMemsetAsync(ws + WS_BAR, 0, WS_BAR_BYTES, stream) != hipSuccess) { fprintf(stderr, "kernel_launch: memset of barrier words failed\n"); return; }
    void* args[] = {&p};
    hipError_t e = hipLaunchCooperativeKernel((const void*)fwd_megakernel, dim3(grid_blocks), dim3(NTHREADS), args, LDS_BYTES, stream);
    if (e != hipSuccess) fprintf(stderr, "kernel_launch: cooperative launch failed: %s (grid %d)\n", hipGetErrorString(e), grid_blocks);
}
```

```cpp
#include <hip/hip_runtime.h>
#include <hip/hip_cooperative_groups.h>
#include <cstdio>
#include <cstdint>
namespace cg = cooperative_groups;

#define LAS __attribute__((address_space(3)))
typedef unsigned short bf16_t;
typedef short bf16x8 __attribute__((ext_vector_type(8)));
typedef float f32x4 __attribute__((ext_vector_type(4)));
typedef unsigned u32x4 __attribute__((ext_vector_type(4)));
typedef unsigned u32x2 __attribute__((ext_vector_type(2)));

constexpr int D = 1024, NB = 16, SEQ = 4096, DSEQ = 16, MP = NB * SEQ, MS = NB * DSEQ, MT = MP + MS;
constexpr int HID = 4096, ADA = 6 * D;
constexpr int GLA_H = 4, GLA_DK = 128, GLA_DV = 256, GLA_N = 3584;
constexpr int RET_H = 4, RET_DK = 256, RET_DV = 512, RET_N = 6144;
constexpr int SWA_N = 1536;
constexpr int NTHREADS = 512;
constexpr int LDS_BYTES = 160 * 1024;
constexpr int DBG_LAYER_MASK = 0xF; constexpr bool DBG_MIXER = true, DBG_MLP = true; constexpr int DBG_SKIP = 0; constexpr bool DBG_FRESH_O = false; constexpr int PROBE_DUP_MIXER = 0, PROBE_DUP_GEMM = 0, PROBE_DUP_MOD = 0;

constexpr size_t O_YP = 0, O_YS = O_YP + (size_t)MP * D, O_G0P = O_YS + (size_t)MS * D, O_G0S = O_G0P + (size_t)NB * 4 * 128 * 256,
                 O_RP = O_G0S + (size_t)NB * 4 * 128 * 256, O_RS = O_RP + (size_t)NB * 4 * 256 * 512, O_KP = O_RS + (size_t)NB * 4 * 256 * 512,
                 O_VP = O_KP + (size_t)NB * 128 * 256, O_KS = O_VP + (size_t)NB * 128 * 256, O_VS = O_KS + (size_t)NB * 16 * 256,
                 O_G3P = O_VS + (size_t)NB * 16 * 256, O_G3S = O_G3P + (size_t)NB * 4 * 128 * 256, O_END = O_G3S + (size_t)NB * 4 * 128 * 256;

constexpr size_t WS_W1T = 0;
constexpr size_t WS_W2T = WS_W1T + (size_t)4 * HID * D * 2;
constexpr size_t WS_GIN = WS_W2T + (size_t)4 * HID * D * 2;
constexpr size_t WS_GO  = WS_GIN + (size_t)2 * GLA_N * D * 2;
constexpr size_t WS_RIN = WS_GO + (size_t)2 * D * D * 2;
constexpr size_t WS_RO  = WS_RIN + (size_t)RET_N * D * 2;
constexpr size_t WS_SIN = WS_RO + (size_t)D * 2048 * 2;
constexpr size_t WS_SO  = WS_SIN + (size_t)SWA_N * D * 2;
constexpr size_t WS_MOD = WS_SO + (size_t)D * D * 2;
constexpr size_t WS_H   = WS_MOD + (size_t)4 * 32 * ADA * 4;
constexpr size_t WS_P   = WS_H + (size_t)MT * D * 2;
constexpr size_t WS_AVEC = WS_P + (size_t)MT * RET_N * 2;
constexpr size_t WS_CVEC = WS_AVEC + (size_t)8 * 32 * D * 4;
constexpr int CVEC_TOTAL_N = 2 * GLA_N + RET_N + SWA_N + 4 * HID;
constexpr size_t WS_RSS = WS_CVEC + (size_t)32 * CVEC_TOTAL_N * 4;
constexpr size_t WS_BAR = WS_RSS + (size_t)MP * 16 * 4 + (size_t)MS * 64 * 4;
constexpr size_t WS_BAR_BYTES = 16384;
constexpr size_t WS_END = WS_BAR + WS_BAR_BYTES;

struct TJob { const float* src; bf16_t* dst; int K, N, tile0; float scale; };
constexpr int NJOBS = 25;
struct Params {
    const float* in[34];
    float* out;
    unsigned char* ws;
    TJob jobs[NJOBS];
    int ntiles; int pad0;
};

typedef __bf16 bf16x2_t __attribute__((ext_vector_type(2)));
typedef float f32x2_t __attribute__((ext_vector_type(2)));
__device__ __forceinline__ unsigned cvt_pk_bf16(float lo, float hi) { const f32x2_t v = {lo, hi}; const bf16x2_t r = __builtin_convertvector(v, bf16x2_t); return __builtin_bit_cast(unsigned, r); }
__device__ __forceinline__ float bf_lo(unsigned u) { return __uint_as_float(u << 16); }
__device__ __forceinline__ float bf_hi(unsigned u) { return __uint_as_float(u & 0xffff0000u); }
__device__ __forceinline__ float silu_f(float x) { return x / (1.0f + __expf(-x)); }
__device__ __forceinline__ int seq_of_row(int r) { return r < MP ? (r >> 12) : 16 + ((r - MP) >> 4); }
__device__ __forceinline__ int opaque_tid() { int t = threadIdx.x; asm volatile("" : "+v"(t)); return t; }
__device__ __forceinline__ int opaque_bid() { int t = blockIdx.x; asm volatile("" : "+s"(t)); return t; }
__device__ __forceinline__ int opaque_nwg() { int t = gridDim.x; asm volatile("" : "+s"(t)); return t; }
__device__ __forceinline__ float wave_sum(float v) {
#pragma unroll
    for (int o = 32; o > 0; o >>= 1) v += __shfl_xor(v, o);
    return v;
}

namespace pg8 {
constexpr int BM = 256, BK = 64, HALF = 128, HTB = HALF * BK * 2, STAGE_BYTES = 8 * HTB, NXCD = 8, WGM = 8;
__host__ __device__ __forceinline__ int lds_byte(int r, int c) { const int st = (r >> 4) * 2 + (c >> 5), rr = r & 15, cc = c & 31, ob = rr * 64 + cc * 2; return st * 1024 + (ob ^ (((ob >> 9) & 1) << 5)); }
__host__ __device__ __forceinline__ void stage_rc(int b, int& R, int& C) { const int st = b / 1024, sb = b % 1024, swz = sb ^ (((sb >> 9) & 1) << 5); R = (st >> 1) * 16 + swz / 64; C = (st & 1) * 32 + (swz % 64) / 2; }
__host__ __device__ __forceinline__ int perm32(int rho) { const int n = rho >> 4, i = rho & 15; return 8 * (i >> 2) + 4 * n + (i & 3); }
struct Unit { int pm, pn; };
struct Gemm { const bf16_t* A; const bf16_t* Bt; int M, N, K, lda; };
struct StaticOrder {
    int nM, nN, nwg, G, c;
    __device__ void init(int M, int N, int G_, int c_) { nM = M / BM; nN = N / BM; nwg = nM * nN; G = G_; c = c_; }
    __device__ bool next(int i, Unit& u) const {
        const long L = (long)i * G + c; if (L >= nwg) return false;
        int wgid = (int)L; { const int q = nwg / NXCD, r = nwg % NXCD, xcd = wgid % NXCD, off = wgid / NXCD; wgid = (xcd < r ? xcd * (q + 1) : r * (q + 1) + (xcd - r) * q) + off; }
        const int nig = WGM * nN, gid = wgid / nig, fm = gid * WGM, gsz = (nM - fm) < WGM ? (nM - fm) : WGM;
        u.pm = fm + ((wgid % nig) % gsz); u.pn = (wgid % nig) / gsz; return true;
    }
};

template <class Epi, bool ALIGN_EPI = true, bool SP2 = true>
__device__ __forceinline__ void gemm_phase(LAS unsigned char* lds, const Gemm g, const StaticOrder& S, const Epi& E) {
    const int tid = opaque_tid(), wid = __builtin_amdgcn_readfirstlane(tid >> 6), lane = tid & 63, wr = wid >> 2, wc = wid & 3, fr = lane & 15, fq = lane >> 4;
    const int K = g.K, nt = K / BK, lda = g.lda;
    unsigned voffA[2], voffB[2];
#pragma unroll
    for (int i = 0; i < 2; ++i) { int R, C; stage_rc(tid * 16 + i * 8192, R, C); const int Rb = Epi::PERM ? ((R & ~31) + perm32(R & 31)) : R;
        voffA[i] = (unsigned)(R * lda + C) * 2u; voffB[i] = (unsigned)(Rb * K + C) * 2u; }
    const size_t kstep = (size_t)(BK * 2);
    const size_t hstepA = (size_t)HALF * lda * 2, hstepB = (size_t)HALF * K * 2;
    const size_t tstepA = 2 * hstepA, tstepB = 2 * hstepB;
    const unsigned ldsw = (unsigned)wid * 1024u;
    const int aoff = lds_byte(wr * 64 + fr, fq * 8), boff = lds_byte(wc * 32 + fr, fq * 8);
#define PG8_SA(b, h) (((b) * 2 + (h)) * HTB)
#define PG8_SB(b, h) ((4 + (b) * 2 + (h)) * HTB)
#define PG8_STAGE(bufoff, gbase, voff) do { _Pragma("unroll") for (int _i = 0; _i < 2; ++_i) \
        __builtin_amdgcn_global_load_lds((const unsigned*)((const char*)(gbase) + (voff)[_i]), (LAS unsigned*)(lds + (bufoff) + ldsw + _i * 8192), 16, 0, 0); } while (0)
#define PG8_LDA(dst, b, h) do { _Pragma("unroll") for (int m = 0; m < 4; ++m) _Pragma("unroll") for (int k = 0; k < 2; ++k) dst[m][k] = *(const LAS bf16x8*)(lds + PG8_SA(b, h) + aoff + m * 2048 + k * 1024); } while (0)
#define PG8_LDB(dst, b, h) do { _Pragma("unroll") for (int n = 0; n < 2; ++n) _Pragma("unroll") for (int k = 0; k < 2; ++k) dst[n][k] = *(const LAS bf16x8*)(lds + PG8_SB(b, h) + boff + n * 2048 + k * 1024); } while (0)
#define PG8_MMA(ai, bj, At, Bt) do { __builtin_amdgcn_s_setprio(1); _Pragma("unroll") for (int m = 0; m < 4; ++m) _Pragma("unroll") for (int n = 0; n < 2; ++n) _Pragma("unroll") for (int k = 0; k < 2; ++k) \
        acc[ai][bj][m][n] = __builtin_amdgcn_mfma_f32_16x16x32_bf16(Bt[n][k], At[m][k], acc[ai][bj][m][n], 0, 0, 0); __builtin_amdgcn_s_setprio(0); } while (0)
#define PG8_WAIT_V(n) asm volatile("s_waitcnt vmcnt(" #n ")" ::: "memory")
#define PG8_WAIT_L(n) asm volatile("s_waitcnt lgkmcnt(" #n ")" ::: "memory")
#define PG8_BAR __builtin_amdgcn_s_barrier()
#define PG8_SCHED __builtin_amdgcn_sched_barrier(0)
    Unit cur, nxt; int ui = 0;
    if (!S.next(0, cur)) return;
    f32x4 acc[2][2][4][2];
#pragma unroll
    for (int a = 0; a < 2; ++a)
#pragma unroll
        for (int b = 0; b < 2; ++b)
#pragma unroll
            for (int m = 0; m < 4; ++m)
#pragma unroll
                for (int n = 0; n < 2; ++n) acc[a][b][m][n] = (f32x4){0.f, 0.f, 0.f, 0.f};
    bf16x8 At[4][2], B0[2][2], B1[2][2];
    const char* cA = (const char*)g.A + (size_t)cur.pm * tstepA; const char* cB = (const char*)g.Bt + (size_t)cur.pn * tstepB;
    if constexpr (SP2) {
        PG8_STAGE(PG8_SB(0, 0), cB, voffB); PG8_STAGE(PG8_SB(0, 1), cB + hstepB, voffB); PG8_STAGE(PG8_SA(0, 0), cA, voffA); PG8_STAGE(PG8_SA(0, 1), cA + hstepA, voffA);
        if (wr == 1) PG8_BAR;
        PG8_WAIT_V(2); PG8_BAR;
        PG8_STAGE(PG8_SB(1, 0), cB + kstep, voffB); PG8_STAGE(PG8_SA(1, 0), cA + kstep, voffA); PG8_STAGE(PG8_SB(1, 1), cB + hstepB + kstep, voffB);
        PG8_WAIT_V(6); PG8_BAR;
    } else {
        PG8_STAGE(PG8_SB(0, 0), cB, voffB); PG8_STAGE(PG8_SA(0, 0), cA, voffA); PG8_STAGE(PG8_SB(0, 1), cB + hstepB, voffB); PG8_STAGE(PG8_SA(0, 1), cA + hstepA, voffA);
        if (wr == 1) PG8_BAR;
        PG8_WAIT_V(4); PG8_BAR;
        PG8_STAGE(PG8_SB(1, 0), cB + kstep, voffB); PG8_STAGE(PG8_SA(1, 0), cA + kstep, voffA); PG8_STAGE(PG8_SB(1, 1), cB + hstepB + kstep, voffB);
        PG8_WAIT_V(6); PG8_BAR;
    }
    for (;;) {
        const bool has_next = S.next(ui + 1, nxt);
        const char* nA = has_next ? (const char*)g.A + (size_t)nxt.pm * tstepA : cA; const char* nB = has_next ? (const char*)g.Bt + (size_t)nxt.pn * tstepB : cB;
        for (int t = 0; t < nt; t += 2) {
            const bool last = (t == nt - 2);
            const char* a1 = cA + (size_t)(t + 1) * kstep;
            const char* a2 = last ? nA : cA + (size_t)(t + 2) * kstep; const char* b2 = last ? nB : cB + (size_t)(t + 2) * kstep;
            const char* a3 = a2 + kstep; const char* b3 = b2 + kstep;
            if constexpr (SP2) {
            PG8_LDB(B0, 0, 0); PG8_LDB(B1, 0, 1); PG8_SCHED; PG8_LDA(At, 0, 0); PG8_STAGE(PG8_SA(1, 1), a1 + hstepA, voffA);
            PG8_WAIT_V(8); PG8_WAIT_L(0); PG8_BAR; PG8_MMA(0, 0, At, B0); PG8_MMA(0, 1, At, B1); PG8_BAR; PG8_SCHED;
            PG8_LDA(At, 0, 1); PG8_STAGE(PG8_SB(0, 0), b2, voffB); PG8_STAGE(PG8_SB(0, 1), b2 + hstepB, voffB); PG8_STAGE(PG8_SA(0, 0), a2, voffA);
            PG8_WAIT_V(8); PG8_WAIT_L(0); PG8_BAR; PG8_MMA(1, 0, At, B0); PG8_MMA(1, 1, At, B1); PG8_BAR; PG8_SCHED;
            PG8_LDB(B0, 1, 0); PG8_LDB(B1, 1, 1); PG8_SCHED; PG8_LDA(At, 1, 0); PG8_STAGE(PG8_SA(0, 1), a2 + hstepA, voffA);
            PG8_WAIT_V(8); PG8_WAIT_L(0); PG8_BAR; PG8_MMA(0, 0, At, B0); PG8_MMA(0, 1, At, B1); PG8_BAR; PG8_SCHED;
            PG8_LDA(At, 1, 1); PG8_STAGE(PG8_SB(1, 0), b3, voffB); PG8_STAGE(PG8_SB(1, 1), b3 + hstepB, voffB); PG8_STAGE(PG8_SA(1, 0), a3, voffA);
            PG8_WAIT_V(8); PG8_WAIT_L(0); PG8_BAR; PG8_MMA(1, 0, At, B0); PG8_MMA(1, 1, At, B1); PG8_BAR; PG8_SCHED;
            } else {
            PG8_LDB(B0, 0, 0); PG8_SCHED; PG8_LDA(At, 0, 0); PG8_STAGE(PG8_SA(1, 1), a1 + hstepA, voffA);
            PG8_WAIT_L(8); PG8_BAR; PG8_WAIT_L(0); PG8_MMA(0, 0, At, B0); PG8_BAR; PG8_SCHED;
            PG8_LDB(B1, 0, 1); PG8_STAGE(PG8_SB(0, 0), b2, voffB);
            PG8_BAR; PG8_WAIT_L(0); PG8_MMA(0, 1, At, B1); PG8_BAR;
            PG8_LDA(At, 0, 1); PG8_STAGE(PG8_SA(0, 0), a2, voffA);
            PG8_BAR; PG8_WAIT_L(0); PG8_MMA(1, 0, At, B0); PG8_BAR; PG8_SCHED;
            PG8_STAGE(PG8_SB(0, 1), b2 + hstepB, voffB);
            PG8_WAIT_V(6); PG8_BAR; PG8_MMA(1, 1, At, B1); PG8_BAR;
            PG8_LDB(B0, 1, 0); PG8_SCHED; PG8_LDA(At, 1, 0); PG8_STAGE(PG8_SA(0, 1), a2 + hstepA, voffA);
            PG8_WAIT_L(8); PG8_BAR; PG8_WAIT_L(0); PG8_MMA(0, 0, At, B0); PG8_BAR; PG8_SCHED;
            PG8_LDB(B1, 1, 1); PG8_STAGE(PG8_SB(1, 0), b3, voffB);
            PG8_BAR; PG8_WAIT_L(0); PG8_MMA(0, 1, At, B1); PG8_BAR;
            PG8_LDA(At, 1, 1); PG8_STAGE(PG8_SA(1, 0), a3, voffA);
            PG8_BAR; PG8_WAIT_L(0); PG8_MMA(1, 0, At, B0); PG8_BAR; PG8_SCHED;
            PG8_STAGE(PG8_SB(1, 1), b3 + hstepB, voffB);
            PG8_WAIT_V(6); PG8_BAR; PG8_MMA(1, 1, At, B1); PG8_BAR;
            }
        }
        if constexpr (ALIGN_EPI) { if (wr == 0) PG8_BAR; }
        E(acc, cur, wr, wc, fr, fq, ui);
        if (!has_next) break;
#pragma unroll
        for (int a = 0; a < 2; ++a)
#pragma unroll
            for (int b = 0; b < 2; ++b)
#pragma unroll
                for (int m = 0; m < 4; ++m)
#pragma unroll
                    for (int n = 0; n < 2; ++n) acc[a][b][m][n] = (f32x4){0.f, 0.f, 0.f, 0.f};
        cur = nxt; cA = nA; cB = nB; ++ui;
        if constexpr (ALIGN_EPI) { if (wr == 1) PG8_BAR; }
    }
    PG8_WAIT_V(0);
    if constexpr (!ALIGN_EPI) { if (wr == 0) PG8_BAR; }
    PG8_BAR;
#undef PG8_SA
#undef PG8_SB
#undef PG8_STAGE
#undef PG8_LDA
#undef PG8_LDB
#undef PG8_MMA
#undef PG8_WAIT_V
#undef PG8_WAIT_L
#undef PG8_BAR
#undef PG8_SCHED
}

__device__ __forceinline__ float row_rs(const float* rss, int r) {
    float t;
    if (r < MP) { const f32x4* q = (const f32x4*)(rss + (size_t)r * 16); const f32x4 a = q[0] + q[1] + q[2] + q[3]; t = (a[0] + a[1]) + (a[2] + a[3]); }
    else { const f32x4* q = (const f32x4*)(rss + (size_t)MP * 16 + (size_t)(r - MP) * 64); f32x4 a = q[0];
#pragma unroll
        for (int i = 1; i < 16; ++i) a += q[i];
        t = (a[0] + a[1]) + (a[2] + a[3]); }
    return rsqrtf(t * (1.0f / D) + 1e-6f);
}
__device__ __forceinline__ float logsig16(float x) { return (fminf(x, 0.f) - __logf(1.0f + __expf(-fabsf(x)))) * (1.0f / 16.0f); }
__device__ __forceinline__ void rs_stage(const StaticOrder& S, const float* rowss, int rbase, LAS float* rsl) {
    const int tid = opaque_tid();
    int nu = 0; { Unit u; while (nu < 24 && S.next(nu, u)) ++nu; }
    __syncthreads();
    for (int idx = tid; idx < nu * 256; idx += NTHREADS) { Unit u; S.next(idx >> 8, u);
        const f32x4* q = (const f32x4*)(rowss + (size_t)(rbase + u.pm * BM + (idx & 255)) * 16);
        const f32x4 a = (q[0] + q[1]) + (q[2] + q[3]);
        rsl[idx] = rsqrtf(((a[0] + a[1]) + (a[2] + a[3])) * (1.0f / D) + 1e-6f); }
    __syncthreads();
}
struct EpiBf16 {
    static constexpr bool PERM = true;
    bf16_t* O; int ldc; int mode; int gate_lo; const float* bias; const float* rowss; const float* cvec;
    const LAS float* rsl;
    __device__ __forceinline__ void tile4(int r, int c, f32x4 v) const {
        const float rs = row_rs(rowss, r);
        v = v * rs + *(const f32x4*)(cvec + (size_t)seq_of_row(r) * ldc + c);
        if (mode == 1) {
#pragma unroll
            for (int j = 0; j < 4; ++j) { const float a = fmaxf(v[j], 0.f); v[j] = a * a; } }
        if (c >= gate_lo) { const f32x4 b = *(const f32x4*)(bias + (c - gate_lo));
#pragma unroll
            for (int j = 0; j < 4; ++j) v[j] = logsig16(v[j] + b[j]); }
        u32x2 w; w.x = cvt_pk_bf16(v[0], v[1]); w.y = cvt_pk_bf16(v[2], v[3]);
        *(u32x2*)(O + (size_t)r * ldc + c) = w;
    }
    __device__ __forceinline__ void operator()(const f32x4 (&acc)[2][2][4][2], const Unit& u, int wr, int wc, int fr, int fq, int ui) const {
        const int row0 = u.pm * BM + wr * 64 + fr, colt = u.pn * BM, col0 = colt + wc * 32 + 8 * fq;
        const bool gate = colt >= gate_lo;
        const float* cvp = cvec + (size_t)seq_of_row(u.pm * BM) * ldc + col0;
        f32x4 bv[2][2];
#pragma unroll
        for (int bj = 0; bj < 2; ++bj)
#pragma unroll
            for (int n = 0; n < 2; ++n) { bv[bj][n] = *(const f32x4*)(cvp + bj * HALF + 4 * n); if (gate) bv[bj][n] += *(const f32x4*)(bias + (col0 - gate_lo) + bj * HALF + 4 * n); }
#pragma unroll
        for (int ai = 0; ai < 2; ++ai) {
#pragma unroll
            for (int m = 0; m < 4; ++m) { const int r = row0 + ai * HALF + m * 16; bf16_t* rowp = O + (size_t)r * ldc + col0;
                const float rs = rsl[ui * 256 + wr * 64 + fr + ai * HALF + m * 16];
#pragma unroll
                for (int bj = 0; bj < 2; ++bj) { f32x4 v0 = acc[ai][bj][m][0] * rs + bv[bj][0], v1 = acc[ai][bj][m][1] * rs + bv[bj][1];
                    if (mode == 1) {
#pragma unroll
                        for (int j = 0; j < 4; ++j) { const float a = fmaxf(v0[j], 0.f), b = fmaxf(v1[j], 0.f); v0[j] = a * a; v1[j] = b * b; } }
                    if (gate) {
#pragma unroll
                        for (int j = 0; j < 4; ++j) { v0[j] = logsig16(v0[j]); v1[j] = logsig16(v1[j]); } }
                    u32x4 w; w.x = cvt_pk_bf16(v0[0], v0[1]); w.y = cvt_pk_bf16(v0[2], v0[3]); w.z = cvt_pk_bf16(v1[0], v1[1]); w.w = cvt_pk_bf16(v1[2], v1[3]);
                    *(u32x4*)(rowp + bj * HALF) = w; } } }
    }
};
struct EpiRes {
    static constexpr bool PERM = false;
    const float* yin_p; const float* yin_s; float* yout; const float* gate;
    bf16_t* Hn; const float* av; float* rowss_next;
    __device__ __forceinline__ void tile4(int r, int c, f32x4 v) const {
        const int sq = seq_of_row(r);
        const f32x4 gv = *(const f32x4*)(gate + (size_t)sq * ADA + c), iv = *(const f32x4*)((r < MP ? yin_p + (size_t)r * D : yin_s + (size_t)(r - MP) * D) + c);
        const f32x4 y = iv + gv * v;
        *(f32x4*)(yout + (size_t)r * D + c) = y;
        if (Hn) {
            const f32x4 a = *(const f32x4*)(av + (size_t)sq * D + c);
            u32x2 w; w.x = cvt_pk_bf16(y[0] * a[0], y[1] * a[1]); w.y = cvt_pk_bf16(y[2] * a[2], y[3] * a[3]);
            *(u32x2*)(Hn + (size_t)r * D + c) = w;
            float ss = y[0] * y[0] + y[1] * y[1] + y[2] * y[2] + y[3] * y[3];
            ss += __shfl_xor(ss, 16); ss += __shfl_xor(ss, 32);
            if ((threadIdx.x & 48) == 0) rowss_next[(size_t)MP * 16 + (size_t)(r - MP) * 64 + (c >> 4)] = ss;
        }
    }
    __device__ __forceinline__ void operator()(const f32x4 (&acc)[2][2][4][2], const Unit& u, int wr, int wc, int fr, int fq, int ui) const {
        const int row0 = u.pm * BM + wr * 64 + fr, col0 = u.pn * BM + wc * 32 + 4 * fq;
        const int sq = seq_of_row(u.pm * BM);
        const float* gp = gate + (size_t)sq * ADA + col0;
        const float* avp = av + (size_t)sq * D + col0;
#pragma unroll
        for (int ai = 0; ai < 2; ++ai) {
            f32x4 yv[4][2][2];
#pragma unroll
            for (int m = 0; m < 4; ++m) { const float* ip = yin_p + (size_t)(row0 + ai * HALF + m * 16) * D + col0;
#pragma unroll
                for (int bj = 0; bj < 2; ++bj)
#pragma unroll
                    for (int n = 0; n < 2; ++n) yv[m][bj][n] = *(const f32x4*)(ip + bj * HALF + n * 16); }
            float ss[4] = {0.f, 0.f, 0.f, 0.f};
#pragma unroll
            for (int bj = 0; bj < 2; ++bj)
#pragma unroll
                for (int n = 0; n < 2; ++n) { const int co = bj * HALF + n * 16;
                    const f32x4 gv = *(const f32x4*)(gp + co), a = Hn ? *(const f32x4*)(avp + co) : (f32x4){0.f, 0.f, 0.f, 0.f};
#pragma unroll
                    for (int m = 0; m < 4; ++m) { const int r = row0 + ai * HALF + m * 16;
                        const f32x4 y = yv[m][bj][n] + gv * acc[ai][bj][m][n];
                        *(f32x4*)(yout + (size_t)r * D + col0 + co) = y;
                        if (Hn) { u32x2 w; w.x = cvt_pk_bf16(y[0] * a[0], y[1] * a[1]); w.y = cvt_pk_bf16(y[2] * a[2], y[3] * a[3]);
                            *(u32x2*)(Hn + (size_t)r * D + col0 + co) = w;
                            ss[m] += y[0] * y[0] + y[1] * y[1] + y[2] * y[2] + y[3] * y[3]; } } }
            if (Hn) {
#pragma unroll
                for (int m = 0; m < 4; ++m) { float t = ss[m]; t += __shfl_xor(t, 16); t += __shfl_xor(t, 32); if (fq == 0) rowss_next[(size_t)(row0 + ai * HALF + m * 16) * 16 + u.pn * 4 + wc] = t; } } }
    }
};

template <class Epi>
__device__ __forceinline__ void gemm_sample(unsigned char* lds, const Gemm g, const Epi& E) {
    const int tid = opaque_tid(), wid = tid >> 6, lane = tid & 63, g4 = lane >> 4, r16 = lane & 15;
    const int K = g.K, CT = g.N >> 8;
    f32x4* red = (f32x4*)lds;
    for (int v = opaque_bid(); v < 256; v += opaque_nwg()) {
        const int row = MP + (v & 15) * 16 + r16, colbase = (v >> 4) * (g.N >> 4);
        const bf16_t* ap = g.A + (size_t)row * g.lda + g4 * 8;
        if (CT == 4) {
            const int ct = wid & 3, kh = wid >> 2, k0 = kh * (K >> 1), k1 = k0 + (K >> 1);
            const bf16_t* bp = g.Bt + (size_t)(colbase + ct * 16 + r16) * K + g4 * 8;
            f32x4 acc = (f32x4){0.f, 0.f, 0.f, 0.f};
#pragma unroll 8
            for (int k = k0; k < k1; k += 32) acc = __builtin_amdgcn_mfma_f32_16x16x32_bf16(*(const bf16x8*)(bp + k), *(const bf16x8*)(ap + k), acc, 0, 0, 0);
            __syncthreads();
            if (kh == 1) red[ct * 64 + lane] = acc;
            __syncthreads();
            if (kh == 0) { acc += red[ct * 64 + lane]; E.tile4(row, colbase + ct * 16 + g4 * 4, acc); }
        } else {
            const int c0 = wid, c1 = wid + 8, c2 = wid + 16;
            const bool h1 = c1 < CT, h2 = c2 < CT;
            if (c0 < CT) {
                const bf16_t* bp0 = g.Bt + (size_t)(colbase + c0 * 16 + r16) * K + g4 * 8;
                const bf16_t* bp1 = g.Bt + (size_t)(colbase + (h1 ? c1 : c0) * 16 + r16) * K + g4 * 8;
                const bf16_t* bp2 = g.Bt + (size_t)(colbase + (h2 ? c2 : c0) * 16 + r16) * K + g4 * 8;
                f32x4 a0 = (f32x4){0.f, 0.f, 0.f, 0.f}, a1 = a0, a2 = a0;
#pragma unroll 4
                for (int k = 0; k < K; k += 32) { const bf16x8 av = *(const bf16x8*)(ap + k);
                    a0 = __builtin_amdgcn_mfma_f32_16x16x32_bf16(*(const bf16x8*)(bp0 + k), av, a0, 0, 0, 0);
                    a1 = __builtin_amdgcn_mfma_f32_16x16x32_bf16(*(const bf16x8*)(bp1 + k), av, a1, 0, 0, 0);
                    a2 = __builtin_amdgcn_mfma_f32_16x16x32_bf16(*(const bf16x8*)(bp2 + k), av, a2, 0, 0, 0); }
                E.tile4(row, colbase + c0 * 16 + g4 * 4, a0);
                if (h1) E.tile4(row, colbase + c1 * 16 + g4 * 4, a1);
                if (h2) E.tile4(row, colbase + c2 * 16 + g4 * 4, a2);
            }
        }
    }
}
}

#define MFMA16(a, b, c) __builtin_amdgcn_mfma_f32_16x16x32_bf16((a), (b), (c), 0, 0, 0)

__device__ __forceinline__ void prep_phase(unsigned char* lds, const Params& p) {
    const int tid = opaque_tid();
    {
        float* sc = (float*)lds;
        float* red = sc + 32 * 512;
        for (int u = opaque_bid(); u < 4 * 48; u += opaque_nwg()) {
            const int l = u / 48, cb = u % 48, col = cb * 128 + (tid & 127), kq = tid >> 7;
            const float* w = p.in[11] + (size_t)l * D * ADA + col;
            float a[32];
#pragma unroll
            for (int s = 0; s < 32; ++s) a[s] = 0.f;
#pragma unroll 1
            for (int half = 0; half < 2; ++half) {
                __syncthreads();
                for (int i = tid; i < 32 * 512; i += NTHREADS) { const int s = i >> 9, k = half * 512 + (i & 511); const float c = s < 16 ? p.in[7][s * D + k] : p.in[8][(s - 16) * D + k]; sc[i] = silu_f(c); }
                __syncthreads();
#pragma unroll 2
                for (int kl = kq * 128; kl < kq * 128 + 128; kl += 4) {
                    const int k = half * 512 + kl;
                    const float w0 = w[(size_t)k * ADA], w1 = w[(size_t)(k + 1) * ADA], w2 = w[(size_t)(k + 2) * ADA], w3 = w[(size_t)(k + 3) * ADA];
#pragma unroll
                    for (int s = 0; s < 32; ++s) { const f32x4 c4 = *(const f32x4*)(sc + s * 512 + kl); a[s] += c4[0] * w0 + c4[1] * w1 + c4[2] * w2 + c4[3] * w3; }
                }
            }
            if (kq > 0) {
#pragma unroll
                for (int s = 0; s < 32; ++s) red[((kq - 1) * 32 + s) * 128 + (tid & 127)] = a[s];
            }
            __syncthreads();
            if (kq == 0) {
                float* mo = (float*)(p.ws + WS_MOD) + (size_t)l * 32 * ADA + col;
                const float bias = p.in[12][(size_t)l * ADA + col];
#pragma unroll
                for (int s = 0; s < 32; ++s) { const int c = tid & 127; mo[(size_t)s * ADA] = a[s] + red[(0 * 32 + s) * 128 + c] + red[(1 * 32 + s) * 128 + c] + red[(2 * 32 + s) * 128 + c] + bias; }
            }
        }
        __syncthreads();
    }
    {
        const int gt = opaque_bid() * NTHREADS + tid, gn = opaque_nwg() * NTHREADS;
        for (int i = gt; i < 2 * 512 * 512; i += gn) {
            const int k2 = (i & 511) * 2, n = (i >> 9) & 511, j = i >> 18;
            const float* w1 = p.in[18] + (size_t)j * D * 16 + (size_t)k2 * 16; const float* w2 = p.in[19] + (size_t)j * 16 * 512 + n;
            float a0 = 0.f, a1 = 0.f;
#pragma unroll
            for (int r = 0; r < 16; ++r) { const float b = w2[r * 512]; a0 += w1[r] * b; a1 += w1[16 + r] * b; }
            bf16_t* dst = (bf16_t*)(p.ws + WS_GIN) + (size_t)j * GLA_N * D + (size_t)(3072 + n) * D + k2;
            *(unsigned*)dst = cvt_pk_bf16(a0, a1);
        }
    }
    {
        float* tl = (float*)lds;
        for (int t = opaque_bid(); t < p.ntiles; t += opaque_nwg()) {
            int j = 0;
#pragma unroll 1
            for (int q = 1; q < NJOBS; ++q) if (t >= p.jobs[q].tile0) j = q;
            const TJob jb = p.jobs[j];
            const int lt = t - jb.tile0, ntn = jb.N >> 7, k0 = (lt / ntn) << 6, n0 = (lt % ntn) << 7;
            __syncthreads();
#pragma unroll
            for (int i = 0; i < 16; ++i) { const int idx = tid + NTHREADS * i, r = idx >> 7, c = idx & 127; tl[c * 65 + r] = jb.src[(size_t)(k0 + r) * jb.N + n0 + c]; }
            __syncthreads();
#pragma unroll
            for (int i = 0; i < 8; ++i) { const int pi = tid + NTHREADS * i, n = pi >> 5, k2 = (pi & 31) * 2;
                *(unsigned*)(jb.dst + (size_t)(n0 + n) * jb.K + k0 + k2) = cvt_pk_bf16(tl[n * 65 + k2] * jb.scale, tl[n * 65 + k2 + 1] * jb.scale); }
        }
    }
}

__device__ __forceinline__ int stage_N(int s) { return (s & 1) ? HID : (s == 2) ? RET_N : (s == 4) ? SWA_N : GLA_N; }
__device__ __forceinline__ int stage_cvoff(int s) { return s == 0 ? 0 : s == 1 ? 3584 : s == 2 ? 7680 : s == 3 ? 13824 : s == 4 ? 17920 : s == 5 ? 19456 : s == 6 ? 23552 : 27136; }
__device__ __forceinline__ const bf16_t* stage_W(const unsigned char* ws, int s) {
    const int layer = s >> 1;
    if (s & 1) return (const bf16_t*)(ws + WS_W1T) + (size_t)layer * HID * D;
    return s == 2 ? (const bf16_t*)(ws + WS_RIN) : s == 4 ? (const bf16_t*)(ws + WS_SIN) : (const bf16_t*)(ws + WS_GIN) + (size_t)(layer / 3) * GLA_N * D;
}
__device__ __forceinline__ void prepb_phase(const Params& p) {
    const int tid = opaque_tid(), lane = tid & 63, wid = tid >> 6, g4 = lane >> 4, r16 = lane & 15;
    const float* mod = (const float*)(p.ws + WS_MOD);
    float* av = (float*)(p.ws + WS_AVEC);
    for (int i = opaque_bid() * NTHREADS + tid; i < 8 * 32 * D; i += opaque_nwg() * NTHREADS) { const int st = i >> 15, sq = (i >> 10) & 31, c = i & 1023, layer = st >> 1;
        const float g = ((st & 1) ? p.in[10] : p.in[9])[layer * D + c];
        av[i] = g * (1.0f + mod[((size_t)layer * 32 + sq) * ADA + ((st & 1) ? 4 : 1) * D + c]); }
    float* cvec = (float*)(p.ws + WS_CVEC);
    for (int it = opaque_bid() * 8 + wid; it < CVEC_TOTAL_N / 16; it += opaque_nwg() * 8) {
        const int ng = it * 16; int st = 0;
#pragma unroll
        for (int q = 1; q < 8; ++q) if (ng >= stage_cvoff(q)) st = q;
        const int n0 = ng - stage_cvoff(st), N = stage_N(st), layer = st >> 1;
        const bf16_t* wp = stage_W(p.ws, st) + (size_t)(n0 + r16) * D + g4 * 8;
        const float* sh0 = mod + ((size_t)layer * 32 + r16) * ADA + ((st & 1) ? 3 : 0) * D + g4 * 8; const float* sh1 = sh0 + (size_t)16 * ADA;
        f32x4 acc0 = (f32x4){0.f, 0.f, 0.f, 0.f}, acc1 = acc0;
#pragma unroll 4
        for (int k = 0; k < D; k += 32) {
            const bf16x8 bw = *(const bf16x8*)(wp + k);
            const f32x4 x0 = *(const f32x4*)(sh0 + k), x1 = *(const f32x4*)(sh0 + k + 4), y0 = *(const f32x4*)(sh1 + k), y1 = *(const f32x4*)(sh1 + k + 4);
            u32x4 a0, a1; a0.x = cvt_pk_bf16(x0[0], x0[1]); a0.y = cvt_pk_bf16(x0[2], x0[3]); a0.z = cvt_pk_bf16(x1[0], x1[1]); a0.w = cvt_pk_bf16(x1[2], x1[3]);
            a1.x = cvt_pk_bf16(y0[0], y0[1]); a1.y = cvt_pk_bf16(y0[2], y0[3]); a1.z = cvt_pk_bf16(y1[0], y1[1]); a1.w = cvt_pk_bf16(y1[2], y1[3]);
            acc0 = MFMA16(bw, __builtin_bit_cast(bf16x8, a0), acc0); acc1 = MFMA16(bw, __builtin_bit_cast(bf16x8, a1), acc1);
        }
        float* cp = cvec + (size_t)32 * stage_cvoff(st) + (size_t)r16 * N + n0 + g4 * 4;
        *(f32x4*)cp = acc0; *(f32x4*)(cp + (size_t)16 * N) = acc1;
    }
    bf16_t* H = (bf16_t*)(p.ws + WS_H); float* rss = (float*)(p.ws + WS_RSS);
    for (int r = opaque_bid() * 8 + wid; r < MT; r += opaque_nwg() * 8) {
        const float* src = r < MP ? p.in[0] + (size_t)r * D : p.in[1] + (size_t)(r - MP) * D;
        const float* mrow = mod + (size_t)seq_of_row(r) * ADA + D;
        float ss = 0.f;
#pragma unroll
        for (int i = 0; i < 4; ++i) { const int c = i * 256 + lane * 4;
            const f32x4 v = *(const f32x4*)(src + c), gv = *(const f32x4*)(p.in[9] + c), sc = *(const f32x4*)(mrow + c);
            ss += v[0] * v[0] + v[1] * v[1] + v[2] * v[2] + v[3] * v[3];
            u32x2 w; w.x = cvt_pk_bf16(v[0] * gv[0] * (1.0f + sc[0]), v[1] * gv[1] * (1.0f + sc[1])); w.y = cvt_pk_bf16(v[2] * gv[2] * (1.0f + sc[2]), v[3] * gv[3] * (1.0f + sc[3]));
            *(u32x2*)(H + (size_t)r * D + c) = w; }
        ss = wave_sum(ss);
        if (r < MP) { if (lane < 16) rss[(size_t)r * 16 + lane] = lane == 0 ? ss : 0.f; } else rss[(size_t)MP * 16 + (size_t)(r - MP) * 64 + lane] = lane == 0 ? ss : 0.f;
    }
}

template <int DK, int DV, bool GLA>
__device__ __forceinline__ void recur_phase(unsigned char* lds, bf16_t* P, int ldp, int qoff, int koff, int voff, int goff, const float* S0s, float* outSp, float* outSs, bool live = true, bf16_t* PO = nullptr, int ldo = 0) {
    constexpr int VS = 64, NVS = DV / VS, NH = 4;
    constexpr int QS = DK + 8, TS = 64 + 8;
    constexpr int CP = DK / 2, NSEG = NTHREADS / CP, RPS = 64 / NSEG, NDT = DK / 128, NKK = DK / 32;
    bf16_t* QD = (bf16_t*)lds;
    bf16_t* KD = QD + 64 * QS;
    bf16_t* KDT = KD + 64 * QS;
    bf16_t* VT = KDT + DK * TS;
    bf16_t* ATT = VT + VS * TS;
    bf16_t* ST = ATT + 64 * TS;
    float* SEG = (float*)(ST + VS * QS);
    float* EBL = SEG + (GLA ? NSEG * DK : 0);
    static_assert((size_t)(64 * QS * 2 + DK * TS + VS * TS + 64 * TS + VS * QS) * 2 + (GLA ? (NSEG + 1) * DK * 4 : 0) <= LDS_BYTES, "recurrence LDS");
    const int tid = opaque_tid(), lane = tid & 63, wid = tid >> 6, g4 = lane >> 4, r16 = lane & 15;
    const int cp = tid % CP, sgm = tid / CP, vcp = tid & 31, vsg = tid >> 5;
    constexpr int NIP = NB * NH * NVS;
    for (int item = opaque_bid(); item < 2 * NIP; item += opaque_nwg()) {
        const bool smp = item >= NIP; const int it = smp ? item - NIP : item;
        const int vs = it % NVS, h = (it / NVS) % NH, b = it / (NVS * NH);
        const int row0 = smp ? MP + b * DSEQ : b * SEQ, nch = smp ? 1 : SEQ / 64, Lc = smp ? DSEQ : 64;
        const float lgam = GLA ? 0.f : __logf(1.0f - exp2f(-5.0f - (float)h));
        f32x4 sacc[NDT][4];
        __syncthreads();
#pragma unroll
        for (int dl = 0; dl < NDT; ++dl)
#pragma unroll
            for (int vt = 0; vt < 4; ++vt) {
                f32x4 s = (f32x4){0.f, 0.f, 0.f, 0.f};
                const int d0 = (wid * NDT + dl) * 16 + g4 * 4, v = vt * 16 + r16;
                if (smp) {
#pragma unroll
                    for (int j = 0; j < 4; ++j) s[j] = S0s[(((size_t)b * NH + h) * DK + d0 + j) * DV + vs * VS + v];
                }
                sacc[dl][vt] = s;
                u32x2 w; w.x = cvt_pk_bf16(s[0], s[1]); w.y = cvt_pk_bf16(s[2], s[3]);
                *(u32x2*)(ST + v * QS + d0) = w;
            }
        unsigned rq[RPS], rk[RPS], rg[RPS], rv[4];
        const bf16_t* Pq = P + qoff + h * DK + 2 * cp; const bf16_t* Pk = P + koff + h * DK + 2 * cp; const bf16_t* Pg = P + goff + h * DK + 2 * cp;
        bf16_t* Pv = P + voff + h * DV + vs * VS;
#define RC_LOAD(c) do { \
        _Pragma("unroll") for (int i = 0; i < RPS; ++i) { const int row = sgm * RPS + i; const size_t go = (size_t)(row0 + (c) * 64 + row) * ldp; const bool ok = row < Lc; \
            rq[i] = ok ? *(const unsigned*)(Pq + go) : 0u; rk[i] = ok ? *(const unsigned*)(Pk + go) : 0u; if (GLA) rg[i] = ok ? *(const unsigned*)(Pg + go) : 0u; } \
        _Pragma("unroll") for (int i = 0; i < 4; ++i) { const int row = vsg * 4 + i; rv[i] = row < Lc ? *(const unsigned*)(Pv + (size_t)(row0 + (c) * 64 + row) * ldp + 2 * vcp) : 0u; } } while (0)
        RC_LOAD(0);
        for (int c = 0; c < nch; ++c) {
            float off0 = 0.f, off1 = 0.f, tot0 = 0.f, tot1 = 0.f;
            float pre0[RPS], pre1[RPS];
            if (GLA) {
                float a0 = 0.f, a1 = 0.f;
#pragma unroll
                for (int i = 0; i < RPS; ++i) { a0 += bf_lo(rg[i]); a1 += bf_hi(rg[i]); pre0[i] = a0; pre1[i] = a1; }
                SEG[sgm * DK + 2 * cp] = a0; SEG[sgm * DK + 2 * cp + 1] = a1;
                __syncthreads();
#pragma unroll
                for (int s = 0; s < NSEG; ++s) { const float t0 = SEG[s * DK + 2 * cp], t1 = SEG[s * DK + 2 * cp + 1]; if (s < sgm) { off0 += t0; off1 += t1; } tot0 += t0; tot1 += t1; }
                if (sgm == 0) { EBL[2 * cp] = __expf(tot0); EBL[2 * cp + 1] = __expf(tot1); }
            }
            {
                float kt0[RPS], kt1[RPS];
#pragma unroll
                for (int i = 0; i < RPS; ++i) { const int row = sgm * RPS + i;
                    const float q0 = bf_lo(rq[i]), q1 = bf_hi(rq[i]), k0 = bf_lo(rk[i]), k1 = bf_hi(rk[i]);
                    if (GLA) {
                        const float b0 = off0 + pre0[i], b1 = off1 + pre1[i];
                        const float e0 = __expf(b0), e1 = __expf(b1);
                        *(unsigned*)(QD + row * QS + 2 * cp) = cvt_pk_bf16(q0 * e0, q1 * e1);
                        *(unsigned*)(KD + row * QS + 2 * cp) = cvt_pk_bf16(k0 * __expf(-b0), k1 * __expf(-b1));
                        kt0[i] = k0 * __expf(tot0 - b0); kt1[i] = k1 * __expf(tot1 - b1);
                    } else {
                        *(unsigned*)(QD + row * QS + 2 * cp) = rq[i];
                        *(unsigned*)(KD + row * QS + 2 * cp) = rk[i];
                        const float dk = __expf(lgam * (float)(Lc - 1 - row));
                        kt0[i] = k0 * dk; kt1[i] = k1 * dk;
                    } }
#pragma unroll
                for (int i = 0; i < RPS; i += 8) {
                    u32x4 w0, w1;
                    w0.x = cvt_pk_bf16(kt0[i], kt0[i + 1]); w0.y = cvt_pk_bf16(kt0[i + 2], kt0[i + 3]); w0.z = cvt_pk_bf16(kt0[i + 4], kt0[i + 5]); w0.w = cvt_pk_bf16(kt0[i + 6], kt0[i + 7]);
                    w1.x = cvt_pk_bf16(kt1[i], kt1[i + 1]); w1.y = cvt_pk_bf16(kt1[i + 2], kt1[i + 3]); w1.z = cvt_pk_bf16(kt1[i + 4], kt1[i + 5]); w1.w = cvt_pk_bf16(kt1[i + 6], kt1[i + 7]);
                    *(u32x4*)(KDT + (2 * cp) * TS + sgm * RPS + i) = w0; *(u32x4*)(KDT + (2 * cp + 1) * TS + sgm * RPS + i) = w1;
                }
                u32x2 v0, v1;
                v0.x = (rv[0] & 0xffffu) | (rv[1] << 16); v0.y = (rv[2] & 0xffffu) | (rv[3] << 16);
                v1.x = (rv[0] >> 16) | (rv[1] & 0xffff0000u); v1.y = (rv[2] >> 16) | (rv[3] & 0xffff0000u);
                *(u32x2*)(VT + (2 * vcp) * TS + vsg * 4) = v0; *(u32x2*)(VT + (2 * vcp + 1) * TS + vsg * 4) = v1;
            }
            __syncthreads();
            if (c + 1 < nch) RC_LOAD(c + 1);
#pragma unroll
            for (int tt = 0; tt < 2; ++tt) { const int t = wid * 2 + tt, lt = t >> 2, st = t & 3;
                f32x4 acc = (f32x4){0.f, 0.f, 0.f, 0.f};
                if (st <= lt) {
#pragma unroll
                    for (int kk = 0; kk < NKK; ++kk) { const bf16x8 a = *(const bf16x8*)(QD + (lt * 16 + r16) * QS + kk * 32 + g4 * 8), bb = *(const bf16x8*)(KD + (st * 16 + r16) * QS + kk * 32 + g4 * 8);
                        acc = MFMA16(bb, a, acc); }
                }
                const int l = lt * 16 + r16, s0 = st * 16 + g4 * 4;
#pragma unroll
                for (int j = 0; j < 4; ++j) { const int s = s0 + j; float v = acc[j]; if (!GLA) v *= __expf(lgam * (float)(l - s)); acc[j] = (s <= l) ? v : 0.f; }
                u32x2 w; w.x = cvt_pk_bf16(acc[0], acc[1]); w.y = cvt_pk_bf16(acc[2], acc[3]);
                *(u32x2*)(ATT + l * TS + s0) = w; }
            __syncthreads();
#pragma unroll
            for (int tt = 0; tt < 2; ++tt) { const int t = wid * 2 + tt, lt = t >> 2, vt = t & 3;
                f32x4 a1 = (f32x4){0.f, 0.f, 0.f, 0.f}, a2 = (f32x4){0.f, 0.f, 0.f, 0.f};
#pragma unroll
                for (int kk = 0; kk < 2; ++kk) { if (kk * 32 <= lt * 16 + 15) { const bf16x8 a = *(const bf16x8*)(ATT + (lt * 16 + r16) * TS + kk * 32 + g4 * 8), bb = *(const bf16x8*)(VT + (vt * 16 + r16) * TS + kk * 32 + g4 * 8);
                        a1 = MFMA16(bb, a, a1); } }
#pragma unroll
                for (int kk = 0; kk < NKK; ++kk) { const bf16x8 a = *(const bf16x8*)(QD + (lt * 16 + r16) * QS + kk * 32 + g4 * 8), bb = *(const bf16x8*)(ST + (vt * 16 + r16) * QS + kk * 32 + g4 * 8);
                    a2 = MFMA16(bb, a, a2); }
                const int l = lt * 16 + r16;
                const float dq = GLA ? 1.0f : __expf(lgam * (float)(l + 1));
                if (l < Lc && live) { u32x2 w; w.x = cvt_pk_bf16(a1[0] + a2[0] * dq, a1[1] + a2[1] * dq); w.y = cvt_pk_bf16(a1[2] + a2[2] * dq, a1[3] + a2[3] * dq);
                    if (PO) *(u32x2*)(PO + (size_t)(row0 + c * 64 + l) * ldo + h * DV + vs * VS + vt * 16 + g4 * 4) = w;
                    else *(u32x2*)(Pv + (size_t)(row0 + c * 64 + l) * ldp + vt * 16 + g4 * 4) = w; } }
            __syncthreads();
#pragma unroll
            for (int dl = 0; dl < NDT; ++dl) { const int dt = wid * NDT + dl;
                f32x4 dec;
                if (GLA) dec = *(const f32x4*)(EBL + dt * 16 + g4 * 4); else { const float dc = __expf(lgam * (float)Lc); dec = (f32x4){dc, dc, dc, dc}; }
                const bf16x8 ka0 = *(const bf16x8*)(KDT + (dt * 16 + r16) * TS + g4 * 8), ka1 = *(const bf16x8*)(KDT + (dt * 16 + r16) * TS + 32 + g4 * 8);
#pragma unroll
                for (int vt = 0; vt < 4; ++vt) {
                    f32x4 acc = sacc[dl][vt] * dec;
                    acc = MFMA16(ka0, *(const bf16x8*)(VT + (vt * 16 + r16) * TS + g4 * 8), acc);
                    acc = MFMA16(ka1, *(const bf16x8*)(VT + (vt * 16 + r16) * TS + 32 + g4 * 8), acc);
                    sacc[dl][vt] = acc;
                    u32x2 w; w.x = cvt_pk_bf16(acc[0], acc[1]); w.y = cvt_pk_bf16(acc[2], acc[3]);
                    *(u32x2*)(ST + (vt * 16 + r16) * QS + dt * 16 + g4 * 4) = w;
                } }
            __syncthreads();
        }
#undef RC_LOAD
        float* So = smp ? outSs : outSp;
#pragma unroll
        for (int dl = 0; dl < NDT; ++dl)
#pragma unroll
            for (int vt = 0; vt < 4; ++vt) { const int d0 = (wid * NDT + dl) * 16 + g4 * 4, v = vt * 16 + r16;
#pragma unroll
                for (int j = 0; j < 4; ++j) if (live) So[(((size_t)b * NH + h) * DK + d0 + j) * DV + vs * VS + v] = sacc[dl][vt][j]; }
    }
}

template <int DV, bool GLA>
__device__ __forceinline__ void post_phase(bf16_t* P, int ldp, int ooff, int goff, const float* normg) {
    constexpr int EPL = DV / 16;
    const int tid = opaque_tid(), lane = tid & 63, wid = tid >> 6;
    for (int r0 = (opaque_bid() * 8 + wid) * 2; r0 < MT; r0 += opaque_nwg() * 16) {
        float o[2][EPL]; u32x4 gw[2][EPL / 8];
#pragma unroll
        for (int rr = 0; rr < 2; ++rr) { const bf16_t* po = P + (size_t)(r0 + rr) * ldp + ooff + lane * EPL; const bf16_t* pg = P + (size_t)(r0 + rr) * ldp + goff + lane * EPL;
#pragma unroll
            for (int i = 0; i < EPL; i += 8) { const u32x4 w = *(const u32x4*)(po + i); gw[rr][i / 8] = *(const u32x4*)(pg + i);
#pragma unroll
                for (int j = 0; j < 4; ++j) { o[rr][i + 2 * j] = bf_lo(w[j]); o[rr][i + 2 * j + 1] = bf_hi(w[j]); } } }
#pragma unroll
        for (int rr = 0; rr < 2; ++rr) {
            float s1 = 0.f, s2 = 0.f;
#pragma unroll
            for (int i = 0; i < EPL; ++i) { s1 += o[rr][i]; s2 += o[rr][i] * o[rr][i]; }
#pragma unroll
            for (int m = 1; m < 16; m <<= 1) { s1 += __shfl_xor(s1, m); s2 += __shfl_xor(s2, m); }
            float mu = 0.f, rs;
            if (GLA) rs = rsqrtf(s2 * (1.0f / DV) + 1e-6f);
            else { mu = s1 * (1.0f / DV); rs = rsqrtf(fmaxf(s2 * (1.0f / DV) - mu * mu, 0.f) + 1e-5f); }
            bf16_t* pg = P + (size_t)(r0 + rr) * ldp + goff + lane * EPL;
#pragma unroll
            for (int i = 0; i < EPL; i += 8) { const u32x4 g = gw[rr][i / 8]; u32x4 w;
#pragma unroll
                for (int j = 0; j < 4; ++j) { float x0 = (o[rr][i + 2 * j] - mu) * rs, x1 = (o[rr][i + 2 * j + 1] - mu) * rs;
                    if (GLA) { const int vc = (lane & 15) * EPL + i + 2 * j; x0 *= normg[vc]; x1 *= normg[vc + 1]; }
                    w[j] = cvt_pk_bf16(x0 * silu_f(bf_lo(g[j])), x1 * silu_f(bf_hi(g[j]))); }
                *(u32x4*)(pg + i) = w; }
        }
    }
}

__device__ __forceinline__ void swa_phase(unsigned char* lds, const Params& p, bf16_t* P, int z) {
    const bool live = true;
    constexpr int KS_S = 72, VT_S = 200, PW_S = 200;
    bf16_t* KS = (bf16_t*)lds;
    bf16_t* VT = KS + 192 * KS_S;
    bf16_t* PW = VT + 64 * VT_S;
    const int tid = opaque_tid(), lane = tid & 63, wid = tid >> 6, g4 = lane >> 4, r16 = lane & 15;
    const float* qn = p.in[30 + z]; const float* kn = p.in[31 + z]; const float* sinks = p.in[32 + z];
    const float* cache_k = p.in[4 + z]; const float* cache_v = p.in[5 + z];
    float* out = p.out + z;
    constexpr int NPI = NB * 64 * 4, NSI = NB * 4;
    for (int item = opaque_bid(); item < NPI + NSI; item += opaque_nwg()) {
        const bool smp = item >= NPI; const int it = smp ? item - NPI : item;
        const int kv = it & 3, c = smp ? 0 : (it >> 2) & 63, b = smp ? it >> 2 : it >> 8;
        const int Lq = smp ? DSEQ : 64;
        __syncthreads();
        const int d0 = (tid & 7) * 8;
        f32x4 kn0 = *(const f32x4*)(kn + d0), kn1 = *(const f32x4*)(kn + d0 + 4);
#pragma unroll
        for (int i = 0; i < 3; ++i) { const int s = (tid >> 3) + 64 * i;
            float kf[8], vf[8]; bool valid, donorm = true; long prow = 0;
            if (!smp) { const int tok = (c - 2) * 64 + s; valid = tok >= 0; prow = (long)b * SEQ + tok; }
            else { valid = s < 128 + DSEQ; donorm = s >= 128; prow = (long)MP + b * DSEQ + (s - 128); }
            if (valid && (!smp || s >= 128)) {
                const u32x4 kw = *(const u32x4*)(P + (size_t)prow * SWA_N + 1024 + kv * 64 + d0), vw = *(const u32x4*)(P + (size_t)prow * SWA_N + 1280 + kv * 64 + d0);
#pragma unroll
                for (int j = 0; j < 4; ++j) { kf[2 * j] = bf_lo(kw[j]); kf[2 * j + 1] = bf_hi(kw[j]); vf[2 * j] = bf_lo(vw[j]); vf[2 * j + 1] = bf_hi(vw[j]); }
            } else if (valid) {
                const float* ck = cache_k + (((size_t)b * 128 + s) * 4 + kv) * 64 + d0; const float* cv = cache_v + (((size_t)b * 128 + s) * 4 + kv) * 64 + d0;
                const f32x4 a0 = *(const f32x4*)ck, a1 = *(const f32x4*)(ck + 4), c0 = *(const f32x4*)cv, c1 = *(const f32x4*)(cv + 4);
#pragma unroll
                for (int j = 0; j < 4; ++j) { kf[j] = a0[j]; kf[4 + j] = a1[j]; vf[j] = c0[j]; vf[4 + j] = c1[j]; }
            } else {
#pragma unroll
                for (int j = 0; j < 8; ++j) { kf[j] = 0.f; vf[j] = 0.f; }
            }
            float ss = 0.f;
#pragma unroll
            for (int j = 0; j < 8; ++j) ss += kf[j] * kf[j];
            ss += __shfl_xor(ss, 1); ss += __shfl_xor(ss, 2); ss += __shfl_xor(ss, 4);
            if (donorm) { const float rs = rsqrtf(ss * (1.0f / 64) + 1e-6f);
#pragma unroll
                for (int j = 0; j < 4; ++j) { kf[j] *= rs * kn0[j]; kf[4 + j] *= rs * kn1[j]; } }
            u32x4 w; w.x = cvt_pk_bf16(kf[0], kf[1]); w.y = cvt_pk_bf16(kf[2], kf[3]); w.z = cvt_pk_bf16(kf[4], kf[5]); w.w = cvt_pk_bf16(kf[6], kf[7]);
            *(u32x4*)(KS + s * KS_S + d0) = w;
#pragma unroll
            for (int j = 0; j < 8; ++j) VT[(d0 + j) * VT_S + s] = (bf16_t)(cvt_pk_bf16(vf[j], 0.f) & 0xffffu);
            float* ko = nullptr; float* vo = nullptr;
            if (!smp && c >= 62 && s >= 128) { const int w_ = (c - 62) * 64 + (s - 128); ko = out + O_KP + (((size_t)b * 128 + w_) * 4 + kv) * 64 + d0; vo = out + O_VP + (((size_t)b * 128 + w_) * 4 + kv) * 64 + d0; }
            if (smp && s >= 128 && s < 128 + DSEQ) { ko = out + O_KS + (((size_t)b * DSEQ + (s - 128)) * 4 + kv) * 64 + d0; vo = out + O_VS + (((size_t)b * DSEQ + (s - 128)) * 4 + kv) * 64 + d0; }
            if (ko && live) { *(f32x4*)ko = (f32x4){kf[0], kf[1], kf[2], kf[3]}; *(f32x4*)(ko + 4) = (f32x4){kf[4], kf[5], kf[6], kf[7]};
                      *(f32x4*)vo = (f32x4){vf[0], vf[1], vf[2], vf[3]}; *(f32x4*)(vo + 4) = (f32x4){vf[4], vf[5], vf[6], vf[7]}; }
        }
        __syncthreads();
        const int gq = wid >> 1, hh = kv * 4 + gq;
        const float slope = exp2f(-0.5f * (float)(hh + 1)), sink = sinks[hh];
        bf16_t* pw = PW + wid * 16 * PW_S;
        for (int rt = 0; rt < 2; ++rt) {
            const int l = (wid & 1) * 32 + rt * 16 + r16;
            if ((wid & 1) * 32 + rt * 16 >= Lq) break;
            const bool lvalid = l < Lq;
            const size_t prow = smp ? (size_t)MP + b * DSEQ + (lvalid ? l : 0) : (size_t)b * SEQ + c * 64 + l;
            bf16_t* qp = P + prow * SWA_N + kv * 256 + gq * 64;
            bf16x8 qa[2];
            {
                float qf[2][8]; float ss = 0.f;
#pragma unroll
                for (int kk = 0; kk < 2; ++kk) { const u32x4 w = *(const u32x4*)(qp + kk * 32 + g4 * 8);
#pragma unroll
                    for (int j = 0; j < 4; ++j) { qf[kk][2 * j] = bf_lo(w[j]); qf[kk][2 * j + 1] = bf_hi(w[j]); } }
#pragma unroll
                for (int kk = 0; kk < 2; ++kk)
#pragma unroll
                    for (int j = 0; j < 8; ++j) ss += qf[kk][j] * qf[kk][j];
                ss += __shfl_xor(ss, 16); ss += __shfl_xor(ss, 32);
                const float rs = rsqrtf(ss * (1.0f / 64) + 1e-6f) * 0.125f;
#pragma unroll
                for (int kk = 0; kk < 2; ++kk) { u32x4 w;
#pragma unroll
                    for (int j = 0; j < 4; ++j) { const int d = kk * 32 + g4 * 8 + 2 * j; w[j] = cvt_pk_bf16(qf[kk][2 * j] * rs * qn[d], qf[kk][2 * j + 1] * rs * qn[d + 1]); }
                    qa[kk] = __builtin_bit_cast(bf16x8, w); }
            }
            f32x4 sc[12]; float mx = sink;
#pragma unroll
            for (int st = 0; st < 12; ++st) { f32x4 acc = (f32x4){0.f, 0.f, 0.f, 0.f};
#pragma unroll
                for (int kk = 0; kk < 2; ++kk) acc = MFMA16(*(const bf16x8*)(KS + (st * 16 + r16) * KS_S + kk * 32 + g4 * 8), qa[kk], acc);
#pragma unroll
                for (int j = 0; j < 4; ++j) { const int s = st * 16 + g4 * 4 + j; const bool kvalid = smp ? (s < 128 + DSEQ) : ((c - 2) * 64 + s >= 0);
                    const float v = kvalid ? acc[j] - slope * fabsf((float)(128 + l - s)) : -1e30f; acc[j] = v; mx = fmaxf(mx, v); }
                sc[st] = acc; }
            mx = fmaxf(mx, __shfl_xor(mx, 16)); mx = fmaxf(mx, __shfl_xor(mx, 32));
            float sum = 0.f;
#pragma unroll
            for (int st = 0; st < 12; ++st)
#pragma unroll
                for (int j = 0; j < 4; ++j) { const float e = __expf(sc[st][j] - mx); sc[st][j] = e; sum += e; }
            sum += __shfl_xor(sum, 16); sum += __shfl_xor(sum, 32);
            const float inv = 1.0f / (sum + __expf(sink - mx));
#pragma unroll
            for (int st = 0; st < 12; ++st) { u32x2 w; w.x = cvt_pk_bf16(sc[st][0] * inv, sc[st][1] * inv); w.y = cvt_pk_bf16(sc[st][2] * inv, sc[st][3] * inv);
                *(u32x2*)(pw + r16 * PW_S + st * 16 + g4 * 4) = w; }
            __builtin_amdgcn_fence(__ATOMIC_RELEASE, "wavefront"); __builtin_amdgcn_wave_barrier(); __builtin_amdgcn_fence(__ATOMIC_ACQUIRE, "wavefront");
#pragma unroll
            for (int dt = 0; dt < 4; ++dt) { f32x4 acc = (f32x4){0.f, 0.f, 0.f, 0.f};
#pragma unroll
                for (int kk = 0; kk < 6; ++kk) acc = MFMA16(*(const bf16x8*)(VT + (dt * 16 + r16) * VT_S + kk * 32 + g4 * 8), *(const bf16x8*)(pw + r16 * PW_S + kk * 32 + g4 * 8), acc);
                if (lvalid && live) { u32x2 w; w.x = cvt_pk_bf16(acc[0], acc[1]); w.y = cvt_pk_bf16(acc[2], acc[3]); *(u32x2*)(qp + dt * 16 + g4 * 4) = w; } }
            __builtin_amdgcn_fence(__ATOMIC_RELEASE, "wavefront"); __builtin_amdgcn_wave_barrier(); __builtin_amdgcn_fence(__ATOMIC_ACQUIRE, "wavefront");
        }
    }
}

#define XB_TMO      128
#define XB_XCNT(j)  (256  + 64 * (j))
#define XB_XSUB(j)  (1280 + 64 * (j))
#define XB_XGEN(j)  (2304 + 64 * (j))
#define XB_TOP      3328
#define XB_TOPGEN   3392
#define XCD_BAR_WORDS 3456
#define XB_SPIN_CAP (1u << 22)
static_assert(XCD_BAR_WORDS * 4 <= WS_BAR_BYTES, "barrier words");
__device__ __forceinline__ unsigned xb_ld(unsigned* p)              { return __hip_atomic_load(p, __ATOMIC_RELAXED, __HIP_MEMORY_SCOPE_AGENT); }
__device__ __forceinline__ unsigned xb_add(unsigned* p, unsigned v) { return __hip_atomic_fetch_add(p, v, __ATOMIC_RELAXED, __HIP_MEMORY_SCOPE_AGENT); }
__device__ __forceinline__ unsigned xb_xcc_id() { return (unsigned)__builtin_amdgcn_s_getreg((3 << 11) | 20) & 0xFu; }
#define XB_SPIN(cond, bar) do { unsigned _sp = 0; while (cond) { __builtin_amdgcn_s_sleep(1); \
    if ((++_sp & 255u) == 0u) { if (xb_ld(&(bar)[XB_TMO])) break; if (_sp > XB_SPIN_CAP) { atomicAdd(&(bar)[XB_TMO], 1u); break; } } } } while (0)
struct XcdBarrier { unsigned* bar; unsigned x; volatile LAS unsigned* st; };
__device__ __forceinline__ XcdBarrier xcd_barrier_post(unsigned* bar, volatile LAS unsigned* st) {
    XcdBarrier b; b.bar = bar; b.x = xb_xcc_id(); b.st = st;
    if (threadIdx.x == 0) (void)xb_add(&bar[XB_XCNT(b.x)], 1u);
    return b;
}
__device__ __forceinline__ void xcd_barrier_complete(unsigned* bar, unsigned x, unsigned& nloc, unsigned& nx) {
    const unsigned G = gridDim.x * gridDim.y * gridDim.z;
    unsigned sum, cnt, mine, sp = 0u;
    for (;;) {
        sum = 0u; cnt = 0u; mine = 0u;
#pragma unroll
        for (unsigned j = 0; j < 16; ++j) { const unsigned c = xb_ld(&bar[XB_XCNT(j)]); sum += c; cnt += (c > 0u) ? 1u : 0u; mine = (j == x) ? c : mine; }
        if (sum == G) break;
        __builtin_amdgcn_s_sleep(1);
        if ((++sp & 255u) == 0u) { if (xb_ld(&bar[XB_TMO])) break; if (sp > XB_SPIN_CAP) { atomicAdd(&bar[XB_TMO], 1u); break; } }
    }
    nloc = mine > 0u ? mine : 1u; nx = cnt > 0u ? cnt : 1u;
}
__device__ __forceinline__ void xcd_barrier(const XcdBarrier& b) {
    asm volatile("s_waitcnt vmcnt(0)" ::: "memory");
    __syncthreads();
    if (opaque_tid() == 0) {
        unsigned* bar = b.bar; asm volatile("" : "+s"(bar));
        __builtin_amdgcn_s_waitcnt(0);
        const unsigned bx = xb_xcc_id();
        unsigned nloc = b.st[0], nx = b.st[1];
        if (nloc == 0u) { xcd_barrier_complete(bar, bx, nloc, nx); b.st[0] = nloc; b.st[1] = nx; }
        const unsigned old = xb_add(&bar[XB_XSUB(bx)], 1u);
        const unsigned gen = old / nloc;
        if (old + 1u == (gen + 1u) * nloc) {
            __builtin_amdgcn_fence(__ATOMIC_RELEASE, "agent");
            asm volatile("s_waitcnt vmcnt(0)" ::: "memory");
            const unsigned og = xb_add(&bar[XB_TOP], 1u);
            const unsigned tg = og / nx;
            if (og + 1u == (tg + 1u) * nx) xb_add(&bar[XB_TOPGEN], 1u);
            else XB_SPIN(xb_ld(&bar[XB_TOPGEN]) == tg, bar);
            __builtin_amdgcn_fence(__ATOMIC_ACQUIRE, "agent");
            xb_add(&bar[XB_XGEN(bx)], 1u);
            asm volatile("s_waitcnt vmcnt(0)" ::: "memory");
        } else {
            XB_SPIN(xb_ld(&bar[XB_XGEN(bx)]) == gen, bar);
            __builtin_amdgcn_fence(__ATOMIC_ACQUIRE, "agent");
            asm volatile("s_waitcnt vmcnt(0)" ::: "memory");
        }
    }
    __syncthreads();
}
__device__ __forceinline__ void gsync_cg(cg::grid_group& g) {
    __builtin_amdgcn_fence(__ATOMIC_RELEASE, "agent");
    asm volatile("s_waitcnt vmcnt(0) lgkmcnt(0)" ::: "memory");
    g.sync();
    __builtin_amdgcn_fence(__ATOMIC_ACQUIRE, "agent");
    asm volatile("s_waitcnt vmcnt(0)" ::: "memory");
}
#define gsync(g) xcd_barrier(xbar)
__global__ void __launch_bounds__(NTHREADS, 2) fwd_megakernel(Params p) {
    extern __shared__ __attribute__((aligned(16))) unsigned char shm[];
    cg::grid_group grid = cg::this_grid();
    LAS unsigned char* shl = (LAS unsigned char*)shm;
    pg8::StaticOrder S;
    volatile LAS unsigned* xst = (volatile LAS unsigned*)(shl + LDS_BYTES - 16);
    if (threadIdx.x == 0) { xst[0] = 0u; xst[1] = 0u; }
    __syncthreads();
    const XcdBarrier xbar = xcd_barrier_post((unsigned*)(p.ws + WS_BAR), xst);

    grid.sync();
    prep_phase(shm, p);
    gsync(grid);
    prepb_phase(p);
    gsync(grid);
#pragma unroll 1
    for (int layer = 0; layer < 4; ++layer) {
        int z = 0; asm volatile("" : "+s"(z));
        unsigned char* ws = p.ws + z; float* yo = p.out + z;
        bf16_t* H = (bf16_t*)(ws + WS_H); bf16_t* P = (bf16_t*)(ws + WS_P);
        const float* mod = (const float*)(ws + WS_MOD);
        float* RS = (float*)(ws + WS_RSS);
        LAS float* RSL = (LAS float*)(shl + 128 * 1024);
        const float* avec = (const float*)(ws + WS_AVEC); const float* cvec = (const float*)(ws + WS_CVEC);
        const int kind = layer % 3, j = layer / 3;
        const float* mod_l = mod + (size_t)layer * 32 * ADA;
        const float* yin_p = layer == 0 ? p.in[0 + z] : yo; const float* yin_s = layer == 0 ? p.in[1 + z] : yo + O_YS;
        const float* cv_mix = cvec + (size_t)32 * stage_cvoff(2 * layer); const float* cv_mlp = cvec + (size_t)32 * stage_cvoff(2 * layer + 1);
        const bf16_t* WoT; int Ko, lda_o; const bf16_t* Ao;
        if (kind == 0) {
            { pg8::Gemm g{H, (const bf16_t*)(ws + WS_GIN) + (size_t)j * GLA_N * D, MP, GLA_N, D, D}; S.init(MP, GLA_N, opaque_nwg(), opaque_bid());
              pg8::EpiBf16 E{P, GLA_N, 0, 3072, p.in[20 + z] + j * 512, RS, cv_mix, RSL}; pg8::rs_stage(S, RS, 0, RSL); pg8::gemm_phase(shl, g, S, E); pg8::gemm_sample(shm, g, E); }
            gsync(grid);
            recur_phase<GLA_DK, GLA_DV, true>(shm, P, GLA_N, 0, 512, 1024, 3072, layer == 0 ? p.in[2 + z] : p.in[6 + z], yo + (layer == 0 ? O_G0P : O_G3P), yo + (layer == 0 ? O_G0S : O_G3S));
            gsync(grid);
            post_phase<GLA_DV, true>(P, GLA_N, 1024, 2048, p.in[22 + z] + j * GLA_DV);
            WoT = (const bf16_t*)(ws + WS_GO) + (size_t)j * D * D; Ko = D; lda_o = GLA_N; Ao = P + 2048;
        } else if (kind == 1) {
            { pg8::Gemm g{H, (const bf16_t*)(ws + WS_RIN), MP, RET_N, D, D}; S.init(MP, RET_N, opaque_nwg(), opaque_bid());
              pg8::EpiBf16 E{P, RET_N, 0, 1 << 30, nullptr, RS, cv_mix, RSL}; pg8::rs_stage(S, RS, 0, RSL); pg8::gemm_phase(shl, g, S, E); pg8::gemm_sample(shm, g, E); }
            gsync(grid);
            recur_phase<RET_DK, RET_DV, false>(shm, P, RET_N, 0, 1024, 2048, 0, p.in[3 + z], yo + O_RP, yo + O_RS);
            gsync(grid);
            post_phase<RET_DV, false>(P, RET_N, 2048, 4096, nullptr);
            WoT = (const bf16_t*)(ws + WS_RO); Ko = 2048; lda_o = RET_N; Ao = P + 4096;
        } else {
            { pg8::Gemm g{H, (const bf16_t*)(ws + WS_SIN), MP, SWA_N, D, D}; S.init(MP, SWA_N, opaque_nwg(), opaque_bid());
              pg8::EpiBf16 E{P, SWA_N, 0, 1 << 30, nullptr, RS, cv_mix, RSL}; pg8::rs_stage(S, RS, 0, RSL); pg8::gemm_phase(shl, g, S, E); pg8::gemm_sample(shm, g, E); }
            gsync(grid);
            swa_phase(shm, p, P, z);
            WoT = (const bf16_t*)(ws + WS_SO); Ko = D; lda_o = SWA_N; Ao = P;
        }
        gsync(grid);
        { pg8::Gemm g{Ao, WoT, MP, D, Ko, lda_o}; S.init(MP, D, opaque_nwg(), opaque_bid());
          pg8::EpiRes E{yin_p, yin_s, yo, mod_l + 2 * D, H, avec + (size_t)(2 * layer + 1) * 32 * D, RS}; pg8::gemm_phase(shl, g, S, E); pg8::gemm_sample(shm, g, E); }
        gsync(grid);
        { pg8::Gemm g{H, (const bf16_t*)(ws + WS_W1T) + (size_t)layer * HID * D, MP, HID, D, D}; S.init(MP, HID, opaque_nwg(), opaque_bid());
          pg8::EpiBf16 E{P, HID, 1, 1 << 30, nullptr, RS, cv_mlp, RSL}; pg8::rs_stage(S, RS, 0, RSL); pg8::gemm_phase(shl, g, S, E); pg8::gemm_sample(shm, g, E); }
        gsync(grid);
        { pg8::Gemm g{P, (const bf16_t*)(ws + WS_W2T) + (size_t)layer * HID * D, MP, D, HID, HID}; S.init(MP, D, opaque_nwg(), opaque_bid());
          pg8::EpiRes E{yo, yo + O_YS, yo, mod_l + 5 * D, layer < 3 ? H : nullptr, avec + (size_t)(layer < 3 ? 2 * layer + 2 : 0) * 32 * D, RS}; pg8::gemm_phase(shl, g, S, E); pg8::gemm_sample(shm, g, E); }
        gsync(grid);
    }
}

extern "C" void kernel_launch(void* const* d_in, const int* in_sizes, int n_in, void* d_out, int out_size, void* d_ws, size_t ws_size, hipStream_t stream) {
    static int grid_blocks = 0;
    if (grid_blocks == 0) {
        if (n_in != 34 || (size_t)out_size != O_END || ws_size < WS_END) { fprintf(stderr, "kernel_launch: unexpected sizes n_in %d out %d ws %zu (need %zu)\n", n_in, out_size, ws_size, (size_t)WS_END); grid_blocks = -1; return; }
        int dev = 0, cus = 0, per_cu = 0;
        hipGetDevice(&dev);
        hipDeviceGetAttribute(&cus, hipDeviceAttributeMultiprocessorCount, dev);
        if (hipFuncSetAttribute((const void*)fwd_megakernel, hipFuncAttributeMaxDynamicSharedMemorySize, LDS_BYTES) != hipSuccess) { fprintf(stderr, "kernel_launch: hipFuncSetAttribute failed\n"); grid_blocks = -1; return; }
        hipOccupancyMaxActiveBlocksPerMultiprocessor(&per_cu, (const void*)fwd_megakernel, NTHREADS, LDS_BYTES);
        if (per_cu < 1) { fprintf(stderr, "kernel_launch: occupancy query says %d blocks per CU\n", per_cu); grid_blocks = -1; return; }
        grid_blocks = cus * per_cu;
    }
    if (grid_blocks < 0) return;
    Params p{};
    for (int i = 0; i < 34; ++i) p.in[i] = (const float*)d_in[i];
    p.out = (float*)d_out; p.ws = (unsigned char*)d_ws;
    unsigned char* ws = (unsigned char*)d_ws;
    int nj = 0, tiles = 0;
    auto add = [&](const float* src, bf16_t* dst, int K, int N, float scale) { TJob& j = p.jobs[nj++]; j.src = src; j.dst = dst; j.K = K; j.N = N; j.tile0 = tiles; j.scale = scale; tiles += (K / 64) * (N / 128); };
    for (int l = 0; l < 4; ++l) {
        add(p.in[13] + (size_t)l * D * HID, (bf16_t*)(ws + WS_W1T) + (size_t)l * HID * D, D, HID, 1.0f);
        add(p.in[14] + (size_t)l * HID * D, (bf16_t*)(ws + WS_W2T) + (size_t)l * HID * D, HID, D, 1.0f);
    }
    for (int j = 0; j < 2; ++j) {
        bf16_t* gin = (bf16_t*)(ws + WS_GIN) + (size_t)j * GLA_N * D;
        add(p.in[15] + (size_t)j * D * 512, gin, D, 512, 0.08838834764831845f);
        add(p.in[16] + (size_t)j * D * 512, gin + (size_t)512 * D, D, 512, 1.0f);
        add(p.in[17] + (size_t)j * D * D, gin + (size_t)1024 * D, D, D, 1.0f);
        add(p.in[21] + (size_t)j * D * D, gin + (size_t)2048 * D, D, D, 1.0f);
        add(p.in[23] + (size_t)j * D * D, (bf16_t*)(ws + WS_GO) + (size_t)j * D * D, D, D, 1.0f);
    }
    {
        bf16_t* rin = (bf16_t*)(ws + WS_RIN);
        add(p.in[24], rin, D, D, 1.0f);
        add(p.in[25], rin + (size_t)1024 * D, D, D, 0.0625f);
        add(p.in[26], rin + (size_t)2048 * D, D, 2048, 1.0f);
        add(p.in[27], rin + (size_t)4096 * D, D, 2048, 1.0f);
        add(p.in[28], (bf16_t*)(ws + WS_RO), 2048, D, 1.0f);
    }
    add(p.in[29], (bf16_t*)(ws + WS_SIN), D, SWA_N, 1.0f);
    add(p.in[33], (bf16_t*)(ws + WS_SO), D, D, 1.0f);
    p.ntiles = tiles;
    if (hipMemsetAsync(ws + WS_BAR, 0, WS_BAR_BYTES, stream) != hipSuccess) { fprintf(stderr, "kernel_launch: memset of barrier words failed\n"); return; }
    void* args[] = {&p};
    hipError_t e = hipLaunchCooperativeKernel((const void*)fwd_megakernel, dim3(grid_blocks), dim3(NTHREADS), args, LDS_BYTES, stream);
    if (e != hipSuccess) fprintf(stderr, "kernel_launch: cooperative launch failed: %s (grid %d)\n", hipGetErrorString(e), grid_blocks);
}
```

```cpp
#include <hip/hip_runtime.h>
#include <hip/hip_cooperative_groups.h>
#include <cstdio>
#include <cstdint>
namespace cg = cooperative_groups;

#define LAS __attribute__((address_space(3)))
typedef unsigned short bf16_t;
typedef short bf16x8 __attribute__((ext_vector_type(8)));
typedef float f32x4 __attribute__((ext_vector_type(4)));
typedef unsigned u32x4 __attribute__((ext_vector_type(4)));
typedef unsigned u32x2 __attribute__((ext_vector_type(2)));

constexpr int D = 1024, NB = 16, SEQ = 4096, DSEQ = 16, MP = NB * SEQ, MS = NB * DSEQ, MT = MP + MS;
constexpr int HID = 4096, ADA = 6 * D;
constexpr int GLA_H = 4, GLA_DK = 128, GLA_DV = 256, GLA_N = 3584;
constexpr int RET_H = 4, RET_DK = 256, RET_DV = 512, RET_N = 6144;
constexpr int SWA_N = 1536;
constexpr int NTHREADS = 512;
constexpr int LDS_BYTES = 160 * 1024;
constexpr int DBG_LAYER_MASK = 0xF; constexpr bool DBG_MIXER = true, DBG_MLP = true; constexpr int DBG_SKIP = 0; constexpr bool DBG_FRESH_O = false; constexpr int PROBE_DUP_MIXER = 0, PROBE_DUP_GEMM = 0, PROBE_DUP_MOD = 0;

constexpr size_t O_YP = 0, O_YS = O_YP + (size_t)MP * D, O_G0P = O_YS + (size_t)MS * D, O_G0S = O_G0P + (size_t)NB * 4 * 128 * 256,
                 O_RP = O_G0S + (size_t)NB * 4 * 128 * 256, O_RS = O_RP + (size_t)NB * 4 * 256 * 512, O_KP = O_RS + (size_t)NB * 4 * 256 * 512,
                 O_VP = O_KP + (size_t)NB * 128 * 256, O_KS = O_VP + (size_t)NB * 128 * 256, O_VS = O_KS + (size_t)NB * 16 * 256,
                 O_G3P = O_VS + (size_t)NB * 16 * 256, O_G3S = O_G3P + (size_t)NB * 4 * 128 * 256, O_END = O_G3S + (size_t)NB * 4 * 128 * 256;

constexpr size_t WS_W1T = 0;
constexpr size_t WS_W2T = WS_W1T + (size_t)4 * HID * D * 2;
constexpr size_t WS_GIN = WS_W2T + (size_t)4 * HID * D * 2;
constexpr size_t WS_GO  = WS_GIN + (size_t)2 * GLA_N * D * 2;
constexpr size_t WS_RIN = WS_GO + (size_t)2 * D * D * 2;
constexpr size_t WS_RO  = WS_RIN + (size_t)RET_N * D * 2;
constexpr size_t WS_SIN = WS_RO + (size_t)D * 2048 * 2;
constexpr size_t WS_SO  = WS_SIN + (size_t)SWA_N * D * 2;
constexpr size_t WS_MOD = WS_SO + (size_t)D * D * 2;
constexpr size_t WS_H   = WS_MOD + (size_t)4 * 32 * ADA * 4;
constexpr size_t WS_P   = WS_H + (size_t)MT * D * 2;
constexpr size_t WS_AVEC = WS_P + (size_t)MT * RET_N * 2;
constexpr size_t WS_CVEC = WS_AVEC + (size_t)8 * 32 * D * 4;
constexpr int CVEC_TOTAL_N = 2 * GLA_N + RET_N + SWA_N + 4 * HID;
constexpr size_t WS_RSS = WS_CVEC + (size_t)32 * CVEC_TOTAL_N * 4;
constexpr size_t WS_BAR = WS_RSS + (size_t)MP * 16 * 4 + (size_t)MS * 64 * 4;
constexpr size_t WS_BAR_BYTES = 16384;
constexpr size_t WS_END = WS_BAR + WS_BAR_BYTES;

struct TJob { const float* src; bf16_t* dst; int K, N, tile0; float scale; };
constexpr int NJOBS = 25;
struct Params {
    const float* in[34];
    float* out;
    unsigned char* ws;
    TJob jobs[NJOBS];
    int ntiles; int pad0;
};

typedef __bf16 bf16x2_t __attribute__((ext_vector_type(2)));
typedef float f32x2_t __attribute__((ext_vector_type(2)));
__device__ __forceinline__ unsigned cvt_pk_bf16(float lo, float hi) { const f32x2_t v = {lo, hi}; const bf16x2_t r = __builtin_convertvector(v, bf16x2_t); return __builtin_bit_cast(unsigned, r); }
__device__ __forceinline__ float bf_lo(unsigned u) { return __uint_as_float(u << 16); }
__device__ __forceinline__ float bf_hi(unsigned u) { return __uint_as_float(u & 0xffff0000u); }
__device__ __forceinline__ float silu_f(float x) { return x / (1.0f + __expf(-x)); }
__device__ __forceinline__ int seq_of_row(int r) { return r < MP ? (r >> 12) : 16 + ((r - MP) >> 4); }
__device__ __forceinline__ int opaque_tid() { int t = threadIdx.x; asm volatile("" : "+v"(t)); return t; }
__device__ __forceinline__ int opaque_bid() { int t = blockIdx.x; asm volatile("" : "+s"(t)); return t; }
__device__ __forceinline__ int opaque_nwg() { int t = gridDim.x; asm volatile("" : "+s"(t)); return t; }
__device__ __forceinline__ float wave_sum(float v) {
#pragma unroll
    for (int o = 32; o > 0; o >>= 1) v += __shfl_xor(v, o);
    return v;
}

namespace pg8 {
constexpr int BM = 256, BK = 64, HALF = 128, HTB = HALF * BK * 2, STAGE_BYTES = 8 * HTB, NXCD = 8, WGM = 8;
__host__ __device__ __forceinline__ int lds_byte(int r, int c) { const int st = (r >> 4) * 2 + (c >> 5), rr = r & 15, cc = c & 31, ob = rr * 64 + cc * 2; return st * 1024 + (ob ^ (((ob >> 9) & 1) << 5)); }
__host__ __device__ __forceinline__ void stage_rc(int b, int& R, int& C) { const int st = b / 1024, sb = b % 1024, swz = sb ^ (((sb >> 9) & 1) << 5); R = (st >> 1) * 16 + swz / 64; C = (st & 1) * 32 + (swz % 64) / 2; }
__host__ __device__ __forceinline__ int perm32(int rho) { const int n = rho >> 4, i = rho & 15; return 8 * (i >> 2) + 4 * n + (i & 3); }
struct Unit { int pm, pn; };
struct Gemm { const bf16_t* A; const bf16_t* Bt; int M, N, K, lda; };
struct StaticOrder {
    int nM, nN, nwg, G, c;
    __device__ void init(int M, int N, int G_, int c_) { nM = M / BM; nN = N / BM; nwg = nM * nN; G = G_; c = c_; }
    __device__ bool next(int i, Unit& u) const {
        const long L = (long)i * G + c; if (L >= nwg) return false;
        int wgid = (int)L; { const int q = nwg / NXCD, r = nwg % NXCD, xcd = wgid % NXCD, off = wgid / NXCD; wgid = (xcd < r ? xcd * (q + 1) : r * (q + 1) + (xcd - r) * q) + off; }
        const int nig = WGM * nN, gid = wgid / nig, fm = gid * WGM, gsz = (nM - fm) < WGM ? (nM - fm) : WGM;
        u.pm = fm + ((wgid % nig) % gsz); u.pn = (wgid % nig) / gsz; return true;
    }
};

template <class Epi, bool ALIGN_EPI = true, bool SP2 = true>
__device__ __forceinline__ void gemm_phase(LAS unsigned char* lds, const Gemm g, const StaticOrder& S, const Epi& E) {
    const int tid = opaque_tid(), wid = __builtin_amdgcn_readfirstlane(tid >> 6), lane = tid & 63, wr = wid >> 2, wc = wid & 3, fr = lane & 15, fq = lane >> 4;
    const int K = g.K, nt = K / BK, lda = g.lda;
    unsigned voffA[2], voffB[2];
#pragma unroll
    for (int i = 0; i < 2; ++i) { int R, C; stage_rc(tid * 16 + i * 8192, R, C); const int Rb = Epi::PERM ? ((R & ~31) + perm32(R & 31)) : R;
        voffA[i] = (unsigned)(R * lda + C) * 2u; voffB[i] = (unsigned)(Rb * K + C) * 2u; }
    const size_t kstep = (size_t)(BK * 2);
    const size_t hstepA = (size_t)HALF * lda * 2, hstepB = (size_t)HALF * K * 2;
    const size_t tstepA = 2 * hstepA, tstepB = 2 * hstepB;
    const unsigned ldsw = (unsigned)wid * 1024u;
    const int aoff = lds_byte(wr * 64 + fr, fq * 8), boff = lds_byte(wc * 32 + fr, fq * 8);
#define PG8_SA(b, h) (((b) * 2 + (h)) * HTB)
#define PG8_SB(b, h) ((4 + (b) * 2 + (h)) * HTB)
#define PG8_STAGE(bufoff, gbase, voff) do { _Pragma("unroll") for (int _i = 0; _i < 2; ++_i) \
        __builtin_amdgcn_global_load_lds((const unsigned*)((const char*)(gbase) + (voff)[_i]), (LAS unsigned*)(lds + (bufoff) + ldsw + _i * 8192), 16, 0, 0); } while (0)
#define PG8_LDA(dst, b, h) do { _Pragma("unroll") for (int m = 0; m < 4; ++m) _Pragma("unroll") for (int k = 0; k < 2; ++k) dst[m][k] = *(const LAS bf16x8*)(lds + PG8_SA(b, h) + aoff + m * 2048 + k * 1024); } while (0)
#define PG8_LDB(dst, b, h) do { _Pragma("unroll") for (int n = 0; n < 2; ++n) _Pragma("unroll") for (int k = 0; k < 2; ++k) dst[n][k] = *(const LAS bf16x8*)(lds + PG8_SB(b, h) + boff + n * 2048 + k * 1024); } while (0)
#define PG8_MMA(ai, bj, At, Bt) do { __builtin_amdgcn_s_setprio(1); _Pragma("unroll") for (int m = 0; m < 4; ++m) _Pragma("unroll") for (int n = 0; n < 2; ++n) _Pragma("unroll") for (int k = 0; k < 2; ++k) \
        acc[ai][bj][m][n] = __builtin_amdgcn_mfma_f32_16x16x32_bf16(Bt[n][k], At[m][k], acc[ai][bj][m][n], 0, 0, 0); __builtin_amdgcn_s_setprio(0); } while (0)
#define PG8_WAIT_V(n) asm volatile("s_waitcnt vmcnt(" #n ")" ::: "memory")
#define PG8_WAIT_L(n) asm volatile("s_waitcnt lgkmcnt(" #n ")" ::: "memory")
#define PG8_BAR __builtin_amdgcn_s_barrier()
#define PG8_SCHED __builtin_amdgcn_sched_barrier(0)
    Unit cur, nxt; int ui = 0;
    if (!S.next(0, cur)) return;
    f32x4 acc[2][2][4][2];
#pragma unroll
    for (int a = 0; a < 2; ++a)
#pragma unroll
        for (int b = 0; b < 2; ++b)
#pragma unroll
            for (int m = 0; m < 4; ++m)
#pragma unroll
                for (int n = 0; n < 2; ++n) acc[a][b][m][n] = (f32x4){0.f, 0.f, 0.f, 0.f};
    bf16x8 At[4][2], B0[2][2], B1[2][2];
    const char* cA = (const char*)g.A + (size_t)cur.pm * tstepA; const char* cB = (const char*)g.Bt + (size_t)cur.pn * tstepB;
    if constexpr (SP2) {
        PG8_STAGE(PG8_SB(0, 0), cB, voffB); PG8_STAGE(PG8_SB(0, 1), cB + hstepB, voffB); PG8_STAGE(PG8_SA(0, 0), cA, voffA); PG8_STAGE(PG8_SA(0, 1), cA + hstepA, voffA);
        if (wr == 1) PG8_BAR;
        PG8_WAIT_V(2); PG8_BAR;
        PG8_STAGE(PG8_SB(1, 0), cB + kstep, voffB); PG8_STAGE(PG8_SA(1, 0), cA + kstep, voffA); PG8_STAGE(PG8_SB(1, 1), cB + hstepB + kstep, voffB);
        PG8_WAIT_V(6); PG8_BAR;
    } else {
        PG8_STAGE(PG8_SB(0, 0), cB, voffB); PG8_STAGE(PG8_SA(0, 0), cA, voffA); PG8_STAGE(PG8_SB(0, 1), cB + hstepB, voffB); PG8_STAGE(PG8_SA(0, 1), cA + hstepA, voffA);
        if (wr == 1) PG8_BAR;
        PG8_WAIT_V(4); PG8_BAR;
        PG8_STAGE(PG8_SB(1, 0), cB + kstep, voffB); PG8_STAGE(PG8_SA(1, 0), cA + kstep, voffA); PG8_STAGE(PG8_SB(1, 1), cB + hstepB + kstep, voffB);
        PG8_WAIT_V(6); PG8_BAR;
    }
    for (;;) {
        const bool has_next = S.next(ui + 1, nxt);
        const char* nA = has_next ? (const char*)g.A + (size_t)nxt.pm * tstepA : cA; const char* nB = has_next ? (const char*)g.Bt + (size_t)nxt.pn * tstepB : cB;
        for (int t = 0; t < nt; t += 2) {
            const bool last = (t == nt - 2);
            const char* a1 = cA + (size_t)(t + 1) * kstep;
            const char* a2 = last ? nA : cA + (size_t)(t + 2) * kstep; const char* b2 = last ? nB : cB + (size_t)(t + 2) * kstep;
            const char* a3 = a2 + kstep; const char* b3 = b2 + kstep;
            if constexpr (SP2) {
            PG8_LDB(B0, 0, 0); PG8_LDB(B1, 0, 1); PG8_SCHED; PG8_LDA(At, 0, 0); PG8_STAGE(PG8_SA(1, 1), a1 + hstepA, voffA);
            PG8_WAIT_V(8); PG8_WAIT_L(0); PG8_BAR; PG8_MMA(0, 0, At, B0); PG8_MMA(0, 1, At, B1); PG8_BAR; PG8_SCHED;
            PG8_LDA(At, 0, 1); PG8_STAGE(PG8_SB(0, 0), b2, voffB); PG8_STAGE(PG8_SB(0, 1), b2 + hstepB, voffB); PG8_STAGE(PG8_SA(0, 0), a2, voffA);
            PG8_WAIT_V(8); PG8_WAIT_L(0); PG8_BAR; PG8_MMA(1, 0, At, B0); PG8_MMA(1, 1, At, B1); PG8_BAR; PG8_SCHED;
            PG8_LDB(B0, 1, 0); PG8_LDB(B1, 1, 1); PG8_SCHED; PG8_LDA(At, 1, 0); PG8_STAGE(PG8_SA(0, 1), a2 + hstepA, voffA);
            PG8_WAIT_V(8); PG8_WAIT_L(0); PG8_BAR; PG8_MMA(0, 0, At, B0); PG8_MMA(0, 1, At, B1); PG8_BAR; PG8_SCHED;
            PG8_LDA(At, 1, 1); PG8_STAGE(PG8_SB(1, 0), b3, voffB); PG8_STAGE(PG8_SB(1, 1), b3 + hstepB, voffB); PG8_STAGE(PG8_SA(1, 0), a3, voffA);
            PG8_WAIT_V(8); PG8_WAIT_L(0); PG8_BAR; PG8_MMA(1, 0, At, B0); PG8_MMA(1, 1, At, B1); PG8_BAR; PG8_SCHED;
            } else {
            PG8_LDB(B0, 0, 0); PG8_SCHED; PG8_LDA(At, 0, 0); PG8_STAGE(PG8_SA(1, 1), a1 + hstepA, voffA);
            PG8_WAIT_L(8); PG8_BAR; PG8_WAIT_L(0); PG8_MMA(0, 0, At, B0); PG8_BAR; PG8_SCHED;
            PG8_LDB(B1, 0, 1); PG8_STAGE(PG8_SB(0, 0), b2, voffB);
            PG8_BAR; PG8_WAIT_L(0); PG8_MMA(0, 1, At, B1); PG8_BAR;
            PG8_LDA(At, 0, 1); PG8_STAGE(PG8_SA(0, 0), a2, voffA);
            PG8_BAR; PG8_WAIT_L(0); PG8_MMA(1, 0, At, B0); PG8_BAR; PG8_SCHED;
            PG8_STAGE(PG8_SB(0, 1), b2 + hstepB, voffB);
            PG8_WAIT_V(6); PG8_BAR; PG8_MMA(1, 1, At, B1); PG8_BAR;
            PG8_LDB(B0, 1, 0); PG8_SCHED; PG8_LDA(At, 1, 0); PG8_STAGE(PG8_SA(0, 1), a2 + hstepA, voffA);
            PG8_WAIT_L(8); PG8_BAR; PG8_WAIT_L(0); PG8_MMA(0, 0, At, B0); PG8_BAR; PG8_SCHED;
            PG8_LDB(B1, 1, 1); PG8_STAGE(PG8_SB(1, 0), b3, voffB);
            PG8_BAR; PG8_WAIT_L(0); PG8_MMA(0, 1, At, B1); PG8_BAR;
            PG8_LDA(At, 1, 1); PG8_STAGE(PG8_SA(1, 0), a3, voffA);
            PG8_BAR; PG8_WAIT_L(0); PG8_MMA(1, 0, At, B0); PG8_BAR; PG8_SCHED;
            PG8_STAGE(PG8_SB(1, 1), b3 + hstepB, voffB);
            PG8_WAIT_V(6); PG8_BAR; PG8_MMA(1, 1, At, B1); PG8_BAR;
            }
        }
        if constexpr (ALIGN_EPI) { if (wr == 0) PG8_BAR; }
        E(acc, cur, wr, wc, fr, fq, ui);
        if (!has_next) break;
#pragma unroll
        for (int a = 0; a < 2; ++a)
#pragma unroll
            for (int b = 0; b < 2; ++b)
#pragma unroll
                for (int m = 0; m < 4; ++m)
#pragma unroll
                    for (int n = 0; n < 2; ++n) acc[a][b][m][n] = (f32x4){0.f, 0.f, 0.f, 0.f};
        cur = nxt; cA = nA; cB = nB; ++ui;
        if constexpr (ALIGN_EPI) { if (wr == 1) PG8_BAR; }
    }
    PG8_WAIT_V(0);
    if constexpr (!ALIGN_EPI) { if (wr == 0) PG8_BAR; }
    PG8_BAR;
#undef PG8_SA
#undef PG8_SB
#undef PG8_STAGE
#undef PG8_LDA
#undef PG8_LDB
#undef PG8_MMA
#undef PG8_WAIT_V
#undef PG8_WAIT_L
#undef PG8_BAR
#undef PG8_SCHED
}

__device__ __forceinline__ float row_rs(const float* rss, int r) {
    float t;
    if (r < MP) { const f32x4* q = (const f32x4*)(rss + (size_t)r * 16); const f32x4 a = q[0] + q[1] + q[2] + q[3]; t = (a[0] + a[1]) + (a[2] + a[3]); }
    else { const f32x4* q = (const f32x4*)(rss + (size_t)MP * 16 + (size_t)(r - MP) * 64); f32x4 a = q[0];
#pragma unroll
        for (int i = 1; i < 16; ++i) a += q[i];
        t = (a[0] + a[1]) + (a[2] + a[3]); }
    return rsqrtf(t * (1.0f / D) + 1e-6f);
}
__device__ __forceinline__ float logsig16(float x) { return (fminf(x, 0.f) - __logf(1.0f + __expf(-fabsf(x)))) * (1.0f / 16.0f); }
__device__ __forceinline__ void rs_stage(const StaticOrder& S, const float* rowss, int rbase, LAS float* rsl) {
    const int tid = opaque_tid();
    int nu = 0; { Unit u; while (nu < 24 && S.next(nu, u)) ++nu; }
    __syncthreads();
    for (int idx = tid; idx < nu * 256; idx += NTHREADS) { Unit u; S.next(idx >> 8, u);
        const f32x4* q = (const f32x4*)(rowss + (size_t)(rbase + u.pm * BM + (idx & 255)) * 16);
        const f32x4 a = (q[0] + q[1]) + (q[2] + q[3]);
        rsl[idx] = rsqrtf(((a[0] + a[1]) + (a[2] + a[3])) * (1.0f / D) + 1e-6f); }
    __syncthreads();
}
struct EpiBf16 {
    static constexpr bool PERM = true;
    bf16_t* O; int ldc; int mode; int gate_lo; const float* bias; const float* rowss; const float* cvec;
    const LAS float* rsl;
    __device__ __forceinline__ void tile4(int r, int c, f32x4 v) const {
        const float rs = row_rs(rowss, r);
        v = v * rs + *(const f32x4*)(cvec + (size_t)seq_of_row(r) * ldc + c);
        if (mode == 1) {
#pragma unroll
            for (int j = 0; j < 4; ++j) { const float a = fmaxf(v[j], 0.f); v[j] = a * a; } }
        if (c >= gate_lo) { const f32x4 b = *(const f32x4*)(bias + (c - gate_lo));
#pragma unroll
            for (int j = 0; j < 4; ++j) v[j] = logsig16(v[j] + b[j]); }
        u32x2 w; w.x = cvt_pk_bf16(v[0], v[1]); w.y = cvt_pk_bf16(v[2], v[3]);
        *(u32x2*)(O + (size_t)r * ldc + c) = w;
    }
    __device__ __forceinline__ void operator()(const f32x4 (&acc)[2][2][4][2], const Unit& u, int wr, int wc, int fr, int fq, int ui) const {
        const int row0 = u.pm * BM + wr * 64 + fr, colt = u.pn * BM, col0 = colt + wc * 32 + 8 * fq;
        const bool gate = colt >= gate_lo;
        const float* cvp = cvec + (size_t)seq_of_row(u.pm * BM) * ldc + col0;
        f32x4 bv[2][2];
#pragma unroll
        for (int bj = 0; bj < 2; ++bj)
#pragma unroll
            for (int n = 0; n < 2; ++n) { bv[bj][n] = *(const f32x4*)(cvp + bj * HALF + 4 * n); if (gate) bv[bj][n] += *(const f32x4*)(bias + (col0 - gate_lo) + bj * HALF + 4 * n); }
#pragma unroll
        for (int ai = 0; ai < 2; ++ai) {
#pragma unroll
            for (int m = 0; m < 4; ++m) { const int r = row0 + ai * HALF + m * 16; bf16_t* rowp = O + (size_t)r * ldc + col0;
                const float rs = rsl[ui * 256 + wr * 64 + fr + ai * HALF + m * 16];
#pragma unroll
                for (int bj = 0; bj < 2; ++bj) { f32x4 v0 = acc[ai][bj][m][0] * rs + bv[bj][0], v1 = acc[ai][bj][m][1] * rs + bv[bj][1];
                    if (mode == 1) {
#pragma unroll
                        for (int j = 0; j < 4; ++j) { const float a = fmaxf(v0[j], 0.f), b = fmaxf(v1[j], 0.f); v0[j] = a * a; v1[j] = b * b; } }
                    if (gate) {
#pragma unroll
                        for (int j = 0; j < 4; ++j) { v0[j] = logsig16(v0[j]); v1[j] = logsig16(v1[j]); } }
                    u32x4 w; w.x = cvt_pk_bf16(v0[0], v0[1]); w.y = cvt_pk_bf16(v0[2], v0[3]); w.z = cvt_pk_bf16(v1[0], v1[1]); w.w = cvt_pk_bf16(v1[2], v1[3]);
                    *(u32x4*)(rowp + bj * HALF) = w; } } }
    }
};
struct EpiRes {
    static constexpr bool PERM = false;
    const float* yin_p; const float* yin_s; float* yout; const float* gate;
    bf16_t* Hn; const float* av; float* rowss_next;
    __device__ __forceinline__ void tile4(int r, int c, f32x4 v) const {
        const int sq = seq_of_row(r);
        const f32x4 gv = *(const f32x4*)(gate + (size_t)sq * ADA + c), iv = *(const f32x4*)((r < MP ? yin_p + (size_t)r * D : yin_s + (size_t)(r - MP) * D) + c);
        const f32x4 y = iv + gv * v;
        *(f32x4*)(yout + (size_t)r * D + c) = y;
        if (Hn) {
            const f32x4 a = *(const f32x4*)(av + (size_t)sq * D + c);
            u32x2 w; w.x = cvt_pk_bf16(y[0] * a[0], y[1] * a[1]); w.y = cvt_pk_bf16(y[2] * a[2], y[3] * a[3]);
            *(u32x2*)(Hn + (size_t)r * D + c) = w;
            float ss = y[0] * y[0] + y[1] * y[1] + y[2] * y[2] + y[3] * y[3];
            ss += __shfl_xor(ss, 16); ss += __shfl_xor(ss, 32);
            if ((threadIdx.x & 48) == 0) rowss_next[(size_t)MP * 16 + (size_t)(r - MP) * 64 + (c >> 4)] = ss;
        }
    }
    __device__ __forceinline__ void operator()(const f32x4 (&acc)[2][2][4][2], const Unit& u, int wr, int wc, int fr, int fq, int ui) const {
        const int row0 = u.pm * BM + wr * 64 + fr, col0 = u.pn * BM + wc * 32 + 4 * fq;
        const int sq = seq_of_row(u.pm * BM);
        const float* gp = gate + (size_t)sq * ADA + col0;
        const float* avp = av + (size_t)sq * D + col0;
#pragma unroll
        for (int ai = 0; ai < 2; ++ai) {
            f32x4 yv[4][2][2];
#pragma unroll
            for (int m = 0; m < 4; ++m) { const float* ip = yin_p + (size_t)(row0 + ai * HALF + m * 16) * D + col0;
#pragma unroll
                for (int bj = 0; bj < 2; ++bj)
#pragma unroll
                    for (int n = 0; n < 2; ++n) yv[m][bj][n] = *(const f32x4*)(ip + bj * HALF + n * 16); }
            float ss[4] = {0.f, 0.f, 0.f, 0.f};
#pragma unroll
            for (int bj = 0; bj < 2; ++bj)
#pragma unroll
                for (int n = 0; n < 2; ++n) { const int co = bj * HALF + n * 16;
                    const f32x4 gv = *(const f32x4*)(gp + co), a = Hn ? *(const f32x4*)(avp + co) : (f32x4){0.f, 0.f, 0.f, 0.f};
#pragma unroll
                    for (int m = 0; m < 4; ++m) { const int r = row0 + ai * HALF + m * 16;
                        const f32x4 y = yv[m][bj][n] + gv * acc[ai][bj][m][n];
                        *(f32x4*)(yout + (size_t)r * D + col0 + co) = y;
                        if (Hn) { u32x2 w; w.x = cvt_pk_bf16(y[0] * a[0], y[1] * a[1]); w.y = cvt_pk_bf16(y[2] * a[2], y[3] * a[3]);
                            *(u32x2*)(Hn + (size_t)r * D + col0 + co) = w;
                            ss[m] += y[0] * y[0] + y[1] * y[1] + y[2] * y[2] + y[3] * y[3]; } } }
            if (Hn) {
#pragma unroll
                for (int m = 0; m < 4; ++m) { float t = ss[m]; t += __shfl_xor(t, 16); t += __shfl_xor(t, 32); if (fq == 0) rowss_next[(size_t)(row0 + ai * HALF + m * 16) * 16 + u.pn * 4 + wc] = t; } } }
    }
};

template <class Epi>
__device__ __forceinline__ void gemm_sample(unsigned char* lds, const Gemm g, const Epi& E) {
    const int tid = opaque_tid(), wid = tid >> 6, lane = tid & 63, g4 = lane >> 4, r16 = lane & 15;
    const int K = g.K, CT = g.N >> 8;
    f32x4* red = (f32x4*)lds;
    for (int v = opaque_bid(); v < 256; v += opaque_nwg()) {
        const int row = MP + (v & 15) * 16 + r16, colbase = (v >> 4) * (g.N >> 4);
        const bf16_t* ap = g.A + (size_t)row * g.lda + g4 * 8;
        if (CT == 4) {
            const int ct = wid & 3, kh = wid >> 2, k0 = kh * (K >> 1), k1 = k0 + (K >> 1);
            const bf16_t* bp = g.Bt + (size_t)(colbase + ct * 16 + r16) * K + g4 * 8;
            f32x4 acc = (f32x4){0.f, 0.f, 0.f, 0.f};
#pragma unroll 8
            for (int k = k0; k < k1; k += 32) acc = __builtin_amdgcn_mfma_f32_16x16x32_bf16(*(const bf16x8*)(bp + k), *(const bf16x8*)(ap + k), acc, 0, 0, 0);
            __syncthreads();
            if (kh == 1) red[ct * 64 + lane] = acc;
            __syncthreads();
            if (kh == 0) { acc += red[ct * 64 + lane]; E.tile4(row, colbase + ct * 16 + g4 * 4, acc); }
        } else {
            const int c0 = wid, c1 = wid + 8, c2 = wid + 16;
            const bool h1 = c1 < CT, h2 = c2 < CT;
            if (c0 < CT) {
                const bf16_t* bp0 = g.Bt + (size_t)(colbase + c0 * 16 + r16) * K + g4 * 8;
                const bf16_t* bp1 = g.Bt + (size_t)(colbase + (h1 ? c1 : c0) * 16 + r16) * K + g4 * 8;
                const bf16_t* bp2 = g.Bt + (size_t)(colbase + (h2 ? c2 : c0) * 16 + r16) * K + g4 * 8;
                f32x4 a0 = (f32x4){0.f, 0.f, 0.f, 0.f}, a1 = a0, a2 = a0;
#pragma unroll 4
                for (int k = 0; k < K; k += 32) { const bf16x8 av = *(const bf16x8*)(ap + k);
                    a0 = __builtin_amdgcn_mfma_f32_16x16x32_bf16(*(const bf16x8*)(bp0 + k), av, a0, 0, 0, 0);
                    a1 = __builtin_amdgcn_mfma_f32_16x16x32_bf16(*(const bf16x8*)(bp1 + k), av, a1, 0, 0, 0);
                    a2 = __builtin_amdgcn_mfma_f32_16x16x32_bf16(*(const bf16x8*)(bp2 + k), av, a2, 0, 0, 0); }
                E.tile4(row, colbase + c0 * 16 + g4 * 4, a0);
                if (h1) E.tile4(row, colbase + c1 * 16 + g4 * 4, a1);
                if (h2) E.tile4(row, colbase + c2 * 16 + g4 * 4, a2);
            }
        }
    }
}
}

#define MFMA16(a, b, c) __builtin_amdgcn_mfma_f32_16x16x32_bf16((a), (b), (c), 0, 0, 0)

__device__ __forceinline__ void prep_phase(unsigned char* lds, const Params& p) {
    const int tid = opaque_tid();
    {
        float* sc = (float*)lds;
        float* red = sc + 32 * 512;
        for (int u = opaque_bid(); u < 4 * 48; u += opaque_nwg()) {
            const int l = u / 48, cb = u % 48, col = cb * 128 + (tid & 127), kq = tid >> 7;
            const float* w = p.in[11] + (size_t)l * D * ADA + col;
            float a[32];
#pragma unroll
            for (int s = 0; s < 32; ++s) a[s] = 0.f;
#pragma unroll 1
            for (int half = 0; half < 2; ++half) {
                __syncthreads();
                for (int i = tid; i < 32 * 512; i += NTHREADS) { const int s = i >> 9, k = half * 512 + (i & 511); const float c = s < 16 ? p.in[7][s * D + k] : p.in[8][(s - 16) * D + k]; sc[i] = silu_f(c); }
                __syncthreads();
#pragma unroll 2
                for (int kl = kq * 128; kl < kq * 128 + 128; kl += 4) {
                    const int k = half * 512 + kl;
                    const float w0 = w[(size_t)k * ADA], w1 = w[(size_t)(k + 1) * ADA], w2 = w[(size_t)(k + 2) * ADA], w3 = w[(size_t)(k + 3) * ADA];
#pragma unroll
                    for (int s = 0; s < 32; ++s) { const f32x4 c4 = *(const f32x4*)(sc + s * 512 + kl); a[s] += c4[0] * w0 + c4[1] * w1 + c4[2] * w2 + c4[3] * w3; }
                }
            }
            if (kq > 0) {
#pragma unroll
                for (int s = 0; s < 32; ++s) red[((kq - 1) * 32 + s) * 128 + (tid & 127)] = a[s];
            }
            __syncthreads();
            if (kq == 0) {
                float* mo = (float*)(p.ws + WS_MOD) + (size_t)l * 32 * ADA + col;
                const float bias = p.in[12][(size_t)l * ADA + col];
#pragma unroll
                for (int s = 0; s < 32; ++s) { const int c = tid & 127; mo[(size_t)s * ADA] = a[s] + red[(0 * 32 + s) * 128 + c] + red[(1 * 32 + s) * 128 + c] + red[(2 * 32 + s) * 128 + c] + bias; }
            }
        }
        __syncthreads();
    }
    {
        const int gt = opaque_bid() * NTHREADS + tid, gn = opaque_nwg() * NTHREADS;
        for (int i = gt; i < 2 * 512 * 512; i += gn) {
            const int k2 = (i & 511) * 2, n = (i >> 9) & 511, j = i >> 18;
            const float* w1 = p.in[18] + (size_t)j * D * 16 + (size_t)k2 * 16; const float* w2 = p.in[19] + (size_t)j * 16 * 512 + n;
            float a0 = 0.f, a1 = 0.f;
#pragma unroll
            for (int r = 0; r < 16; ++r) { const float b = w2[r * 512]; a0 += w1[r] * b; a1 += w1[16 + r] * b; }
            bf16_t* dst = (bf16_t*)(p.ws + WS_GIN) + (size_t)j * GLA_N * D + (size_t)(3072 + n) * D + k2;
            *(unsigned*)dst = cvt_pk_bf16(a0, a1);
        }
    }
    {
        float* tl = (float*)lds;
        for (int t = opaque_bid(); t < p.ntiles; t += opaque_nwg()) {
            int j = 0;
#pragma unroll 1
            for (int q = 1; q < NJOBS; ++q) if (t >= p.jobs[q].tile0) j = q;
            const TJob jb = p.jobs[j];
            const int lt = t - jb.tile0, ntn = jb.N >> 7, k0 = (lt / ntn) << 6, n0 = (lt % ntn) << 7;
            __syncthreads();
#pragma unroll
            for (int i = 0; i < 16; ++i) { const int idx = tid + NTHREADS * i, r = idx >> 7, c = idx & 127; tl[c * 65 + r] = jb.src[(size_t)(k0 + r) * jb.N + n0 + c]; }
            __syncthreads();
#pragma unroll
            for (int i = 0; i < 8; ++i) { const int pi = tid + NTHREADS * i, n = pi >> 5, k2 = (pi & 31) * 2;
                *(unsigned*)(jb.dst + (size_t)(n0 + n) * jb.K + k0 + k2) = cvt_pk_bf16(tl[n * 65 + k2] * jb.scale, tl[n * 65 + k2 + 1] * jb.scale); }
        }
    }
}

__device__ __forceinline__ int stage_N(int s) { return (s & 1) ? HID : (s == 2) ? RET_N : (s == 4) ? SWA_N : GLA_N; }
__device__ __forceinline__ int stage_cvoff(int s) { return s == 0 ? 0 : s == 1 ? 3584 : s == 2 ? 7680 : s == 3 ? 13824 : s == 4 ? 17920 : s == 5 ? 19456 : s == 6 ? 23552 : 27136; }
__device__ __forceinline__ const bf16_t* stage_W(const unsigned char* ws, int s) {
    const int layer = s >> 1;
    if (s & 1) return (const bf16_t*)(ws + WS_W1T) + (size_t)layer * HID * D;
    return s == 2 ? (const bf16_t*)(ws + WS_RIN) : s == 4 ? (const bf16_t*)(ws + WS_SIN) : (const bf16_t*)(ws + WS_GIN) + (size_t)(layer / 3) * GLA_N * D;
}
__device__ __forceinline__ void prepb_phase(const Params& p) {
    const int tid = opaque_tid(), lane = tid & 63, wid = tid >> 6, g4 = lane >> 4, r16 = lane & 15;
    const float* mod = (const float*)(p.ws + WS_MOD);
    float* av = (float*)(p.ws + WS_AVEC);
    for (int i = opaque_bid() * NTHREADS + tid; i < 8 * 32 * D; i += opaque_nwg() * NTHREADS) { const int st = i >> 15, sq = (i >> 10) & 31, c = i & 1023, layer = st >> 1;
        const float g = ((st & 1) ? p.in[10] : p.in[9])[layer * D + c];
        av[i] = g * (1.0f + mod[((size_t)layer * 32 + sq) * ADA + ((st & 1) ? 4 : 1) * D + c]); }
    float* cvec = (float*)(p.ws + WS_CVEC);
    for (int it = opaque_bid() * 8 + wid; it < CVEC_TOTAL_N / 16; it += opaque_nwg() * 8) {
        const int ng = it * 16; int st = 0;
#pragma unroll
        for (int q = 1; q < 8; ++q) if (ng >= stage_cvoff(q)) st = q;
        const int n0 = ng - stage_cvoff(st), N = stage_N(st), layer = st >> 1;
        const bf16_t* wp = stage_W(p.ws, st) + (size_t)(n0 + r16) * D + g4 * 8;
        const float* sh0 = mod + ((size_t)layer * 32 + r16) * ADA + ((st & 1) ? 3 : 0) * D + g4 * 8; const float* sh1 = sh0 + (size_t)16 * ADA;
        f32x4 acc0 = (f32x4){0.f, 0.f, 0.f, 0.f}, acc1 = acc0;
#pragma unroll 4
        for (int k = 0; k < D; k += 32) {
            const bf16x8 bw = *(const bf16x8*)(wp + k);
            const f32x4 x0 = *(const f32x4*)(sh0 + k), x1 = *(const f32x4*)(sh0 + k + 4), y0 = *(const f32x4*)(sh1 + k), y1 = *(const f32x4*)(sh1 + k + 4);
            u32x4 a0, a1; a0.x = cvt_pk_bf16(x0[0], x0[1]); a0.y = cvt_pk_bf16(x0[2], x0[3]); a0.z = cvt_pk_bf16(x1[0], x1[1]); a0.w = cvt_pk_bf16(x1[2], x1[3]);
            a1.x = cvt_pk_bf16(y0[0], y0[1]); a1.y = cvt_pk_bf16(y0[2], y0[3]); a1.z = cvt_pk_bf16(y1[0], y1[1]); a1.w = cvt_pk_bf16(y1[2], y1[3]);
            acc0 = MFMA16(bw, __builtin_bit_cast(bf16x8, a0), acc0); acc1 = MFMA16(bw, __builtin_bit_cast(bf16x8, a1), acc1);
        }
        float* cp = cvec + (size_t)32 * stage_cvoff(st) + (size_t)r16 * N + n0 + g4 * 4;
        *(f32x4*)cp = acc0; *(f32x4*)(cp + (size_t)16 * N) = acc1;
    }
    bf16_t* H = (bf16_t*)(p.ws + WS_H); float* rss = (float*)(p.ws + WS_RSS);
    for (int r = opaque_bid() * 8 + wid; r < MT; r += opaque_nwg() * 8) {
        const float* src = r < MP ? p.in[0] + (size_t)r * D : p.in[1] + (size_t)(r - MP) * D;
        const float* mrow = mod + (size_t)seq_of_row(r) * ADA + D;
        float ss = 0.f;
#pragma unroll
        for (int i = 0; i < 4; ++i) { const int c = i * 256 + lane * 4;
            const f32x4 v = *(const f32x4*)(src + c), gv = *(const f32x4*)(p.in[9] + c), sc = *(const f32x4*)(mrow + c);
            ss += v[0] * v[0] + v[1] * v[1] + v[2] * v[2] + v[3] * v[3];
            u32x2 w; w.x = cvt_pk_bf16(v[0] * gv[0] * (1.0f + sc[0]), v[1] * gv[1] * (1.0f + sc[1])); w.y = cvt_pk_bf16(v[2] * gv[2] * (1.0f + sc[2]), v[3] * gv[3] * (1.0f + sc[3]));
            *(u32x2*)(H + (size_t)r * D + c) = w; }
        ss = wave_sum(ss);
        if (r < MP) { if (lane < 16) rss[(size_t)r * 16 + lane] = lane == 0 ? ss : 0.f; } else rss[(size_t)MP * 16 + (size_t)(r - MP) * 64 + lane] = lane == 0 ? ss : 0.f;
    }
}

template <int DK, int DV, bool GLA>
__device__ __forceinline__ void recur_phase(unsigned char* lds, bf16_t* P, int ldp, int qoff, int koff, int voff, int goff, const float* S0s, float* outSp, float* outSs, bool live = true, bf16_t* PO = nullptr, int ldo = 0) {
    constexpr int VS = 64, NVS = DV / VS, NH = 4;
    constexpr int QS = DK + 8, TS = 64 + 8;
    constexpr int CP = DK / 2, NSEG = NTHREADS / CP, RPS = 64 / NSEG, NDT = DK / 128, NKK = DK / 32;
    bf16_t* QD = (bf16_t*)lds;
    bf16_t* KD = QD + 64 * QS;
    bf16_t* KDT = KD + 64 * QS;
    bf16_t* VT = KDT + DK * TS;
    bf16_t* ATT = VT + VS * TS;
    bf16_t* ST = ATT + 64 * TS;
    float* SEG = (float*)(ST + VS * QS);
    float* EBL = SEG + (GLA ? NSEG * DK : 0);
    static_assert((size_t)(64 * QS * 2 + DK * TS + VS * TS + 64 * TS + VS * QS) * 2 + (GLA ? (NSEG + 1) * DK * 4 : 0) <= LDS_BYTES, "recurrence LDS");
    const int tid = opaque_tid(), lane = tid & 63, wid = tid >> 6, g4 = lane >> 4, r16 = lane & 15;
    const int cp = tid % CP, sgm = tid / CP, vcp = tid & 31, vsg = tid >> 5;
    constexpr int NIP = NB * NH * NVS;
    for (int item = opaque_bid(); item < 2 * NIP; item += opaque_nwg()) {
        const bool smp = item >= NIP; const int it = smp ? item - NIP : item;
        const int vs = it % NVS, h = (it / NVS) % NH, b = it / (NVS * NH);
        const int row0 = smp ? MP + b * DSEQ : b * SEQ, nch = smp ? 1 : SEQ / 64, Lc = smp ? DSEQ : 64;
        const float lgam = GLA ? 0.f : __logf(1.0f - exp2f(-5.0f - (float)h));
        f32x4 sacc[NDT][4];
        __syncthreads();
#pragma unroll
        for (int dl = 0; dl < NDT; ++dl)
#pragma unroll
            for (int vt = 0; vt < 4; ++vt) {
                f32x4 s = (f32x4){0.f, 0.f, 0.f, 0.f};
                const int d0 = (wid * NDT + dl) * 16 + g4 * 4, v = vt * 16 + r16;
                if (smp) {
#pragma unroll
                    for (int j = 0; j < 4; ++j) s[j] = S0s[(((size_t)b * NH + h) * DK + d0 + j) * DV + vs * VS + v];
                }
                sacc[dl][vt] = s;
                u32x2 w; w.x = cvt_pk_bf16(s[0], s[1]); w.y = cvt_pk_bf16(s[2], s[3]);
                *(u32x2*)(ST + v * QS + d0) = w;
            }
        unsigned rq[RPS], rk[RPS], rg[RPS], rv[4];
        const bf16_t* Pq = P + qoff + h * DK + 2 * cp; const bf16_t* Pk = P + koff + h * DK + 2 * cp; const bf16_t* Pg = P + goff + h * DK + 2 * cp;
        bf16_t* Pv = P + voff + h * DV + vs * VS;
#define RC_LOAD(c) do { \
        _Pragma("unroll") for (int i = 0; i < RPS; ++i) { const int row = sgm * RPS + i; const size_t go = (size_t)(row0 + (c) * 64 + row) * ldp; const bool ok = row < Lc; \
            rq[i] = ok ? *(const unsigned*)(Pq + go) : 0u; rk[i] = ok ? *(const unsigned*)(Pk + go) : 0u; if (GLA) rg[i] = ok ? *(const unsigned*)(Pg + go) : 0u; } \
        _Pragma("unroll") for (int i = 0; i < 4; ++i) { const int row = vsg * 4 + i; rv[i] = row < Lc ? *(const unsigned*)(Pv + (size_t)(row0 + (c) * 64 + row) * ldp + 2 * vcp) : 0u; } } while (0)
        RC_LOAD(0);
        for (int c = 0; c < nch; ++c) {
            float off0 = 0.f, off1 = 0.f, tot0 = 0.f, tot1 = 0.f;
            float pre0[RPS], pre1[RPS];
            if (GLA) {
                float a0 = 0.f, a1 = 0.f;
#pragma unroll
                for (int i = 0; i < RPS; ++i) { a0 += bf_lo(rg[i]); a1 += bf_hi(rg[i]); pre0[i] = a0; pre1[i] = a1; }
                SEG[sgm * DK + 2 * cp] = a0; SEG[sgm * DK + 2 * cp + 1] = a1;
                __syncthreads();
#pragma unroll
                for (int s = 0; s < NSEG; ++s) { const float t0 = SEG[s * DK + 2 * cp], t1 = SEG[s * DK + 2 * cp + 1]; if (s < sgm) { off0 += t0; off1 += t1; } tot0 += t0; tot1 += t1; }
                if (sgm == 0) { EBL[2 * cp] = __expf(tot0); EBL[2 * cp + 1] = __expf(tot1); }
            }
            {
                float kt0[RPS], kt1[RPS];
#pragma unroll
                for (int i = 0; i < RPS; ++i) { const int row = sgm * RPS + i;
                    const float q0 = bf_lo(rq[i]), q1 = bf_hi(rq[i]), k0 = bf_lo(rk[i]), k1 = bf_hi(rk[i]);
                    if (GLA) {
                        const float b0 = off0 + pre0[i], b1 = off1 + pre1[i];
                        const float e0 = __expf(b0), e1 = __expf(b1);
                        *(unsigned*)(QD + row * QS + 2 * cp) = cvt_pk_bf16(q0 * e0, q1 * e1);
                        *(unsigned*)(KD + row * QS + 2 * cp) = cvt_pk_bf16(k0 * __expf(-b0), k1 * __expf(-b1));
                        kt0[i] = k0 * __expf(tot0 - b0); kt1[i] = k1 * __expf(tot1 - b1);
                    } else {
                        *(unsigned*)(QD + row * QS + 2 * cp) = rq[i];
                        *(unsigned*)(KD + row * QS + 2 * cp) = rk[i];
                        const float dk = __expf(lgam * (float)(Lc - 1 - row));
                        kt0[i] = k0 * dk; kt1[i] = k1 * dk;
                    } }
#pragma unroll
                for (int i = 0; i < RPS; i += 8) {
                    u32x4 w0, w1;
                    w0.x = cvt_pk_bf16(kt0[i], kt0[i + 1]); w0.y = cvt_pk_bf16(kt0[i + 2], kt0[i + 3]); w0.z = cvt_pk_bf16(kt0[i + 4], kt0[i + 5]); w0.w = cvt_pk_bf16(kt0[i + 6], kt0[i + 7]);
                    w1.x = cvt_pk_bf16(kt1[i], kt1[i + 1]); w1.y = cvt_pk_bf16(kt1[i + 2], kt1[i + 3]); w1.z = cvt_pk_bf16(kt1[i + 4], kt1[i + 5]); w1.w = cvt_pk_bf16(kt1[i + 6], kt1[i + 7]);
                    *(u32x4*)(KDT + (2 * cp) * TS + sgm * RPS + i) = w0; *(u32x4*)(KDT + (2 * cp + 1) * TS + sgm * RPS + i) = w1;
                }
                u32x2 v0, v1;
                v0.x = (rv[0] & 0xffffu) | (rv[1] << 16); v0.y = (rv[2] & 0xffffu) | (rv[3] << 16);
                v1.x = (rv[0] >> 16) | (rv[1] & 0xffff0000u); v1.y = (rv[2] >> 16) | (rv[3] & 0xffff0000u);
                *(u32x2*)(VT + (2 * vcp) * TS + vsg * 4) = v0; *(u32x2*)(VT + (2 * vcp + 1) * TS + vsg * 4) = v1;
            }
            __syncthreads();
            if (c + 1 < nch) RC_LOAD(c + 1);
#pragma unroll
            for (int tt = 0; tt < 2; ++tt) { const int t = wid * 2 + tt, lt = t >> 2, st = t & 3;
                f32x4 acc = (f32x4){0.f, 0.f, 0.f, 0.f};
                if (st <= lt) {
#pragma unroll
                    for (int kk = 0; kk < NKK; ++kk) { const bf16x8 a = *(const bf16x8*)(QD + (lt * 16 + r16) * QS + kk * 32 + g4 * 8), bb = *(const bf16x8*)(KD + (st * 16 + r16) * QS + kk * 32 + g4 * 8);
                        acc = MFMA16(bb, a, acc); }
                }
                const int l = lt * 16 + r16, s0 = st * 16 + g4 * 4;
#pragma unroll
                for (int j = 0; j < 4; ++j) { const int s = s0 + j; float v = acc[j]; if (!GLA) v *= __expf(lgam * (float)(l - s)); acc[j] = (s <= l) ? v : 0.f; }
                u32x2 w; w.x = cvt_pk_bf16(acc[0], acc[1]); w.y = cvt_pk_bf16(acc[2], acc[3]);
                *(u32x2*)(ATT + l * TS + s0) = w; }
            __syncthreads();
#pragma unroll
            for (int tt = 0; tt < 2; ++tt) { const int t = wid * 2 + tt, lt = t >> 2, vt = t & 3;
                f32x4 a1 = (f32x4){0.f, 0.f, 0.f, 0.f}, a2 = (f32x4){0.f, 0.f, 0.f, 0.f};
#pragma unroll
                for (int kk = 0; kk < 2; ++kk) { if (kk * 32 <= lt * 16 + 15) { const bf16x8 a = *(const bf16x8*)(ATT + (lt * 16 + r16) * TS + kk * 32 + g4 * 8), bb = *(const bf16x8*)(VT + (vt * 16 + r16) * TS + kk * 32 + g4 * 8);
                        a1 = MFMA16(bb, a, a1); } }
#pragma unroll
                for (int kk = 0; kk < NKK; ++kk) { const bf16x8 a = *(const bf16x8*)(QD + (lt * 16 + r16) * QS + kk * 32 + g4 * 8), bb = *(const bf16x8*)(ST + (vt * 16 + r16) * QS + kk * 32 + g4 * 8);
                    a2 = MFMA16(bb, a, a2); }
                const int l = lt * 16 + r16;
                const float dq = GLA ? 1.0f : __expf(lgam * (float)(l + 1));
                if (l < Lc && live) { u32x2 w; w.x = cvt_pk_bf16(a1[0] + a2[0] * dq, a1[1] + a2[1] * dq); w.y = cvt_pk_bf16(a1[2] + a2[2] * dq, a1[3] + a2[3] * dq);
                    if (PO) *(u32x2*)(PO + (size_t)(row0 + c * 64 + l) * ldo + h * DV + vs * VS + vt * 16 + g4 * 4) = w;
                    else *(u32x2*)(Pv + (size_t)(row0 + c * 64 + l) * ldp + vt * 16 + g4 * 4) = w; } }
            __syncthreads();
#pragma unroll
            for (int dl = 0; dl < NDT; ++dl) { const int dt = wid * NDT + dl;
                f32x4 dec;
                if (GLA) dec = *(const f32x4*)(EBL + dt * 16 + g4 * 4); else { const float dc = __expf(lgam * (float)Lc); dec = (f32x4){dc, dc, dc, dc}; }
                const bf16x8 ka0 = *(const bf16x8*)(KDT + (dt * 16 + r16) * TS + g4 * 8), ka1 = *(const bf16x8*)(KDT + (dt * 16 + r16) * TS + 32 + g4 * 8);
#pragma unroll
                for (int vt = 0; vt < 4; ++vt) {
                    f32x4 acc = sacc[dl][vt] * dec;
                    acc = MFMA16(ka0, *(const bf16x8*)(VT + (vt * 16 + r16) * TS + g4 * 8), acc);
                    acc = MFMA16(ka1, *(const bf16x8*)(VT + (vt * 16 + r16) * TS + 32 + g4 * 8), acc);
                    sacc[dl][vt] = acc;
                    u32x2 w; w.x = cvt_pk_bf16(acc[0], acc[1]); w.y = cvt_pk_bf16(acc[2], acc[3]);
                    *(u32x2*)(ST + (vt * 16 + r16) * QS + dt * 16 + g4 * 4) = w;
                } }
            __syncthreads();
        }
#undef RC_LOAD
        float* So = smp ? outSs : outSp;
#pragma unroll
        for (int dl = 0; dl < NDT; ++dl)
#pragma unroll
            for (int vt = 0; vt < 4; ++vt) { const int d0 = (wid * NDT + dl) * 16 + g4 * 4, v = vt * 16 + r16;
#pragma unroll
                for (int j = 0; j < 4; ++j) if (live) So[(((size_t)b * NH + h) * DK + d0 + j) * DV + vs * VS + v] = sacc[dl][vt][j]; }
    }
}

template <int DV, bool GLA>
__device__ __forceinline__ void post_phase(bf16_t* P, int ldp, int ooff, int goff, const float* normg) {
    constexpr int EPL = DV / 16;
    const int tid = opaque_tid(), lane = tid & 63, wid = tid >> 6;
    float ng[EPL];
#pragma unroll
    for (int i = 0; i < EPL; ++i) ng[i] = GLA ? normg[(lane & 15) * EPL + i] : 1.0f;
    for (int r0 = (opaque_bid() * 8 + wid) * 2; r0 < MT; r0 += opaque_nwg() * 16) {
        float o[2][EPL]; u32x4 gw[2][EPL / 8];
#pragma unroll
        for (int rr = 0; rr < 2; ++rr) { const bf16_t* po = P + (size_t)(r0 + rr) * ldp + ooff + lane * EPL; const bf16_t* pg = P + (size_t)(r0 + rr) * ldp + goff + lane * EPL;
#pragma unroll
            for (int i = 0; i < EPL; i += 8) { const u32x4 w = *(const u32x4*)(po + i); gw[rr][i / 8] = *(const u32x4*)(pg + i);
#pragma unroll
                for (int j = 0; j < 4; ++j) { o[rr][i + 2 * j] = bf_lo(w[j]); o[rr][i + 2 * j + 1] = bf_hi(w[j]); } } }
#pragma unroll
        for (int rr = 0; rr < 2; ++rr) {
            float s1 = 0.f, s2 = 0.f;
#pragma unroll
            for (int i = 0; i < EPL; ++i) { s1 += o[rr][i]; s2 += o[rr][i] * o[rr][i]; }
#pragma unroll
            for (int m = 1; m < 16; m <<= 1) { s1 += __shfl_xor(s1, m); s2 += __shfl_xor(s2, m); }
            float mu = 0.f, rs;
            if (GLA) rs = rsqrtf(s2 * (1.0f / DV) + 1e-6f);
            else { mu = s1 * (1.0f / DV); rs = rsqrtf(fmaxf(s2 * (1.0f / DV) - mu * mu, 0.f) + 1e-5f); }
            bf16_t* pg = P + (size_t)(r0 + rr) * ldp + goff + lane * EPL;
#pragma unroll
            for (int i = 0; i < EPL; i += 8) { const u32x4 g = gw[rr][i / 8]; u32x4 w;
#pragma unroll
                for (int j = 0; j < 4; ++j) { float x0 = (o[rr][i + 2 * j] - mu) * rs, x1 = (o[rr][i + 2 * j + 1] - mu) * rs;
                    if (GLA) { x0 *= ng[i + 2 * j]; x1 *= ng[i + 2 * j + 1]; }
                    w[j] = cvt_pk_bf16(x0 * silu_f(bf_lo(g[j])), x1 * silu_f(bf_hi(g[j]))); }
                *(u32x4*)(pg + i) = w; }
        }
    }
}

__device__ __forceinline__ void swa_phase(unsigned char* lds, const Params& p, bf16_t* P, int z) {
    const bool live = true;
    constexpr int KS_S = 72, VT_S = 200, PW_S = 200;
    bf16_t* KS = (bf16_t*)lds;
    bf16_t* VT = KS + 192 * KS_S;
    bf16_t* PW = VT + 64 * VT_S;
    const int tid = opaque_tid(), lane = tid & 63, wid = tid >> 6, g4 = lane >> 4, r16 = lane & 15;
    const float* qn = p.in[30 + z]; const float* kn = p.in[31 + z]; const float* sinks = p.in[32 + z];
    const float* cache_k = p.in[4 + z]; const float* cache_v = p.in[5 + z];
    float* out = p.out + z;
    constexpr int NPI = NB * 64 * 4, NSI = NB * 4;
    for (int item = opaque_bid(); item < NPI + NSI; item += opaque_nwg()) {
        const bool smp = item >= NPI; const int it = smp ? item - NPI : item;
        const int kv = it & 3, c = smp ? 0 : (it >> 2) & 63, b = smp ? it >> 2 : it >> 8;
        const int Lq = smp ? DSEQ : 64;
        __syncthreads();
        const int d0 = (tid & 7) * 8;
        f32x4 kn0 = *(const f32x4*)(kn + d0), kn1 = *(const f32x4*)(kn + d0 + 4);
#pragma unroll
        for (int i = 0; i < 3; ++i) { const int s = (tid >> 3) + 64 * i;
            float kf[8], vf[8]; bool valid, donorm = true; long prow = 0;
            if (!smp) { const int tok = (c - 2) * 64 + s; valid = tok >= 0; prow = (long)b * SEQ + tok; }
            else { valid = s < 128 + DSEQ; donorm = s >= 128; prow = (long)MP + b * DSEQ + (s - 128); }
            if (valid && (!smp || s >= 128)) {
                const u32x4 kw = *(const u32x4*)(P + (size_t)prow * SWA_N + 1024 + kv * 64 + d0), vw = *(const u32x4*)(P + (size_t)prow * SWA_N + 1280 + kv * 64 + d0);
#pragma unroll
                for (int j = 0; j < 4; ++j) { kf[2 * j] = bf_lo(kw[j]); kf[2 * j + 1] = bf_hi(kw[j]); vf[2 * j] = bf_lo(vw[j]); vf[2 * j + 1] = bf_hi(vw[j]); }
            } else if (valid) {
                const float* ck = cache_k + (((size_t)b * 128 + s) * 4 + kv) * 64 + d0; const float* cv = cache_v + (((size_t)b * 128 + s) * 4 + kv) * 64 + d0;
                const f32x4 a0 = *(const f32x4*)ck, a1 = *(const f32x4*)(ck + 4), c0 = *(const f32x4*)cv, c1 = *(const f32x4*)(cv + 4);
#pragma unroll
                for (int j = 0; j < 4; ++j) { kf[j] = a0[j]; kf[4 + j] = a1[j]; vf[j] = c0[j]; vf[4 + j] = c1[j]; }
            } else {
#pragma unroll
                for (int j = 0; j < 8; ++j) { kf[j] = 0.f; vf[j] = 0.f; }
            }
            float ss = 0.f;
#pragma unroll
            for (int j = 0; j < 8; ++j) ss += kf[j] * kf[j];
            ss += __shfl_xor(ss, 1); ss += __shfl_xor(ss, 2); ss += __shfl_xor(ss, 4);
            if (donorm) { const float rs = rsqrtf(ss * (1.0f / 64) + 1e-6f);
#pragma unroll
                for (int j = 0; j < 4; ++j) { kf[j] *= rs * kn0[j]; kf[4 + j] *= rs * kn1[j]; } }
            u32x4 w; w.x = cvt_pk_bf16(kf[0], kf[1]); w.y = cvt_pk_bf16(kf[2], kf[3]); w.z = cvt_pk_bf16(kf[4], kf[5]); w.w = cvt_pk_bf16(kf[6], kf[7]);
            *(u32x4*)(KS + s * KS_S + d0) = w;
#pragma unroll
            for (int j = 0; j < 8; ++j) VT[(d0 + j) * VT_S + s] = (bf16_t)(cvt_pk_bf16(vf[j], 0.f) & 0xffffu);
            float* ko = nullptr; float* vo = nullptr;
            if (!smp && c >= 62 && s >= 128) { const int w_ = (c - 62) * 64 + (s - 128); ko = out + O_KP + (((size_t)b * 128 + w_) * 4 + kv) * 64 + d0; vo = out + O_VP + (((size_t)b * 128 + w_) * 4 + kv) * 64 + d0; }
            if (smp && s >= 128 && s < 128 + DSEQ) { ko = out + O_KS + (((size_t)b * DSEQ + (s - 128)) * 4 + kv) * 64 + d0; vo = out + O_VS + (((size_t)b * DSEQ + (s - 128)) * 4 + kv) * 64 + d0; }
            if (ko && live) { *(f32x4*)ko = (f32x4){kf[0], kf[1], kf[2], kf[3]}; *(f32x4*)(ko + 4) = (f32x4){kf[4], kf[5], kf[6], kf[7]};
                      *(f32x4*)vo = (f32x4){vf[0], vf[1], vf[2], vf[3]}; *(f32x4*)(vo + 4) = (f32x4){vf[4], vf[5], vf[6], vf[7]}; }
        }
        __syncthreads();
        const int gq = wid >> 1, hh = kv * 4 + gq;
        const float slope = exp2f(-0.5f * (float)(hh + 1)), sink = sinks[hh];
        bf16_t* pw = PW + wid * 16 * PW_S;
        for (int rt = 0; rt < 2; ++rt) {
            const int l = (wid & 1) * 32 + rt * 16 + r16;
            if ((wid & 1) * 32 + rt * 16 >= Lq) break;
            const bool lvalid = l < Lq;
            const size_t prow = smp ? (size_t)MP + b * DSEQ + (lvalid ? l : 0) : (size_t)b * SEQ + c * 64 + l;
            bf16_t* qp = P + prow * SWA_N + kv * 256 + gq * 64;
            bf16x8 qa[2];
            {
                float qf[2][8]; float ss = 0.f;
#pragma unroll
                for (int kk = 0; kk < 2; ++kk) { const u32x4 w = *(const u32x4*)(qp + kk * 32 + g4 * 8);
#pragma unroll
                    for (int j = 0; j < 4; ++j) { qf[kk][2 * j] = bf_lo(w[j]); qf[kk][2 * j + 1] = bf_hi(w[j]); } }
#pragma unroll
                for (int kk = 0; kk < 2; ++kk)
#pragma unroll
                    for (int j = 0; j < 8; ++j) ss += qf[kk][j] * qf[kk][j];
                ss += __shfl_xor(ss, 16); ss += __shfl_xor(ss, 32);
                const float rs = rsqrtf(ss * (1.0f / 64) + 1e-6f) * 0.125f;
#pragma unroll
                for (int kk = 0; kk < 2; ++kk) { u32x4 w;
#pragma unroll
                    for (int j = 0; j < 4; ++j) { const int d = kk * 32 + g4 * 8 + 2 * j; w[j] = cvt_pk_bf16(qf[kk][2 * j] * rs * qn[d], qf[kk][2 * j + 1] * rs * qn[d + 1]); }
                    qa[kk] = __builtin_bit_cast(bf16x8, w); }
            }
            f32x4 sc[12]; float mx = sink;
#pragma unroll
            for (int st = 0; st < 12; ++st) { f32x4 acc = (f32x4){0.f, 0.f, 0.f, 0.f};
#pragma unroll
                for (int kk = 0; kk < 2; ++kk) acc = MFMA16(*(const bf16x8*)(KS + (st * 16 + r16) * KS_S + kk * 32 + g4 * 8), qa[kk], acc);
#pragma unroll
                for (int j = 0; j < 4; ++j) { const int s = st * 16 + g4 * 4 + j; const bool kvalid = smp ? (s < 128 + DSEQ) : ((c - 2) * 64 + s >= 0);
                    const float v = kvalid ? acc[j] - slope * fabsf((float)(128 + l - s)) : -1e30f; acc[j] = v; mx = fmaxf(mx, v); }
                sc[st] = acc; }
            mx = fmaxf(mx, __shfl_xor(mx, 16)); mx = fmaxf(mx, __shfl_xor(mx, 32));
            float sum = 0.f;
#pragma unroll
            for (int st = 0; st < 12; ++st)
#pragma unroll
                for (int j = 0; j < 4; ++j) { const float e = __expf(sc[st][j] - mx); sc[st][j] = e; sum += e; }
            sum += __shfl_xor(sum, 16); sum += __shfl_xor(sum, 32);
            const float inv = 1.0f / (sum + __expf(sink - mx));
#pragma unroll
            for (int st = 0; st < 12; ++st) { u32x2 w; w.x = cvt_pk_bf16(sc[st][0] * inv, sc[st][1] * inv); w.y = cvt_pk_bf16(sc[st][2] * inv, sc[st][3] * inv);
                *(u32x2*)(pw + r16 * PW_S + st * 16 + g4 * 4) = w; }
            __builtin_amdgcn_fence(__ATOMIC_RELEASE, "wavefront"); __builtin_amdgcn_wave_barrier(); __builtin_amdgcn_fence(__ATOMIC_ACQUIRE, "wavefront");
#pragma unroll
            for (int dt = 0; dt < 4; ++dt) { f32x4 acc = (f32x4){0.f, 0.f, 0.f, 0.f};
#pragma unroll
                for (int kk = 0; kk < 6; ++kk) acc = MFMA16(*(const bf16x8*)(VT + (dt * 16 + r16) * VT_S + kk * 32 + g4 * 8), *(const bf16x8*)(pw + r16 * PW_S + kk * 32 + g4 * 8), acc);
                if (lvalid && live) { u32x2 w; w.x = cvt_pk_bf16(acc[0], acc[1]); w.y = cvt_pk_bf16(acc[2], acc[3]); *(u32x2*)(qp + dt * 16 + g4 * 4) = w; } }
            __builtin_amdgcn_fence(__ATOMIC_RELEASE, "wavefront"); __builtin_amdgcn_wave_barrier(); __builtin_amdgcn_fence(__ATOMIC_ACQUIRE, "wavefront");
        }
    }
}

#define XB_TMO      128
#define XB_XCNT(j)  (256  + 64 * (j))
#define XB_XSUB(j)  (1280 + 64 * (j))
#define XB_XGEN(j)  (2304 + 64 * (j))
#define XB_TOP      3328
#define XB_TOPGEN   3392
#define XCD_BAR_WORDS 3456
#define XB_SPIN_CAP (1u << 22)
static_assert(XCD_BAR_WORDS * 4 <= WS_BAR_BYTES, "barrier words");
__device__ __forceinline__ unsigned xb_ld(unsigned* p)              { return __hip_atomic_load(p, __ATOMIC_RELAXED, __HIP_MEMORY_SCOPE_AGENT); }
__device__ __forceinline__ unsigned xb_add(unsigned* p, unsigned v) { return __hip_atomic_fetch_add(p, v, __ATOMIC_RELAXED, __HIP_MEMORY_SCOPE_AGENT); }
__device__ __forceinline__ unsigned xb_xcc_id() { return (unsigned)__builtin_amdgcn_s_getreg((3 << 11) | 20) & 0xFu; }
#define XB_SPIN(cond, bar) do { unsigned _sp = 0; while (cond) { __builtin_amdgcn_s_sleep(1); \
    if ((++_sp & 255u) == 0u) { if (xb_ld(&(bar)[XB_TMO])) break; if (_sp > XB_SPIN_CAP) { atomicAdd(&(bar)[XB_TMO], 1u); break; } } } } while (0)
struct XcdBarrier { unsigned* bar; unsigned x; volatile LAS unsigned* st; };
__device__ __forceinline__ XcdBarrier xcd_barrier_post(unsigned* bar, volatile LAS unsigned* st) {
    XcdBarrier b; b.bar = bar; b.x = xb_xcc_id(); b.st = st;
    if (threadIdx.x == 0) (void)xb_add(&bar[XB_XCNT(b.x)], 1u);
    return b;
}
__device__ __forceinline__ void xcd_barrier_complete(unsigned* bar, unsigned x, unsigned& nloc, unsigned& nx) {
    const unsigned G = gridDim.x * gridDim.y * gridDim.z;
    unsigned sum, cnt, mine, sp = 0u;
    for (;;) {
        sum = 0u; cnt = 0u; mine = 0u;
#pragma unroll
        for (unsigned j = 0; j < 16; ++j) { const unsigned c = xb_ld(&bar[XB_XCNT(j)]); sum += c; cnt += (c > 0u) ? 1u : 0u; mine = (j == x) ? c : mine; }
        if (sum == G) break;
        __builtin_amdgcn_s_sleep(1);
        if ((++sp & 255u) == 0u) { if (xb_ld(&bar[XB_TMO])) break; if (sp > XB_SPIN_CAP) { atomicAdd(&bar[XB_TMO], 1u); break; } }
    }
    nloc = mine > 0u ? mine : 1u; nx = cnt > 0u ? cnt : 1u;
}
__device__ __forceinline__ void xcd_barrier(const XcdBarrier& b) {
    asm volatile("s_waitcnt vmcnt(0)" ::: "memory");
    __syncthreads();
    if (opaque_tid() == 0) {
        unsigned* bar = b.bar; asm volatile("" : "+s"(bar));
        __builtin_amdgcn_s_waitcnt(0);
        const unsigned bx = xb_xcc_id();
        unsigned nloc = b.st[0], nx = b.st[1];
        if (nloc == 0u) { xcd_barrier_complete(bar, bx, nloc, nx); b.st[0] = nloc; b.st[1] = nx; }
        const unsigned old = xb_add(&bar[XB_XSUB(bx)], 1u);
        const unsigned gen = old / nloc;
        if (old + 1u == (gen + 1u) * nloc) {
            __builtin_amdgcn_fence(__ATOMIC_RELEASE, "agent");
            asm volatile("s_waitcnt vmcnt(0)" ::: "memory");
            const unsigned og = xb_add(&bar[XB_TOP], 1u);
            const unsigned tg = og / nx;
            if (og + 1u == (tg + 1u) * nx) xb_add(&bar[XB_TOPGEN], 1u);
            else XB_SPIN(xb_ld(&bar[XB_TOPGEN]) == tg, bar);
            __builtin_amdgcn_fence(__ATOMIC_ACQUIRE, "agent");
            xb_add(&bar[XB_XGEN(bx)], 1u);
            asm volatile("s_waitcnt vmcnt(0)" ::: "memory");
        } else {
            XB_SPIN(xb_ld(&bar[XB_XGEN(bx)]) == gen, bar);
            __builtin_amdgcn_fence(__ATOMIC_ACQUIRE, "agent");
            asm volatile("s_waitcnt vmcnt(0)" ::: "memory");
        }
    }
    __syncthreads();
}
__device__ __forceinline__ void gsync_cg(cg::grid_group& g) {
    __builtin_amdgcn_fence(__ATOMIC_RELEASE, "agent");
    asm volatile("s_waitcnt vmcnt(0) lgkmcnt(0)" ::: "memory");
    g.sync();
    __builtin_amdgcn_fence(__ATOMIC_ACQUIRE, "agent");
    asm volatile("s_waitcnt vmcnt(0)" ::: "memory");
}
#define gsync(g) xcd_barrier(xbar)
__global__ void __launch_bounds__(NTHREADS, 2) fwd_megakernel(Params p) {
    extern __shared__ __attribute__((aligned(16))) unsigned char shm[];
    cg::grid_group grid = cg::this_grid();
    LAS unsigned char* shl = (LAS unsigned char*)shm;
    pg8::StaticOrder S;
    volatile LAS unsigned* xst = (volatile LAS unsigned*)(shl + LDS_BYTES - 16);
    if (threadIdx.x == 0) { xst[0] = 0u; xst[1] = 0u; }
    __syncthreads();
    const XcdBarrier xbar = xcd_barrier_post((unsigned*)(p.ws + WS_BAR), xst);

    grid.sync();
    prep_phase(shm, p);
    gsync(grid);
    prepb_phase(p);
    gsync(grid);
#pragma unroll 1
    for (int layer = 0; layer < 4; ++layer) {
        int z = 0; asm volatile("" : "+s"(z));
        unsigned char* ws = p.ws + z; float* yo = p.out + z;
        bf16_t* H = (bf16_t*)(ws + WS_H); bf16_t* P = (bf16_t*)(ws + WS_P);
        const float* mod = (const float*)(ws + WS_MOD);
        float* RS = (float*)(ws + WS_RSS);
        LAS float* RSL = (LAS float*)(shl + 128 * 1024);
        const float* avec = (const float*)(ws + WS_AVEC); const float* cvec = (const float*)(ws + WS_CVEC);
        const int kind = layer % 3, j = layer / 3;
        const float* mod_l = mod + (size_t)layer * 32 * ADA;
        const float* yin_p = layer == 0 ? p.in[0 + z] : yo; const float* yin_s = layer == 0 ? p.in[1 + z] : yo + O_YS;
        const float* cv_mix = cvec + (size_t)32 * stage_cvoff(2 * layer); const float* cv_mlp = cvec + (size_t)32 * stage_cvoff(2 * layer + 1);
        const bf16_t* WoT; int Ko, lda_o; const bf16_t* Ao;
        if (kind == 0) {
            { pg8::Gemm g{H, (const bf16_t*)(ws + WS_GIN) + (size_t)j * GLA_N * D, MP, GLA_N, D, D}; S.init(MP, GLA_N, opaque_nwg(), opaque_bid());
              pg8::EpiBf16 E{P, GLA_N, 0, 3072, p.in[20 + z] + j * 512, RS, cv_mix, RSL}; pg8::rs_stage(S, RS, 0, RSL); pg8::gemm_phase(shl, g, S, E); pg8::gemm_sample(shm, g, E); }
            gsync(grid);
            recur_phase<GLA_DK, GLA_DV, true>(shm, P, GLA_N, 0, 512, 1024, 3072, layer == 0 ? p.in[2 + z] : p.in[6 + z], yo + (layer == 0 ? O_G0P : O_G3P), yo + (layer == 0 ? O_G0S : O_G3S));
            gsync(grid);
            post_phase<GLA_DV, true>(P, GLA_N, 1024, 2048, p.in[22 + z] + j * GLA_DV);
            WoT = (const bf16_t*)(ws + WS_GO) + (size_t)j * D * D; Ko = D; lda_o = GLA_N; Ao = P + 2048;
        } else if (kind == 1) {
            { pg8::Gemm g{H, (const bf16_t*)(ws + WS_RIN), MP, RET_N, D, D}; S.init(MP, RET_N, opaque_nwg(), opaque_bid());
              pg8::EpiBf16 E{P, RET_N, 0, 1 << 30, nullptr, RS, cv_mix, RSL}; pg8::rs_stage(S, RS, 0, RSL); pg8::gemm_phase(shl, g, S, E); pg8::gemm_sample(shm, g, E); }
            gsync(grid);
            recur_phase<RET_DK, RET_DV, false>(shm, P, RET_N, 0, 1024, 2048, 0, p.in[3 + z], yo + O_RP, yo + O_RS);
            gsync(grid);
            post_phase<RET_DV, false>(P, RET_N, 2048, 4096, nullptr);
            WoT = (const bf16_t*)(ws + WS_RO); Ko = 2048; lda_o = RET_N; Ao = P + 4096;
        } else {
            { pg8::Gemm g{H, (const bf16_t*)(ws + WS_SIN), MP, SWA_N, D, D}; S.init(MP, SWA_N, opaque_nwg(), opaque_bid());
              pg8::EpiBf16 E{P, SWA_N, 0, 1 << 30, nullptr, RS, cv_mix, RSL}; pg8::rs_stage(S, RS, 0, RSL); pg8::gemm_phase(shl, g, S, E); pg8::gemm_sample(shm, g, E); }
            gsync(grid);
            swa_phase(shm, p, P, z);
            WoT = (const bf16_t*)(ws + WS_SO); Ko = D; lda_o = SWA_N; Ao = P;
        }
        gsync(grid);
        { pg8::Gemm g{Ao, WoT, MP, D, Ko, lda_o}; S.init(MP, D, opaque_nwg(), opaque_bid());
          pg8::EpiRes E{yin_p, yin_s, yo, mod_l + 2 * D, H, avec + (size_t)(2 * layer + 1) * 32 * D, RS}; pg8::gemm_phase(shl, g, S, E); pg8::gemm_sample(shm, g, E); }
        gsync(grid);
        { pg8::Gemm g{H, (const bf16_t*)(ws + WS_W1T) + (size_t)layer * HID * D, MP, HID, D, D}; S.init(MP, HID, opaque_nwg(), opaque_bid());
          pg8::EpiBf16 E{P, HID, 1, 1 << 30, nullptr, RS, cv_mlp, RSL}; pg8::rs_stage(S, RS, 0, RSL); pg8::gemm_phase(shl, g, S, E); pg8::gemm_sample(shm, g, E); }
        gsync(grid);
        { pg8::Gemm g{P, (const bf16_t*)(ws + WS_W2T) + (size_t)layer * HID * D, MP, D, HID, HID}; S.init(MP, D, opaque_nwg(), opaque_bid());
          pg8::EpiRes E{yo, yo + O_YS, yo, mod_l + 5 * D, layer < 3 ? H : nullptr, avec + (size_t)(layer < 3 ? 2 * layer + 2 : 0) * 32 * D, RS}; pg8::gemm_phase(shl, g, S, E); pg8::gemm_sample(shm, g, E); }
        gsync(grid);
    }
}

extern "C" void kernel_launch(void* const* d_in, const int* in_sizes, int n_in, void* d_out, int out_size, void* d_ws, size_t ws_size, hipStream_t stream) {
    static int grid_blocks = 0;
    if (grid_blocks == 0) {
        if (n_in != 34 || (size_t)out_size != O_END || ws_size < WS_END) { fprintf(stderr, "kernel_launch: unexpected sizes n_in %d out %d ws %zu (need %zu)\n", n_in, out_size, ws_size, (size_t)WS_END); grid_blocks = -1; return; }
        int dev = 0, cus = 0, per_cu = 0;
        hipGetDevice(&dev);
        hipDeviceGetAttribute(&cus, hipDeviceAttributeMultiprocessorCount, dev);
        if (hipFuncSetAttribute((const void*)fwd_megakernel, hipFuncAttributeMaxDynamicSharedMemorySize, LDS_BYTES) != hipSuccess) { fprintf(stderr, "kernel_launch: hipFuncSetAttribute failed\n"); grid_blocks = -1; return; }
        hipOccupancyMaxActiveBlocksPerMultiprocessor(&per_cu, (const void*)fwd_megakernel, NTHREADS, LDS_BYTES);
        if (per_cu < 1) { fprintf(stderr, "kernel_launch: occupancy query says %d blocks per CU\n", per_cu); grid_blocks = -1; return; }
        grid_blocks = cus * per_cu;
    }
    if (grid_blocks < 0) return;
    Params p{};
    for (int i = 0; i < 34; ++i) p.in[i] = (const float*)d_in[i];
    p.out = (float*)d_out; p.ws = (unsigned char*)d_ws;
    unsigned char* ws = (unsigned char*)d_ws;
    int nj = 0, tiles = 0;
    auto add = [&](const float* src, bf16_t* dst, int K, int N, float scale) { TJob& j = p.jobs[nj++]; j.src = src; j.dst = dst; j.K = K; j.N = N; j.tile0 = tiles; j.scale = scale; tiles += (K / 64) * (N / 128); };
    for (int l = 0; l < 4; ++l) {
        add(p.in[13] + (size_t)l * D * HID, (bf16_t*)(ws + WS_W1T) + (size_t)l * HID * D, D, HID, 1.0f);
        add(p.in[14] + (size_t)l * HID * D, (bf16_t*)(ws + WS_W2T) + (size_t)l * HID * D, HID, D, 1.0f);
    }
    for (int j = 0; j < 2; ++j) {
        bf16_t* gin = (bf16_t*)(ws + WS_GIN) + (size_t)j * GLA_N * D;
        add(p.in[15] + (size_t)j * D * 512, gin, D, 512, 0.08838834764831845f);
        add(p.in[16] + (size_t)j * D * 512, gin + (size_t)512 * D, D, 512, 1.0f);
        add(p.in[17] + (size_t)j * D * D, gin + (size_t)1024 * D, D, D, 1.0f);
        add(p.in[21] + (size_t)j * D * D, gin + (size_t)2048 * D, D, D, 1.0f);
        add(p.in[23] + (size_t)j * D * D, (bf16_t*)(ws + WS_GO) + (size_t)j * D * D, D, D, 1.0f);
    }
    {
        bf16_t* rin = (bf16_t*)(ws + WS_RIN);
        add(p.in[24], rin, D, D, 1.0f);
        add(p.in[25], rin + (size_t)1024 * D, D, D, 0.0625f);
        add(p.in[26], rin + (size_t)2048 * D, D, 2048, 1.0f);
        add(p.in[27], rin + (size_t)4096 * D, D, 2048, 1.0f);
        add(p.in[28], (bf16_t*)(ws + WS_RO), 2048, D, 1.0f);
    }
    add(p.in[29], (bf16_t*)(ws + WS_SIN), D, SWA_N, 1.0f);
    add(p.in[33], (bf16_t*)(ws + WS_SO), D, D, 1.0f);
    p.ntiles = tiles;
    if (hipMemsetAsync(ws + WS_BAR, 0, WS_BAR_BYTES, stream) != hipSuccess) { fprintf(stderr, "kernel_launch: memset of barrier words failed\n"); return; }
    void* args[] = {&p};
    hipError_t e = hipLaunchCooperativeKernel((const void*)fwd_megakernel, dim3(grid_blocks), dim3(NTHREADS), args, LDS_BYTES, stream);
    if (e != hipSuccess) fprintf(stderr, "kernel_launch: cooperative launch failed: %s (grid %d)\n", hipGetErrorString(e), grid_blocks);
}
```

```cpp
#include <hip/hip_runtime.h>
#include <hip/hip_cooperative_groups.h>
#include <cstdio>
#include <cstdint>
namespace cg = cooperative_groups;

#define LAS __attribute__((address_space(3)))
typedef unsigned short bf16_t;
typedef short bf16x8 __attribute__((ext_vector_type(8)));
typedef float f32x4 __attribute__((ext_vector_type(4)));
typedef unsigned u32x4 __attribute__((ext_vector_type(4)));
typedef unsigned u32x2 __attribute__((ext_vector_type(2)));

constexpr int D = 1024, NB = 16, SEQ = 4096, DSEQ = 16, MP = NB * SEQ, MS = NB * DSEQ, MT = MP + MS;
constexpr int HID = 4096, ADA = 6 * D;
constexpr int GLA_H = 4, GLA_DK = 128, GLA_DV = 256, GLA_N = 3584;
constexpr int RET_H = 4, RET_DK = 256, RET_DV = 512, RET_N = 6144;
constexpr int SWA_N = 1536;
constexpr int NTHREADS = 512;
constexpr int LDS_BYTES = 160 * 1024;
constexpr int DBG_LAYER_MASK = 0xF; constexpr bool DBG_MIXER = true, DBG_MLP = true; constexpr int DBG_SKIP = 0; constexpr bool DBG_FRESH_O = false; constexpr int PROBE_DUP_MIXER = 0, PROBE_DUP_GEMM = 0, PROBE_DUP_MOD = 0;

constexpr size_t O_YP = 0, O_YS = O_YP + (size_t)MP * D, O_G0P = O_YS + (size_t)MS * D, O_G0S = O_G0P + (size_t)NB * 4 * 128 * 256,
                 O_RP = O_G0S + (size_t)NB * 4 * 128 * 256, O_RS = O_RP + (size_t)NB * 4 * 256 * 512, O_KP = O_RS + (size_t)NB * 4 * 256 * 512,
                 O_VP = O_KP + (size_t)NB * 128 * 256, O_KS = O_VP + (size_t)NB * 128 * 256, O_VS = O_KS + (size_t)NB * 16 * 256,
                 O_G3P = O_VS + (size_t)NB * 16 * 256, O_G3S = O_G3P + (size_t)NB * 4 * 128 * 256, O_END = O_G3S + (size_t)NB * 4 * 128 * 256;

constexpr size_t WS_W1T = 0;
constexpr size_t WS_W2T = WS_W1T + (size_t)4 * HID * D * 2;
constexpr size_t WS_GIN = WS_W2T + (size_t)4 * HID * D * 2;
constexpr size_t WS_GO  = WS_GIN + (size_t)2 * GLA_N * D * 2;
constexpr size_t WS_RIN = WS_GO + (size_t)2 * D * D * 2;
constexpr size_t WS_RO  = WS_RIN + (size_t)RET_N * D * 2;
constexpr size_t WS_SIN = WS_RO + (size_t)D * 2048 * 2;
constexpr size_t WS_SO  = WS_SIN + (size_t)SWA_N * D * 2;
constexpr size_t WS_MOD = WS_SO + (size_t)D * D * 2;
constexpr size_t WS_H   = WS_MOD + (size_t)4 * 32 * ADA * 4;
constexpr size_t WS_P   = WS_H + (size_t)MT * D * 2;
constexpr size_t WS_AVEC = WS_P + (size_t)MT * RET_N * 2;
constexpr size_t WS_CVEC = WS_AVEC + (size_t)8 * 32 * D * 4;
constexpr int CVEC_TOTAL_N = 2 * GLA_N + RET_N + SWA_N + 4 * HID;
constexpr size_t WS_RSS = WS_CVEC + (size_t)32 * CVEC_TOTAL_N * 4;
constexpr size_t WS_BAR = WS_RSS + (size_t)MP * 16 * 4 + (size_t)MS * 64 * 4;
constexpr size_t WS_BAR_BYTES = 16384;
constexpr size_t WS_END = WS_BAR + WS_BAR_BYTES;

struct TJob { const float* src; bf16_t* dst; int K, N, tile0; float scale; };
constexpr int NJOBS = 25;
struct Params {
    const float* in[34];
    float* out;
    unsigned char* ws;
    TJob jobs[NJOBS];
    int ntiles; int pad0;
};

typedef __bf16 bf16x2_t __attribute__((ext_vector_type(2)));
typedef float f32x2_t __attribute__((ext_vector_type(2)));
__device__ __forceinline__ unsigned cvt_pk_bf16(float lo, float hi) { const f32x2_t v = {lo, hi}; const bf16x2_t r = __builtin_convertvector(v, bf16x2_t); return __builtin_bit_cast(unsigned, r); }
__device__ __forceinline__ float bf_lo(unsigned u) { return __uint_as_float(u << 16); }
__device__ __forceinline__ float bf_hi(unsigned u) { return __uint_as_float(u & 0xffff0000u); }
__device__ __forceinline__ float silu_f(float x) { return x / (1.0f + __expf(-x)); }
__device__ __forceinline__ int seq_of_row(int r) { return r < MP ? (r >> 12) : 16 + ((r - MP) >> 4); }
__device__ __forceinline__ int opaque_tid() { int t = threadIdx.x; asm volatile("" : "+v"(t)); return t; }
__device__ __forceinline__ int opaque_bid() { int t = blockIdx.x; asm volatile("" : "+s"(t)); return t; }
__device__ __forceinline__ int opaque_nwg() { int t = gridDim.x; asm volatile("" : "+s"(t)); return t; }
__device__ __forceinline__ float wave_sum(float v) {
#pragma unroll
    for (int o = 32; o > 0; o >>= 1) v += __shfl_xor(v, o);
    return v;
}

namespace pg8 {
constexpr int BM = 256, BK = 64, HALF = 128, HTB = HALF * BK * 2, STAGE_BYTES = 8 * HTB, NXCD = 8, WGM = 8;
__host__ __device__ __forceinline__ int lds_byte(int r, int c) { const int st = (r >> 4) * 2 + (c >> 5), rr = r & 15, cc = c & 31, ob = rr * 64 + cc * 2; return st * 1024 + (ob ^ (((ob >> 9) & 1) << 5)); }
__host__ __device__ __forceinline__ void stage_rc(int b, int& R, int& C) { const int st = b / 1024, sb = b % 1024, swz = sb ^ (((sb >> 9) & 1) << 5); R = (st >> 1) * 16 + swz / 64; C = (st & 1) * 32 + (swz % 64) / 2; }
__host__ __device__ __forceinline__ int perm32(int rho) { const int n = rho >> 4, i = rho & 15; return 8 * (i >> 2) + 4 * n + (i & 3); }
struct Unit { int pm, pn; };
struct Gemm { const bf16_t* A; const bf16_t* Bt; int M, N, K, lda; };
struct StaticOrder {
    int nM, nN, nwg, G, c;
    __device__ void init(int M, int N, int G_, int c_) { nM = M / BM; nN = N / BM; nwg = nM * nN; G = G_; c = c_; }
    __device__ bool next(int i, Unit& u) const {
        const long L = (long)i * G + c; if (L >= nwg) return false;
        int wgid = (int)L; { const int q = nwg / NXCD, r = nwg % NXCD, xcd = wgid % NXCD, off = wgid / NXCD; wgid = (xcd < r ? xcd * (q + 1) : r * (q + 1) + (xcd - r) * q) + off; }
        const int nig = WGM * nN, gid = wgid / nig, fm = gid * WGM, gsz = (nM - fm) < WGM ? (nM - fm) : WGM;
        u.pm = fm + ((wgid % nig) % gsz); u.pn = (wgid % nig) / gsz; return true;
    }
};

template <class Epi, bool ALIGN_EPI = true, bool SP2 = true>
__device__ __forceinline__ void gemm_phase(LAS unsigned char* lds, const Gemm g, const StaticOrder& S, const Epi& E) {
    const int tid = opaque_tid(), wid = __builtin_amdgcn_readfirstlane(tid >> 6), lane = tid & 63, wr = wid >> 2, wc = wid & 3, fr = lane & 15, fq = lane >> 4;
    const int K = g.K, nt = K / BK, lda = g.lda;
    unsigned voffA[2], voffB[2];
#pragma unroll
    for (int i = 0; i < 2; ++i) { int R, C; stage_rc(tid * 16 + i * 8192, R, C); const int Rb = Epi::PERM ? ((R & ~31) + perm32(R & 31)) : R;
        voffA[i] = (unsigned)(R * lda + C) * 2u; voffB[i] = (unsigned)(Rb * K + C) * 2u; }
    const size_t kstep = (size_t)(BK * 2);
    const size_t hstepA = (size_t)HALF * lda * 2, hstepB = (size_t)HALF * K * 2;
    const size_t tstepA = 2 * hstepA, tstepB = 2 * hstepB;
    const unsigned ldsw = (unsigned)wid * 1024u;
    const int aoff = lds_byte(wr * 64 + fr, fq * 8), boff = lds_byte(wc * 32 + fr, fq * 8);
#define PG8_SA(b, h) (((b) * 2 + (h)) * HTB)
#define PG8_SB(b, h) ((4 + (b) * 2 + (h)) * HTB)
#define PG8_STAGE(bufoff, gbase, voff) do { _Pragma("unroll") for (int _i = 0; _i < 2; ++_i) \
        __builtin_amdgcn_global_load_lds((const unsigned*)((const char*)(gbase) + (voff)[_i]), (LAS unsigned*)(lds + (bufoff) + ldsw + _i * 8192), 16, 0, 0); } while (0)
#define PG8_LDA(dst, b, h) do { _Pragma("unroll") for (int m = 0; m < 4; ++m) _Pragma("unroll") for (int k = 0; k < 2; ++k) dst[m][k] = *(const LAS bf16x8*)(lds + PG8_SA(b, h) + aoff + m * 2048 + k * 1024); } while (0)
#define PG8_LDB(dst, b, h) do { _Pragma("unroll") for (int n = 0; n < 2; ++n) _Pragma("unroll") for (int k = 0; k < 2; ++k) dst[n][k] = *(const LAS bf16x8*)(lds + PG8_SB(b, h) + boff + n * 2048 + k * 1024); } while (0)
#define PG8_MMA(ai, bj, At, Bt) do { __builtin_amdgcn_s_setprio(1); _Pragma("unroll") for (int m = 0; m < 4; ++m) _Pragma("unroll") for (int n = 0; n < 2; ++n) _Pragma("unroll") for (int k = 0; k < 2; ++k) \
        acc[ai][bj][m][n] = __builtin_amdgcn_mfma_f32_16x16x32_bf16(Bt[n][k], At[m][k], acc[ai][bj][m][n], 0, 0, 0); __builtin_amdgcn_s_setprio(0); } while (0)
#define PG8_WAIT_V(n) asm volatile("s_waitcnt vmcnt(" #n ")" ::: "memory")
#define PG8_WAIT_L(n) asm volatile("s_waitcnt lgkmcnt(" #n ")" ::: "memory")
#define PG8_BAR __builtin_amdgcn_s_barrier()
#define PG8_SCHED __builtin_amdgcn_sched_barrier(0)
    Unit cur, nxt; int ui = 0;
    if (!S.next(0, cur)) return;
    f32x4 acc[2][2][4][2];
#pragma unroll
    for (int a = 0; a < 2; ++a)
#pragma unroll
        for (int b = 0; b < 2; ++b)
#pragma unroll
            for (int m = 0; m < 4; ++m)
#pragma unroll
                for (int n = 0; n < 2; ++n) acc[a][b][m][n] = (f32x4){0.f, 0.f, 0.f, 0.f};
    bf16x8 At[4][2], B0[2][2], B1[2][2];
    const char* cA = (const char*)g.A + (size_t)cur.pm * tstepA; const char* cB = (const char*)g.Bt + (size_t)cur.pn * tstepB;
    if constexpr (SP2) {
        PG8_STAGE(PG8_SB(0, 0), cB, voffB); PG8_STAGE(PG8_SB(0, 1), cB + hstepB, voffB); PG8_STAGE(PG8_SA(0, 0), cA, voffA); PG8_STAGE(PG8_SA(0, 1), cA + hstepA, voffA);
        if (wr == 1) PG8_BAR;
        PG8_WAIT_V(2); PG8_BAR;
        PG8_STAGE(PG8_SB(1, 0), cB + kstep, voffB); PG8_STAGE(PG8_SA(1, 0), cA + kstep, voffA); PG8_STAGE(PG8_SB(1, 1), cB + hstepB + kstep, voffB);
        PG8_WAIT_V(6); PG8_BAR;
    } else {
        PG8_STAGE(PG8_SB(0, 0), cB, voffB); PG8_STAGE(PG8_SA(0, 0), cA, voffA); PG8_STAGE(PG8_SB(0, 1), cB + hstepB, voffB); PG8_STAGE(PG8_SA(0, 1), cA + hstepA, voffA);
        if (wr == 1) PG8_BAR;
        PG8_WAIT_V(4); PG8_BAR;
        PG8_STAGE(PG8_SB(1, 0), cB + kstep, voffB); PG8_STAGE(PG8_SA(1, 0), cA + kstep, voffA); PG8_STAGE(PG8_SB(1, 1), cB + hstepB + kstep, voffB);
        PG8_WAIT_V(6); PG8_BAR;
    }
    for (;;) {
        const bool has_next = S.next(ui + 1, nxt);
        const char* nA = has_next ? (const char*)g.A + (size_t)nxt.pm * tstepA : cA; const char* nB = has_next ? (const char*)g.Bt + (size_t)nxt.pn * tstepB : cB;
        for (int t = 0; t < nt; t += 2) {
            const bool last = (t == nt - 2);
            const char* a1 = cA + (size_t)(t + 1) * kstep;
            const char* a2 = last ? nA : cA + (size_t)(t + 2) * kstep; const char* b2 = last ? nB : cB + (size_t)(t + 2) * kstep;
            const char* a3 = a2 + kstep; const char* b3 = b2 + kstep;
            if constexpr (SP2) {
            PG8_LDB(B0, 0, 0); PG8_LDB(B1, 0, 1); PG8_SCHED; PG8_LDA(At, 0, 0); PG8_STAGE(PG8_SA(1, 1), a1 + hstepA, voffA);
            PG8_WAIT_V(8); PG8_WAIT_L(0); PG8_BAR; PG8_MMA(0, 0, At, B0); PG8_MMA(0, 1, At, B1); PG8_BAR; PG8_SCHED;
            PG8_LDA(At, 0, 1); PG8_STAGE(PG8_SB(0, 0), b2, voffB); PG8_STAGE(PG8_SB(0, 1), b2 + hstepB, voffB); PG8_STAGE(PG8_SA(0, 0), a2, voffA);
            PG8_WAIT_V(8); PG8_WAIT_L(0); PG8_BAR; PG8_MMA(1, 0, At, B0); PG8_MMA(1, 1, At, B1); PG8_BAR; PG8_SCHED;
            PG8_LDB(B0, 1, 0); PG8_LDB(B1, 1, 1); PG8_SCHED; PG8_LDA(At, 1, 0); PG8_STAGE(PG8_SA(0, 1), a2 + hstepA, voffA);
            PG8_WAIT_V(8); PG8_WAIT_L(0); PG8_BAR; PG8_MMA(0, 0, At, B0); PG8_MMA(0, 1, At, B1); PG8_BAR; PG8_SCHED;
            PG8_LDA(At, 1, 1); PG8_STAGE(PG8_SB(1, 0), b3, voffB); PG8_STAGE(PG8_SB(1, 1), b3 + hstepB, voffB); PG8_STAGE(PG8_SA(1, 0), a3, voffA);
            PG8_WAIT_V(8); PG8_WAIT_L(0); PG8_BAR; PG8_MMA(1, 0, At, B0); PG8_MMA(1, 1, At, B1); PG8_BAR; PG8_SCHED;
            } else {
            PG8_LDB(B0, 0, 0); PG8_SCHED; PG8_LDA(At, 0, 0); PG8_STAGE(PG8_SA(1, 1), a1 + hstepA, voffA);
            PG8_WAIT_L(8); PG8_BAR; PG8_WAIT_L(0); PG8_MMA(0, 0, At, B0); PG8_BAR; PG8_SCHED;
            PG8_LDB(B1, 0, 1); PG8_STAGE(PG8_SB(0, 0), b2, voffB);
            PG8_BAR; PG8_WAIT_L(0); PG8_MMA(0, 1, At, B1); PG8_BAR;
            PG8_LDA(At, 0, 1); PG8_STAGE(PG8_SA(0, 0), a2, voffA);
            PG8_BAR; PG8_WAIT_L(0); PG8_MMA(1, 0, At, B0); PG8_BAR; PG8_SCHED;
            PG8_STAGE(PG8_SB(0, 1), b2 + hstepB, voffB);
            PG8_WAIT_V(6); PG8_BAR; PG8_MMA(1, 1, At, B1); PG8_BAR;
            PG8_LDB(B0, 1, 0); PG8_SCHED; PG8_LDA(At, 1, 0); PG8_STAGE(PG8_SA(0, 1), a2 + hstepA, voffA);
            PG8_WAIT_L(8); PG8_BAR; PG8_WAIT_L(0); PG8_MMA(0, 0, At, B0); PG8_BAR; PG8_SCHED;
            PG8_LDB(B1, 1, 1); PG8_STAGE(PG8_SB(1, 0), b3, voffB);
            PG8_BAR; PG8_WAIT_L(0); PG8_MMA(0, 1, At, B1); PG8_BAR;
            PG8_LDA(At, 1, 1); PG8_STAGE(PG8_SA(1, 0), a3, voffA);
            PG8_BAR; PG8_WAIT_L(0); PG8_MMA(1, 0, At, B0); PG8_BAR; PG8_SCHED;
            PG8_STAGE(PG8_SB(1, 1), b3 + hstepB, voffB);
            PG8_WAIT_V(6); PG8_BAR; PG8_MMA(1, 1, At, B1); PG8_BAR;
            }
        }
        if constexpr (ALIGN_EPI) { if (wr == 0) PG8_BAR; }
        E(acc, cur, wr, wc, fr, fq, ui);
        if (!has_next) break;
#pragma unroll
        for (int a = 0; a < 2; ++a)
#pragma unroll
            for (int b = 0; b < 2; ++b)
#pragma unroll
                for (int m = 0; m < 4; ++m)
#pragma unroll
                    for (int n = 0; n < 2; ++n) acc[a][b][m][n] = (f32x4){0.f, 0.f, 0.f, 0.f};
        cur = nxt; cA = nA; cB = nB; ++ui;
        if constexpr (ALIGN_EPI) { if (wr == 1) PG8_BAR; }
    }
    PG8_WAIT_V(0);
    if constexpr (!ALIGN_EPI) { if (wr == 0) PG8_BAR; }
    PG8_BAR;
#undef PG8_SA
#undef PG8_SB
#undef PG8_STAGE
#undef PG8_LDA
#undef PG8_LDB
#undef PG8_MMA
#undef PG8_WAIT_V
#undef PG8_WAIT_L
#undef PG8_BAR
#undef PG8_SCHED
}

__device__ __forceinline__ float row_rs(const float* rss, int r) {
    float t;
    if (r < MP) { const f32x4* q = (const f32x4*)(rss + (size_t)r * 16); const f32x4 a = q[0] + q[1] + q[2] + q[3]; t = (a[0] + a[1]) + (a[2] + a[3]); }
    else { const f32x4* q = (const f32x4*)(rss + (size_t)MP * 16 + (size_t)(r - MP) * 64); f32x4 a = q[0];
#pragma unroll
        for (int i = 1; i < 16; ++i) a += q[i];
        t = (a[0] + a[1]) + (a[2] + a[3]); }
    return rsqrtf(t * (1.0f / D) + 1e-6f);
}
__device__ __forceinline__ float logsig16(float x) { return (fminf(x, 0.f) - __logf(1.0f + __expf(-fabsf(x)))) * (1.0f / 16.0f); }
__device__ __forceinline__ void rs_stage(const StaticOrder& S, const float* rowss, int rbase, LAS float* rsl) {
    const int tid = opaque_tid();
    int nu = 0; { Unit u; while (nu < 24 && S.next(nu, u)) ++nu; }
    __syncthreads();
    for (int idx = tid; idx < nu * 256; idx += NTHREADS) { Unit u; S.next(idx >> 8, u);
        const f32x4* q = (const f32x4*)(rowss + (size_t)(rbase + u.pm * BM + (idx & 255)) * 16);
        const f32x4 a = (q[0] + q[1]) + (q[2] + q[3]);
        rsl[idx] = rsqrtf(((a[0] + a[1]) + (a[2] + a[3])) * (1.0f / D) + 1e-6f); }
    __syncthreads();
}
struct EpiBf16 {
    static constexpr bool PERM = true;
    bf16_t* O; int ldc; int mode; int gate_lo; const float* bias; const float* rowss; const float* cvec;
    const LAS float* rsl;
    __device__ __forceinline__ void tile4(int r, int c, f32x4 v) const {
        const float rs = row_rs(rowss, r);
        v = v * rs + *(const f32x4*)(cvec + (size_t)seq_of_row(r) * ldc + c);
        if (mode == 1) {
#pragma unroll
            for (int j = 0; j < 4; ++j) { const float a = fmaxf(v[j], 0.f); v[j] = a * a; } }
        if (c >= gate_lo) { const f32x4 b = *(const f32x4*)(bias + (c - gate_lo));
#pragma unroll
            for (int j = 0; j < 4; ++j) v[j] = logsig16(v[j] + b[j]); }
        u32x2 w; w.x = cvt_pk_bf16(v[0], v[1]); w.y = cvt_pk_bf16(v[2], v[3]);
        *(u32x2*)(O + (size_t)r * ldc + c) = w;
    }
    __device__ __forceinline__ void operator()(const f32x4 (&acc)[2][2][4][2], const Unit& u, int wr, int wc, int fr, int fq, int ui) const {
        const int row0 = u.pm * BM + wr * 64 + fr, colt = u.pn * BM, col0 = colt + wc * 32 + 8 * fq;
        const bool gate = colt >= gate_lo;
        const float* cvp = cvec + (size_t)seq_of_row(u.pm * BM) * ldc + col0;
        f32x4 bv[2][2];
#pragma unroll
        for (int bj = 0; bj < 2; ++bj)
#pragma unroll
            for (int n = 0; n < 2; ++n) { bv[bj][n] = *(const f32x4*)(cvp + bj * HALF + 4 * n); if (gate) bv[bj][n] += *(const f32x4*)(bias + (col0 - gate_lo) + bj * HALF + 4 * n); }
#pragma unroll
        for (int ai = 0; ai < 2; ++ai) {
#pragma unroll
            for (int m = 0; m < 4; ++m) { const int r = row0 + ai * HALF + m * 16; bf16_t* rowp = O + (size_t)r * ldc + col0;
                const float rs = rsl[ui * 256 + wr * 64 + fr + ai * HALF + m * 16];
#pragma unroll
                for (int bj = 0; bj < 2; ++bj) { f32x4 v0 = acc[ai][bj][m][0] * rs + bv[bj][0], v1 = acc[ai][bj][m][1] * rs + bv[bj][1];
                    if (mode == 1) {
#pragma unroll
                        for (int j = 0; j < 4; ++j) { const float a = fmaxf(v0[j], 0.f), b = fmaxf(v1[j], 0.f); v0[j] = a * a; v1[j] = b * b; } }
                    if (gate) {
#pragma unroll
                        for (int j = 0; j < 4; ++j) { v0[j] = logsig16(v0[j]); v1[j] = logsig16(v1[j]); } }
                    u32x4 w; w.x = cvt_pk_bf16(v0[0], v0[1]); w.y = cvt_pk_bf16(v0[2], v0[3]); w.z = cvt_pk_bf16(v1[0], v1[1]); w.w = cvt_pk_bf16(v1[2], v1[3]);
                    *(u32x4*)(rowp + bj * HALF) = w; } } }
    }
};
struct EpiRes {
    static constexpr bool PERM = false;
    const float* yin_p; const float* yin_s; float* yout; const float* gate;
    bf16_t* Hn; const float* av; float* rowss_next;
    __device__ __forceinline__ void tile4(int r, int c, f32x4 v) const {
        const int sq = seq_of_row(r);
        const f32x4 gv = *(const f32x4*)(gate + (size_t)sq * ADA + c), iv = *(const f32x4*)((r < MP ? yin_p + (size_t)r * D : yin_s + (size_t)(r - MP) * D) + c);
        const f32x4 y = iv + gv * v;
        *(f32x4*)(yout + (size_t)r * D + c) = y;
        if (Hn) {
            const f32x4 a = *(const f32x4*)(av + (size_t)sq * D + c);
            u32x2 w; w.x = cvt_pk_bf16(y[0] * a[0], y[1] * a[1]); w.y = cvt_pk_bf16(y[2] * a[2], y[3] * a[3]);
            *(u32x2*)(Hn + (size_t)r * D + c) = w;
            float ss = y[0] * y[0] + y[1] * y[1] + y[2] * y[2] + y[3] * y[3];
            ss += __shfl_xor(ss, 16); ss += __shfl_xor(ss, 32);
            if ((threadIdx.x & 48) == 0) rowss_next[(size_t)MP * 16 + (size_t)(r - MP) * 64 + (c >> 4)] = ss;
        }
    }
    __device__ __forceinline__ void operator()(const f32x4 (&acc)[2][2][4][2], const Unit& u, int wr, int wc, int fr, int fq, int ui) const {
        const int row0 = u.pm * BM + wr * 64 + fr, col0 = u.pn * BM + wc * 32 + 4 * fq;
        const int sq = seq_of_row(u.pm * BM);
        const float* gp = gate + (size_t)sq * ADA + col0;
        const float* avp = av + (size_t)sq * D + col0;
#pragma unroll
        for (int ai = 0; ai < 2; ++ai) {
            f32x4 yv[4][2][2];
#pragma unroll
            for (int m = 0; m < 4; ++m) { const float* ip = yin_p + (size_t)(row0 + ai * HALF + m * 16) * D + col0;
#pragma unroll
                for (int bj = 0; bj < 2; ++bj)
#pragma unroll
                    for (int n = 0; n < 2; ++n) yv[m][bj][n] = *(const f32x4*)(ip + bj * HALF + n * 16); }
            float ss[4] = {0.f, 0.f, 0.f, 0.f};
#pragma unroll
            for (int bj = 0; bj < 2; ++bj)
#pragma unroll
                for (int n = 0; n < 2; ++n) { const int co = bj * HALF + n * 16;
                    const f32x4 gv = *(const f32x4*)(gp + co), a = Hn ? *(const f32x4*)(avp + co) : (f32x4){0.f, 0.f, 0.f, 0.f};
#pragma unroll
                    for (int m = 0; m < 4; ++m) { const int r = row0 + ai * HALF + m * 16;
                        const f32x4 y = yv[m][bj][n] + gv * acc[ai][bj][m][n];
                        *(f32x4*)(yout + (size_t)r * D + col0 + co) = y;
                        if (Hn) { u32x2 w; w.x = cvt_pk_bf16(y[0] * a[0], y[1] * a[1]); w.y = cvt_pk_bf16(y[2] * a[2], y[3] * a[3]);
                            *(u32x2*)(Hn + (size_t)r * D + col0 + co) = w;
                            ss[m] += y[0] * y[0] + y[1] * y[1] + y[2] * y[2] + y[3] * y[3]; } } }
            if (Hn) {
#pragma unroll
                for (int m = 0; m < 4; ++m) { float t = ss[m]; t += __shfl_xor(t, 16); t += __shfl_xor(t, 32); if (fq == 0) rowss_next[(size_t)(row0 + ai * HALF + m * 16) * 16 + u.pn * 4 + wc] = t; } } }
    }
};

template <class Epi>
__device__ __forceinline__ void gemm_sample(unsigned char* lds, const Gemm g, const Epi& E) {
    const int tid = opaque_tid(), wid = tid >> 6, lane = tid & 63, g4 = lane >> 4, r16 = lane & 15;
    const int K = g.K, CT = g.N >> 8;
    f32x4* red = (f32x4*)lds;
    for (int v = opaque_bid(); v < 256; v += opaque_nwg()) {
        const int row = MP + (v & 15) * 16 + r16, colbase = (v >> 4) * (g.N >> 4);
        const bf16_t* ap = g.A + (size_t)row * g.lda + g4 * 8;
        if (CT == 4) {
            const int ct = wid & 3, kh = wid >> 2, k0 = kh * (K >> 1), k1 = k0 + (K >> 1);
            const bf16_t* bp = g.Bt + (size_t)(colbase + ct * 16 + r16) * K + g4 * 8;
            f32x4 acc = (f32x4){0.f, 0.f, 0.f, 0.f};
#pragma unroll 16
            for (int k = k0; k < k1; k += 32) acc = __builtin_amdgcn_mfma_f32_16x16x32_bf16(*(const bf16x8*)(bp + k), *(const bf16x8*)(ap + k), acc, 0, 0, 0);
            __syncthreads();
            if (kh == 1) red[ct * 64 + lane] = acc;
            __syncthreads();
            if (kh == 0) { acc += red[ct * 64 + lane]; E.tile4(row, colbase + ct * 16 + g4 * 4, acc); }
        } else {
            const int c0 = wid, c1 = wid + 8, c2 = wid + 16;
            const bool h1 = c1 < CT, h2 = c2 < CT;
            if (c0 < CT) {
                const bf16_t* bp0 = g.Bt + (size_t)(colbase + c0 * 16 + r16) * K + g4 * 8;
                const bf16_t* bp1 = g.Bt + (size_t)(colbase + (h1 ? c1 : c0) * 16 + r16) * K + g4 * 8;
                const bf16_t* bp2 = g.Bt + (size_t)(colbase + (h2 ? c2 : c0) * 16 + r16) * K + g4 * 8;
                f32x4 a0 = (f32x4){0.f, 0.f, 0.f, 0.f}, a1 = a0, a2 = a0;
#pragma unroll 8
                for (int k = 0; k < K; k += 32) { const bf16x8 av = *(const bf16x8*)(ap + k);
                    a0 = __builtin_amdgcn_mfma_f32_16x16x32_bf16(*(const bf16x8*)(bp0 + k), av, a0, 0, 0, 0);
                    a1 = __builtin_amdgcn_mfma_f32_16x16x32_bf16(*(const bf16x8*)(bp1 + k), av, a1, 0, 0, 0);
                    a2 = __builtin_amdgcn_mfma_f32_16x16x32_bf16(*(const bf16x8*)(bp2 + k), av, a2, 0, 0, 0); }
                E.tile4(row, colbase + c0 * 16 + g4 * 4, a0);
                if (h1) E.tile4(row, colbase + c1 * 16 + g4 * 4, a1);
                if (h2) E.tile4(row, colbase + c2 * 16 + g4 * 4, a2);
            }
        }
    }
}
}

#define MFMA16(a, b, c) __builtin_amdgcn_mfma_f32_16x16x32_bf16((a), (b), (c), 0, 0, 0)

__device__ __forceinline__ void prep_phase(unsigned char* lds, const Params& p) {
    const int tid = opaque_tid();
    {
        float* sc = (float*)lds;
        float* red = sc + 32 * 512;
        for (int u = opaque_bid(); u < 4 * 48; u += opaque_nwg()) {
            const int l = u / 48, cb = u % 48, col = cb * 128 + (tid & 127), kq = tid >> 7;
            const float* w = p.in[11] + (size_t)l * D * ADA + col;
            float a[32];
#pragma unroll
            for (int s = 0; s < 32; ++s) a[s] = 0.f;
#pragma unroll 1
            for (int half = 0; half < 2; ++half) {
                __syncthreads();
                for (int i = tid; i < 32 * 512; i += NTHREADS) { const int s = i >> 9, k = half * 512 + (i & 511); const float c = s < 16 ? p.in[7][s * D + k] : p.in[8][(s - 16) * D + k]; sc[i] = silu_f(c); }
                __syncthreads();
#pragma unroll 2
                for (int kl = kq * 128; kl < kq * 128 + 128; kl += 4) {
                    const int k = half * 512 + kl;
                    const float w0 = w[(size_t)k * ADA], w1 = w[(size_t)(k + 1) * ADA], w2 = w[(size_t)(k + 2) * ADA], w3 = w[(size_t)(k + 3) * ADA];
#pragma unroll
                    for (int s = 0; s < 32; ++s) { const f32x4 c4 = *(const f32x4*)(sc + s * 512 + kl); a[s] += c4[0] * w0 + c4[1] * w1 + c4[2] * w2 + c4[3] * w3; }
                }
            }
            if (kq > 0) {
#pragma unroll
                for (int s = 0; s < 32; ++s) red[((kq - 1) * 32 + s) * 128 + (tid & 127)] = a[s];
            }
            __syncthreads();
            if (kq == 0) {
                float* mo = (float*)(p.ws + WS_MOD) + (size_t)l * 32 * ADA + col;
                const float bias = p.in[12][(size_t)l * ADA + col];
#pragma unroll
                for (int s = 0; s < 32; ++s) { const int c = tid & 127; mo[(size_t)s * ADA] = a[s] + red[(0 * 32 + s) * 128 + c] + red[(1 * 32 + s) * 128 + c] + red[(2 * 32 + s) * 128 + c] + bias; }
            }
        }
        __syncthreads();
    }
    {
        const int gt = opaque_bid() * NTHREADS + tid, gn = opaque_nwg() * NTHREADS;
        for (int i = gt; i < 2 * 512 * 512; i += gn) {
            const int k2 = (i & 511) * 2, n = (i >> 9) & 511, j = i >> 18;
            const float* w1 = p.in[18] + (size_t)j * D * 16 + (size_t)k2 * 16; const float* w2 = p.in[19] + (size_t)j * 16 * 512 + n;
            float a0 = 0.f, a1 = 0.f;
#pragma unroll
            for (int r = 0; r < 16; ++r) { const float b = w2[r * 512]; a0 += w1[r] * b; a1 += w1[16 + r] * b; }
            bf16_t* dst = (bf16_t*)(p.ws + WS_GIN) + (size_t)j * GLA_N * D + (size_t)(3072 + n) * D + k2;
            *(unsigned*)dst = cvt_pk_bf16(a0, a1);
        }
    }
    {
        float* tl = (float*)lds;
        for (int t = opaque_bid(); t < p.ntiles; t += opaque_nwg()) {
            int j = 0;
#pragma unroll 1
            for (int q = 1; q < NJOBS; ++q) if (t >= p.jobs[q].tile0) j = q;
            const TJob jb = p.jobs[j];
            const int lt = t - jb.tile0, ntn = jb.N >> 7, k0 = (lt / ntn) << 6, n0 = (lt % ntn) << 7;
            __syncthreads();
#pragma unroll
            for (int i = 0; i < 16; ++i) { const int idx = tid + NTHREADS * i, r = idx >> 7, c = idx & 127; tl[c * 65 + r] = jb.src[(size_t)(k0 + r) * jb.N + n0 + c]; }
            __syncthreads();
#pragma unroll
            for (int i = 0; i < 8; ++i) { const int pi = tid + NTHREADS * i, n = pi >> 5, k2 = (pi & 31) * 2;
                *(unsigned*)(jb.dst + (size_t)(n0 + n) * jb.K + k0 + k2) = cvt_pk_bf16(tl[n * 65 + k2] * jb.scale, tl[n * 65 + k2 + 1] * jb.scale); }
        }
    }
}

__device__ __forceinline__ int stage_N(int s) { return (s & 1) ? HID : (s == 2) ? RET_N : (s == 4) ? SWA_N : GLA_N; }
__device__ __forceinline__ int stage_cvoff(int s) { return s == 0 ? 0 : s == 1 ? 3584 : s == 2 ? 7680 : s == 3 ? 13824 : s == 4 ? 17920 : s == 5 ? 19456 : s == 6 ? 23552 : 27136; }
__device__ __forceinline__ const bf16_t* stage_W(const unsigned char* ws, int s) {
    const int layer = s >> 1;
    if (s & 1) return (const bf16_t*)(ws + WS_W1T) + (size_t)layer * HID * D;
    return s == 2 ? (const bf16_t*)(ws + WS_RIN) : s == 4 ? (const bf16_t*)(ws + WS_SIN) : (const bf16_t*)(ws + WS_GIN) + (size_t)(layer / 3) * GLA_N * D;
}
__device__ __forceinline__ void prepb_phase(const Params& p) {
    const int tid = opaque_tid(), lane = tid & 63, wid = tid >> 6, g4 = lane >> 4, r16 = lane & 15;
    const float* mod = (const float*)(p.ws + WS_MOD);
    float* av = (float*)(p.ws + WS_AVEC);
    for (int i = opaque_bid() * NTHREADS + tid; i < 8 * 32 * D; i += opaque_nwg() * NTHREADS) { const int st = i >> 15, sq = (i >> 10) & 31, c = i & 1023, layer = st >> 1;
        const float g = ((st & 1) ? p.in[10] : p.in[9])[layer * D + c];
        av[i] = g * (1.0f + mod[((size_t)layer * 32 + sq) * ADA + ((st & 1) ? 4 : 1) * D + c]); }
    float* cvec = (float*)(p.ws + WS_CVEC);
    for (int it = opaque_bid() * 8 + wid; it < CVEC_TOTAL_N / 16; it += opaque_nwg() * 8) {
        const int ng = it * 16; int st = 0;
#pragma unroll
        for (int q = 1; q < 8; ++q) if (ng >= stage_cvoff(q)) st = q;
        const int n0 = ng - stage_cvoff(st), N = stage_N(st), layer = st >> 1;
        const bf16_t* wp = stage_W(p.ws, st) + (size_t)(n0 + r16) * D + g4 * 8;
        const float* sh0 = mod + ((size_t)layer * 32 + r16) * ADA + ((st & 1) ? 3 : 0) * D + g4 * 8; const float* sh1 = sh0 + (size_t)16 * ADA;
        f32x4 acc0 = (f32x4){0.f, 0.f, 0.f, 0.f}, acc1 = acc0;
#pragma unroll 4
        for (int k = 0; k < D; k += 32) {
            const bf16x8 bw = *(const bf16x8*)(wp + k);
            const f32x4 x0 = *(const f32x4*)(sh0 + k), x1 = *(const f32x4*)(sh0 + k + 4), y0 = *(const f32x4*)(sh1 + k), y1 = *(const f32x4*)(sh1 + k + 4);
            u32x4 a0, a1; a0.x = cvt_pk_bf16(x0[0], x0[1]); a0.y = cvt_pk_bf16(x0[2], x0[3]); a0.z = cvt_pk_bf16(x1[0], x1[1]); a0.w = cvt_pk_bf16(x1[2], x1[3]);
            a1.x = cvt_pk_bf16(y0[0], y0[1]); a1.y = cvt_pk_bf16(y0[2], y0[3]); a1.z = cvt_pk_bf16(y1[0], y1[1]); a1.w = cvt_pk_bf16(y1[2], y1[3]);
            acc0 = MFMA16(bw, __builtin_bit_cast(bf16x8, a0), acc0); acc1 = MFMA16(bw, __builtin_bit_cast(bf16x8, a1), acc1);
        }
        float* cp = cvec + (size_t)32 * stage_cvoff(st) + (size_t)r16 * N + n0 + g4 * 4;
        *(f32x4*)cp = acc0; *(f32x4*)(cp + (size_t)16 * N) = acc1;
    }
    bf16_t* H = (bf16_t*)(p.ws + WS_H); float* rss = (float*)(p.ws + WS_RSS);
    for (int r = opaque_bid() * 8 + wid; r < MT; r += opaque_nwg() * 8) {
        const float* src = r < MP ? p.in[0] + (size_t)r * D : p.in[1] + (size_t)(r - MP) * D;
        const float* mrow = mod + (size_t)seq_of_row(r) * ADA + D;
        float ss = 0.f;
#pragma unroll
        for (int i = 0; i < 4; ++i) { const int c = i * 256 + lane * 4;
            const f32x4 v = *(const f32x4*)(src + c), gv = *(const f32x4*)(p.in[9] + c), sc = *(const f32x4*)(mrow + c);
            ss += v[0] * v[0] + v[1] * v[1] + v[2] * v[2] + v[3] * v[3];
            u32x2 w; w.x = cvt_pk_bf16(v[0] * gv[0] * (1.0f + sc[0]), v[1] * gv[1] * (1.0f + sc[1])); w.y = cvt_pk_bf16(v[2] * gv[2] * (1.0f + sc[2]), v[3] * gv[3] * (1.0f + sc[3]));
            *(u32x2*)(H + (size_t)r * D + c) = w; }
        ss = wave_sum(ss);
        if (r < MP) { if (lane < 16) rss[(size_t)r * 16 + lane] = lane == 0 ? ss : 0.f; } else rss[(size_t)MP * 16 + (size_t)(r - MP) * 64 + lane] = lane == 0 ? ss : 0.f;
    }
}

template <int DK, int DV, bool GLA>
__device__ __forceinline__ void recur_phase(unsigned char* lds, bf16_t* P, int ldp, int qoff, int koff, int voff, int goff, const float* S0s, float* outSp, float* outSs, bool live = true, bf16_t* PO = nullptr, int ldo = 0) {
    constexpr int VS = 64, NVS = DV / VS, NH = 4;
    constexpr int QS = DK + 8, TS = 64 + 8;
    constexpr int CP = DK / 2, NSEG = NTHREADS / CP, RPS = 64 / NSEG, NDT = DK / 128, NKK = DK / 32;
    bf16_t* QD = (bf16_t*)lds;
    bf16_t* KD = QD + 64 * QS;
    bf16_t* KDT = KD + 64 * QS;
    bf16_t* VT = KDT + DK * TS;
    bf16_t* ATT = VT + VS * TS;
    bf16_t* ST = ATT + 64 * TS;
    float* SEG = (float*)(ST + VS * QS);
    float* EBL = SEG + (GLA ? NSEG * DK : 0);
    static_assert((size_t)(64 * QS * 2 + DK * TS + VS * TS + 64 * TS + VS * QS) * 2 + (GLA ? (NSEG + 1) * DK * 4 : 0) <= LDS_BYTES, "recurrence LDS");
    const int tid = opaque_tid(), lane = tid & 63, wid = tid >> 6, g4 = lane >> 4, r16 = lane & 15;
    const int cp = tid % CP, sgm = tid / CP, vcp = tid & 31, vsg = tid >> 5;
    constexpr int NIP = NB * NH * NVS;
    for (int item = opaque_bid(); item < 2 * NIP; item += opaque_nwg()) {
        const bool smp = item >= NIP; const int it = smp ? item - NIP : item;
        const int vs = it % NVS, h = (it / NVS) % NH, b = it / (NVS * NH);
        const int row0 = smp ? MP + b * DSEQ : b * SEQ, nch = smp ? 1 : SEQ / 64, Lc = smp ? DSEQ : 64;
        const float lgam = GLA ? 0.f : __logf(1.0f - exp2f(-5.0f - (float)h));
        f32x4 sacc[NDT][4];
        __syncthreads();
#pragma unroll
        for (int dl = 0; dl < NDT; ++dl)
#pragma unroll
            for (int vt = 0; vt < 4; ++vt) {
                f32x4 s = (f32x4){0.f, 0.f, 0.f, 0.f};
                const int d0 = (wid * NDT + dl) * 16 + g4 * 4, v = vt * 16 + r16;
                if (smp) {
#pragma unroll
                    for (int j = 0; j < 4; ++j) s[j] = S0s[(((size_t)b * NH + h) * DK + d0 + j) * DV + vs * VS + v];
                }
                sacc[dl][vt] = s;
                u32x2 w; w.x = cvt_pk_bf16(s[0], s[1]); w.y = cvt_pk_bf16(s[2], s[3]);
                *(u32x2*)(ST + v * QS + d0) = w;
            }
        unsigned rq[RPS], rk[RPS], rg[RPS], rv[4];
        const bf16_t* Pq = P + qoff + h * DK + 2 * cp; const bf16_t* Pk = P + koff + h * DK + 2 * cp; const bf16_t* Pg = P + goff + h * DK + 2 * cp;
        bf16_t* Pv = P + voff + h * DV + vs * VS;
#define RC_LOAD(c) do { \
        _Pragma("unroll") for (int i = 0; i < RPS; ++i) { const int row = sgm * RPS + i; const size_t go = (size_t)(row0 + (c) * 64 + row) * ldp; const bool ok = row < Lc; \
            rq[i] = ok ? *(const unsigned*)(Pq + go) : 0u; rk[i] = ok ? *(const unsigned*)(Pk + go) : 0u; if (GLA) rg[i] = ok ? *(const unsigned*)(Pg + go) : 0u; } \
        _Pragma("unroll") for (int i = 0; i < 4; ++i) { const int row = vsg * 4 + i; rv[i] = row < Lc ? *(const unsigned*)(Pv + (size_t)(row0 + (c) * 64 + row) * ldp + 2 * vcp) : 0u; } } while (0)
        RC_LOAD(0);
        for (int c = 0; c < nch; ++c) {
            float off0 = 0.f, off1 = 0.f, tot0 = 0.f, tot1 = 0.f;
            float pre0[RPS], pre1[RPS];
            if (GLA) {
                float a0 = 0.f, a1 = 0.f;
#pragma unroll
                for (int i = 0; i < RPS; ++i) { a0 += bf_lo(rg[i]); a1 += bf_hi(rg[i]); pre0[i] = a0; pre1[i] = a1; }
                SEG[sgm * DK + 2 * cp] = a0; SEG[sgm * DK + 2 * cp + 1] = a1;
                __syncthreads();
#pragma unroll
                for (int s = 0; s < NSEG; ++s) { const float t0 = SEG[s * DK + 2 * cp], t1 = SEG[s * DK + 2 * cp + 1]; if (s < sgm) { off0 += t0; off1 += t1; } tot0 += t0; tot1 += t1; }
                if (sgm == 0) { EBL[2 * cp] = __expf(tot0); EBL[2 * cp + 1] = __expf(tot1); }
            }
            {
                float kt0[RPS], kt1[RPS];
#pragma unroll
                for (int i = 0; i < RPS; ++i) { const int row = sgm * RPS + i;
                    const float q0 = bf_lo(rq[i]), q1 = bf_hi(rq[i]), k0 = bf_lo(rk[i]), k1 = bf_hi(rk[i]);
                    if (GLA) {
                        const float b0 = off0 + pre0[i], b1 = off1 + pre1[i];
                        const float e0 = __expf(b0), e1 = __expf(b1);
                        *(unsigned*)(QD + row * QS + 2 * cp) = cvt_pk_bf16(q0 * e0, q1 * e1);
                        *(unsigned*)(KD + row * QS + 2 * cp) = cvt_pk_bf16(k0 * __expf(-b0), k1 * __expf(-b1));
                        kt0[i] = k0 * __expf(tot0 - b0); kt1[i] = k1 * __expf(tot1 - b1);
                    } else {
                        *(unsigned*)(QD + row * QS + 2 * cp) = rq[i];
                        *(unsigned*)(KD + row * QS + 2 * cp) = rk[i];
                        const float dk = __expf(lgam * (float)(Lc - 1 - row));
                        kt0[i] = k0 * dk; kt1[i] = k1 * dk;
                    } }
#pragma unroll
                for (int i = 0; i < RPS; i += 8) {
                    u32x4 w0, w1;
                    w0.x = cvt_pk_bf16(kt0[i], kt0[i + 1]); w0.y = cvt_pk_bf16(kt0[i + 2], kt0[i + 3]); w0.z = cvt_pk_bf16(kt0[i + 4], kt0[i + 5]); w0.w = cvt_pk_bf16(kt0[i + 6], kt0[i + 7]);
                    w1.x = cvt_pk_bf16(kt1[i], kt1[i + 1]); w1.y = cvt_pk_bf16(kt1[i + 2], kt1[i + 3]); w1.z = cvt_pk_bf16(kt1[i + 4], kt1[i + 5]); w1.w = cvt_pk_bf16(kt1[i + 6], kt1[i + 7]);
                    *(u32x4*)(KDT + (2 * cp) * TS + sgm * RPS + i) = w0; *(u32x4*)(KDT + (2 * cp + 1) * TS + sgm * RPS + i) = w1;
                }
                u32x2 v0, v1;
                v0.x = (rv[0] & 0xffffu) | (rv[1] << 16); v0.y = (rv[2] & 0xffffu) | (rv[3] << 16);
                v1.x = (rv[0] >> 16) | (rv[1] & 0xffff0000u); v1.y = (rv[2] >> 16) | (rv[3] & 0xffff0000u);
                *(u32x2*)(VT + (2 * vcp) * TS + vsg * 4) = v0; *(u32x2*)(VT + (2 * vcp + 1) * TS + vsg * 4) = v1;
            }
            __syncthreads();
            if (c + 1 < nch) RC_LOAD(c + 1);
#pragma unroll
            for (int tt = 0; tt < 2; ++tt) { const int t = wid * 2 + tt, lt = t >> 2, st = t & 3;
                f32x4 acc = (f32x4){0.f, 0.f, 0.f, 0.f};
                if (st <= lt) {
#pragma unroll
                    for (int kk = 0; kk < NKK; ++kk) { const bf16x8 a = *(const bf16x8*)(QD + (lt * 16 + r16) * QS + kk * 32 + g4 * 8), bb = *(const bf16x8*)(KD + (st * 16 + r16) * QS + kk * 32 + g4 * 8);
                        acc = MFMA16(bb, a, acc); }
                }
                const int l = lt * 16 + r16, s0 = st * 16 + g4 * 4;
#pragma unroll
                for (int j = 0; j < 4; ++j) { const int s = s0 + j; float v = acc[j]; if (!GLA) v *= __expf(lgam * (float)(l - s)); acc[j] = (s <= l) ? v : 0.f; }
                u32x2 w; w.x = cvt_pk_bf16(acc[0], acc[1]); w.y = cvt_pk_bf16(acc[2], acc[3]);
                *(u32x2*)(ATT + l * TS + s0) = w; }
            __syncthreads();
#pragma unroll
            for (int tt = 0; tt < 2; ++tt) { const int t = wid * 2 + tt, lt = t >> 2, vt = t & 3;
                f32x4 a1 = (f32x4){0.f, 0.f, 0.f, 0.f}, a2 = (f32x4){0.f, 0.f, 0.f, 0.f};
#pragma unroll
                for (int kk = 0; kk < 2; ++kk) { if (kk * 32 <= lt * 16 + 15) { const bf16x8 a = *(const bf16x8*)(ATT + (lt * 16 + r16) * TS + kk * 32 + g4 * 8), bb = *(const bf16x8*)(VT + (vt * 16 + r16) * TS + kk * 32 + g4 * 8);
                        a1 = MFMA16(bb, a, a1); } }
#pragma unroll
                for (int kk = 0; kk < NKK; ++kk) { const bf16x8 a = *(const bf16x8*)(QD + (lt * 16 + r16) * QS + kk * 32 + g4 * 8), bb = *(const bf16x8*)(ST + (vt * 16 + r16) * QS + kk * 32 + g4 * 8);
                    a2 = MFMA16(bb, a, a2); }
                const int l = lt * 16 + r16;
                const float dq = GLA ? 1.0f : __expf(lgam * (float)(l + 1));
                if (l < Lc && live) { u32x2 w; w.x = cvt_pk_bf16(a1[0] + a2[0] * dq, a1[1] + a2[1] * dq); w.y = cvt_pk_bf16(a1[2] + a2[2] * dq, a1[3] + a2[3] * dq);
                    if (PO) *(u32x2*)(PO + (size_t)(row0 + c * 64 + l) * ldo + h * DV + vs * VS + vt * 16 + g4 * 4) = w;
                    else *(u32x2*)(Pv + (size_t)(row0 + c * 64 + l) * ldp + vt * 16 + g4 * 4) = w; } }
            __syncthreads();
#pragma unroll
            for (int dl = 0; dl < NDT; ++dl) { const int dt = wid * NDT + dl;
                f32x4 dec;
                if (GLA) dec = *(const f32x4*)(EBL + dt * 16 + g4 * 4); else { const float dc = __expf(lgam * (float)Lc); dec = (f32x4){dc, dc, dc, dc}; }
                const bf16x8 ka0 = *(const bf16x8*)(KDT + (dt * 16 + r16) * TS + g4 * 8), ka1 = *(const bf16x8*)(KDT + (dt * 16 + r16) * TS + 32 + g4 * 8);
#pragma unroll
                for (int vt = 0; vt < 4; ++vt) {
                    f32x4 acc = sacc[dl][vt] * dec;
                    acc = MFMA16(ka0, *(const bf16x8*)(VT + (vt * 16 + r16) * TS + g4 * 8), acc);
                    acc = MFMA16(ka1, *(const bf16x8*)(VT + (vt * 16 + r16) * TS + 32 + g4 * 8), acc);
                    sacc[dl][vt] = acc;
                    u32x2 w; w.x = cvt_pk_bf16(acc[0], acc[1]); w.y = cvt_pk_bf16(acc[2], acc[3]);
                    *(u32x2*)(ST + (vt * 16 + r16) * QS + dt * 16 + g4 * 4) = w;
                } }
            __syncthreads();
        }
#undef RC_LOAD
        float* So = smp ? outSs : outSp;
#pragma unroll
        for (int dl = 0; dl < NDT; ++dl)
#pragma unroll
            for (int vt = 0; vt < 4; ++vt) { const int d0 = (wid * NDT + dl) * 16 + g4 * 4, v = vt * 16 + r16;
#pragma unroll
                for (int j = 0; j < 4; ++j) if (live) So[(((size_t)b * NH + h) * DK + d0 + j) * DV + vs * VS + v] = sacc[dl][vt][j]; }
    }
}

template <int DV, bool GLA>
__device__ __forceinline__ void post_phase(bf16_t* P, int ldp, int ooff, int goff, const float* normg) {
    constexpr int EPL = DV / 16;
    const int tid = opaque_tid(), lane = tid & 63, wid = tid >> 6;
    float ng[EPL];
#pragma unroll
    for (int i = 0; i < EPL; ++i) ng[i] = GLA ? normg[(lane & 15) * EPL + i] : 1.0f;
    for (int r0 = (opaque_bid() * 8 + wid) * 2; r0 < MT; r0 += opaque_nwg() * 16) {
        float o[2][EPL]; u32x4 gw[2][EPL / 8];
#pragma unroll
        for (int rr = 0; rr < 2; ++rr) { const bf16_t* po = P + (size_t)(r0 + rr) * ldp + ooff + lane * EPL; const bf16_t* pg = P + (size_t)(r0 + rr) * ldp + goff + lane * EPL;
#pragma unroll
            for (int i = 0; i < EPL; i += 8) { const u32x4 w = *(const u32x4*)(po + i); gw[rr][i / 8] = *(const u32x4*)(pg + i);
#pragma unroll
                for (int j = 0; j < 4; ++j) { o[rr][i + 2 * j] = bf_lo(w[j]); o[rr][i + 2 * j + 1] = bf_hi(w[j]); } } }
#pragma unroll
        for (int rr = 0; rr < 2; ++rr) {
            float s1 = 0.f, s2 = 0.f;
#pragma unroll
            for (int i = 0; i < EPL; ++i) { s1 += o[rr][i]; s2 += o[rr][i] * o[rr][i]; }
#pragma unroll
            for (int m = 1; m < 16; m <<= 1) { s1 += __shfl_xor(s1, m); s2 += __shfl_xor(s2, m); }
            float mu = 0.f, rs;
            if (GLA) rs = rsqrtf(s2 * (1.0f / DV) + 1e-6f);
            else { mu = s1 * (1.0f / DV); rs = rsqrtf(fmaxf(s2 * (1.0f / DV) - mu * mu, 0.f) + 1e-5f); }
            bf16_t* pg = P + (size_t)(r0 + rr) * ldp + goff + lane * EPL;
#pragma unroll
            for (int i = 0; i < EPL; i += 8) { const u32x4 g = gw[rr][i / 8]; u32x4 w;
#pragma unroll
                for (int j = 0; j < 4; ++j) { float x0 = (o[rr][i + 2 * j] - mu) * rs, x1 = (o[rr][i + 2 * j + 1] - mu) * rs;
                    if (GLA) { x0 *= ng[i + 2 * j]; x1 *= ng[i + 2 * j + 1]; }
                    w[j] = cvt_pk_bf16(x0 * silu_f(bf_lo(g[j])), x1 * silu_f(bf_hi(g[j]))); }
                *(u32x4*)(pg + i) = w; }
        }
    }
}

__device__ __forceinline__ void swa_phase(unsigned char* lds, const Params& p, bf16_t* P, int z) {
    const bool live = true;
    constexpr int KS_S = 72, VT_S = 200, PW_S = 200;
    bf16_t* KS = (bf16_t*)lds;
    bf16_t* VT = KS + 192 * KS_S;
    bf16_t* PW = VT + 64 * VT_S;
    const int tid = opaque_tid(), lane = tid & 63, wid = tid >> 6, g4 = lane >> 4, r16 = lane & 15;
    const float* qn = p.in[30 + z]; const float* kn = p.in[31 + z]; const float* sinks = p.in[32 + z];
    const float* cache_k = p.in[4 + z]; const float* cache_v = p.in[5 + z];
    float* out = p.out + z;
    constexpr int NPI = NB * 64 * 4, NSI = NB * 4;
    for (int item = opaque_bid(); item < NPI + NSI; item += opaque_nwg()) {
        const bool smp = item >= NPI; const int it = smp ? item - NPI : item;
        const int kv = it & 3, c = smp ? 0 : (it >> 2) & 63, b = smp ? it >> 2 : it >> 8;
        const int Lq = smp ? DSEQ : 64;
        __syncthreads();
        const int d0 = (tid & 7) * 8;
        f32x4 kn0 = *(const f32x4*)(kn + d0), kn1 = *(const f32x4*)(kn + d0 + 4);
#pragma unroll
        for (int i = 0; i < 3; ++i) { const int s = (tid >> 3) + 64 * i;
            float kf[8], vf[8]; bool valid, donorm = true; long prow = 0;
            if (!smp) { const int tok = (c - 2) * 64 + s; valid = tok >= 0; prow = (long)b * SEQ + tok; }
            else { valid = s < 128 + DSEQ; donorm = s >= 128; prow = (long)MP + b * DSEQ + (s - 128); }
            if (valid && (!smp || s >= 128)) {
                const u32x4 kw = *(const u32x4*)(P + (size_t)prow * SWA_N + 1024 + kv * 64 + d0), vw = *(const u32x4*)(P + (size_t)prow * SWA_N + 1280 + kv * 64 + d0);
#pragma unroll
                for (int j = 0; j < 4; ++j) { kf[2 * j] = bf_lo(kw[j]); kf[2 * j + 1] = bf_hi(kw[j]); vf[2 * j] = bf_lo(vw[j]); vf[2 * j + 1] = bf_hi(vw[j]); }
            } else if (valid) {
                const float* ck = cache_k + (((size_t)b * 128 + s) * 4 + kv) * 64 + d0; const float* cv = cache_v + (((size_t)b * 128 + s) * 4 + kv) * 64 + d0;
                const f32x4 a0 = *(const f32x4*)ck, a1 = *(const f32x4*)(ck + 4), c0 = *(const f32x4*)cv, c1 = *(const f32x4*)(cv + 4);
#pragma unroll
                for (int j = 0; j < 4; ++j) { kf[j] = a0[j]; kf[4 + j] = a1[j]; vf[j] = c0[j]; vf[4 + j] = c1[j]; }
            } else {
#pragma unroll
                for (int j = 0; j < 8; ++j) { kf[j] = 0.f; vf[j] = 0.f; }
            }
            float ss = 0.f;
#pragma unroll
            for (int j = 0; j < 8; ++j) ss += kf[j] * kf[j];
            ss += __shfl_xor(ss, 1); ss += __shfl_xor(ss, 2); ss += __shfl_xor(ss, 4);
            if (donorm) { const float rs = rsqrtf(ss * (1.0f / 64) + 1e-6f);
#pragma unroll
                for (int j = 0; j < 4; ++j) { kf[j] *= rs * kn0[j]; kf[4 + j] *= rs * kn1[j]; } }
            u32x4 w; w.x = cvt_pk_bf16(kf[0], kf[1]); w.y = cvt_pk_bf16(kf[2], kf[3]); w.z = cvt_pk_bf16(kf[4], kf[5]); w.w = cvt_pk_bf16(kf[6], kf[7]);
            *(u32x4*)(KS + s * KS_S + d0) = w;
#pragma unroll
            for (int j = 0; j < 8; ++j) VT[(d0 + j) * VT_S + s] = (bf16_t)(cvt_pk_bf16(vf[j], 0.f) & 0xffffu);
            float* ko = nullptr; float* vo = nullptr;
            if (!smp && c >= 62 && s >= 128) { const int w_ = (c - 62) * 64 + (s - 128); ko = out + O_KP + (((size_t)b * 128 + w_) * 4 + kv) * 64 + d0; vo = out + O_VP + (((size_t)b * 128 + w_) * 4 + kv) * 64 + d0; }
            if (smp && s >= 128 && s < 128 + DSEQ) { ko = out + O_KS + (((size_t)b * DSEQ + (s - 128)) * 4 + kv) * 64 + d0; vo = out + O_VS + (((size_t)b * DSEQ + (s - 128)) * 4 + kv) * 64 + d0; }
            if (ko && live) { *(f32x4*)ko = (f32x4){kf[0], kf[1], kf[2], kf[3]}; *(f32x4*)(ko + 4) = (f32x4){kf[4], kf[5], kf[6], kf[7]};
                      *(f32x4*)vo = (f32x4){vf[0], vf[1], vf[2], vf[3]}; *(f32x4*)(vo + 4) = (f32x4){vf[4], vf[5], vf[6], vf[7]}; }
        }
        __syncthreads();
        const int gq = wid >> 1, hh = kv * 4 + gq;
        const float slope = exp2f(-0.5f * (float)(hh + 1)), sink = sinks[hh];
        bf16_t* pw = PW + wid * 16 * PW_S;
        for (int rt = 0; rt < 2; ++rt) {
            const int l = (wid & 1) * 32 + rt * 16 + r16;
            if ((wid & 1) * 32 + rt * 16 >= Lq) break;
            const bool lvalid = l < Lq;
            const size_t prow = smp ? (size_t)MP + b * DSEQ + (lvalid ? l : 0) : (size_t)b * SEQ + c * 64 + l;
            bf16_t* qp = P + prow * SWA_N + kv * 256 + gq * 64;
            bf16x8 qa[2];
            {
                float qf[2][8]; float ss = 0.f;
#pragma unroll
                for (int kk = 0; kk < 2; ++kk) { const u32x4 w = *(const u32x4*)(qp + kk * 32 + g4 * 8);
#pragma unroll
                    for (int j = 0; j < 4; ++j) { qf[kk][2 * j] = bf_lo(w[j]); qf[kk][2 * j + 1] = bf_hi(w[j]); } }
#pragma unroll
                for (int kk = 0; kk < 2; ++kk)
#pragma unroll
                    for (int j = 0; j < 8; ++j) ss += qf[kk][j] * qf[kk][j];
                ss += __shfl_xor(ss, 16); ss += __shfl_xor(ss, 32);
                const float rs = rsqrtf(ss * (1.0f / 64) + 1e-6f) * 0.125f;
#pragma unroll
                for (int kk = 0; kk < 2; ++kk) { u32x4 w;
#pragma unroll
                    for (int j = 0; j < 4; ++j) { const int d = kk * 32 + g4 * 8 + 2 * j; w[j] = cvt_pk_bf16(qf[kk][2 * j] * rs * qn[d], qf[kk][2 * j + 1] * rs * qn[d + 1]); }
                    qa[kk] = __builtin_bit_cast(bf16x8, w); }
            }
            f32x4 sc[12]; float mx = sink;
#pragma unroll
            for (int st = 0; st < 12; ++st) { f32x4 acc = (f32x4){0.f, 0.f, 0.f, 0.f};
#pragma unroll
                for (int kk = 0; kk < 2; ++kk) acc = MFMA16(*(const bf16x8*)(KS + (st * 16 + r16) * KS_S + kk * 32 + g4 * 8), qa[kk], acc);
#pragma unroll
                for (int j = 0; j < 4; ++j) { const int s = st * 16 + g4 * 4 + j; const bool kvalid = smp ? (s < 128 + DSEQ) : ((c - 2) * 64 + s >= 0);
                    const float v = kvalid ? acc[j] - slope * fabsf((float)(128 + l - s)) : -1e30f; acc[j] = v; mx = fmaxf(mx, v); }
                sc[st] = acc; }
            mx = fmaxf(mx, __shfl_xor(mx, 16)); mx = fmaxf(mx, __shfl_xor(mx, 32));
            float sum = 0.f;
#pragma unroll
            for (int st = 0; st < 12; ++st)
#pragma unroll
                for (int j = 0; j < 4; ++j) { const float e = __expf(sc[st][j] - mx); sc[st][j] = e; sum += e; }
            sum += __shfl_xor(sum, 16); sum += __shfl_xor(sum, 32);
            const float inv = 1.0f / (sum + __expf(sink - mx));
#pragma unroll
            for (int st = 0; st < 12; ++st) { u32x2 w; w.x = cvt_pk_bf16(sc[st][0] * inv, sc[st][1] * inv); w.y = cvt_pk_bf16(sc[st][2] * inv, sc[st][3] * inv);
                *(u32x2*)(pw + r16 * PW_S + st * 16 + g4 * 4) = w; }
            __builtin_amdgcn_fence(__ATOMIC_RELEASE, "wavefront"); __builtin_amdgcn_wave_barrier(); __builtin_amdgcn_fence(__ATOMIC_ACQUIRE, "wavefront");
#pragma unroll
            for (int dt = 0; dt < 4; ++dt) { f32x4 acc = (f32x4){0.f, 0.f, 0.f, 0.f};
#pragma unroll
                for (int kk = 0; kk < 6; ++kk) acc = MFMA16(*(const bf16x8*)(VT + (dt * 16 + r16) * VT_S + kk * 32 + g4 * 8), *(const bf16x8*)(pw + r16 * PW_S + kk * 32 + g4 * 8), acc);
                if (lvalid && live) { u32x2 w; w.x = cvt_pk_bf16(acc[0], acc[1]); w.y = cvt_pk_bf16(acc[2], acc[3]); *(u32x2*)(qp + dt * 16 + g4 * 4) = w; } }
            __builtin_amdgcn_fence(__ATOMIC_RELEASE, "wavefront"); __builtin_amdgcn_wave_barrier(); __builtin_amdgcn_fence(__ATOMIC_ACQUIRE, "wavefront");
        }
    }
}

#define XB_TMO      128
#define XB_XCNT(j)  (256  + 64 * (j))
#define XB_XSUB(j)  (1280 + 64 * (j))
#define XB_XGEN(j)  (2304 + 64 * (j))
#define XB_TOP      3328
#define XB_TOPGEN   3392
#define XCD_BAR_WORDS 3456
#define XB_SPIN_CAP (1u << 22)
static_assert(XCD_BAR_WORDS * 4 <= WS_BAR_BYTES, "barrier words");
__device__ __forceinline__ unsigned xb_ld(unsigned* p)              { return __hip_atomic_load(p, __ATOMIC_RELAXED, __HIP_MEMORY_SCOPE_AGENT); }
__device__ __forceinline__ unsigned xb_add(unsigned* p, unsigned v) { return __hip_atomic_fetch_add(p, v, __ATOMIC_RELAXED, __HIP_MEMORY_SCOPE_AGENT); }
__device__ __forceinline__ unsigned xb_xcc_id() { return (unsigned)__builtin_amdgcn_s_getreg((3 << 11) | 20) & 0xFu; }
#define XB_SPIN(cond, bar) do { unsigned _sp = 0; while (cond) { __builtin_amdgcn_s_sleep(1); \
    if ((++_sp & 255u) == 0u) { if (xb_ld(&(bar)[XB_TMO])) break; if (_sp > XB_SPIN_CAP) { atomicAdd(&(bar)[XB_TMO], 1u); break; } } } } while (0)
struct XcdBarrier { unsigned* bar; unsigned x; volatile LAS unsigned* st; };
__device__ __forceinline__ XcdBarrier xcd_barrier_post(unsigned* bar, volatile LAS unsigned* st) {
    XcdBarrier b; b.bar = bar; b.x = xb_xcc_id(); b.st = st;
    if (threadIdx.x == 0) (void)xb_add(&bar[XB_XCNT(b.x)], 1u);
    return b;
}
__device__ __forceinline__ void xcd_barrier_complete(unsigned* bar, unsigned x, unsigned& nloc, unsigned& nx) {
    const unsigned G = gridDim.x * gridDim.y * gridDim.z;
    unsigned sum, cnt, mine, sp = 0u;
    for (;;) {
        sum = 0u; cnt = 0u; mine = 0u;
#pragma unroll
        for (unsigned j = 0; j < 16; ++j) { const unsigned c = xb_ld(&bar[XB_XCNT(j)]); sum += c; cnt += (c > 0u) ? 1u : 0u; mine = (j == x) ? c : mine; }
        if (sum == G) break;
        __builtin_amdgcn_s_sleep(1);
        if ((++sp & 255u) == 0u) { if (xb_ld(&bar[XB_TMO])) break; if (sp > XB_SPIN_CAP) { atomicAdd(&bar[XB_TMO], 1u); break; } }
    }
    nloc = mine > 0u ? mine : 1u; nx = cnt > 0u ? cnt : 1u;
}
__device__ __forceinline__ void xcd_barrier(const XcdBarrier& b) {
    asm volatile("s_waitcnt vmcnt(0)" ::: "memory");
    __syncthreads();
    if (opaque_tid() == 0) {
        unsigned* bar = b.bar; asm volatile("" : "+s"(bar));
        __builtin_amdgcn_s_waitcnt(0);
        const unsigned bx = xb_xcc_id();
        unsigned nloc = b.st[0], nx = b.st[1];
        if (nloc == 0u) { xcd_barrier_complete(bar, bx, nloc, nx); b.st[0] = nloc; b.st[1] = nx; }
        const unsigned old = xb_add(&bar[XB_XSUB(bx)], 1u);
        const unsigned gen = old / nloc;
        if (old + 1u == (gen + 1u) * nloc) {
            __builtin_amdgcn_fence(__ATOMIC_RELEASE, "agent");
            asm volatile("s_waitcnt vmcnt(0)" ::: "memory");
            const unsigned og = xb_add(&bar[XB_TOP], 1u);
            const unsigned tg = og / nx;
            if (og + 1u == (tg + 1u) * nx) xb_add(&bar[XB_TOPGEN], 1u);
            else XB_SPIN(xb_ld(&bar[XB_TOPGEN]) == tg, bar);
            __builtin_amdgcn_fence(__ATOMIC_ACQUIRE, "agent");
            xb_add(&bar[XB_XGEN(bx)], 1u);
            asm volatile("s_waitcnt vmcnt(0)" ::: "memory");
        } else {
            XB_SPIN(xb_ld(&bar[XB_XGEN(bx)]) == gen, bar);
            __builtin_amdgcn_fence(__ATOMIC_ACQUIRE, "agent");
            asm volatile("s_waitcnt vmcnt(0)" ::: "memory");
        }
    }
    __syncthreads();
}
__device__ __forceinline__ void gsync_cg(cg::grid_group& g) {
    __builtin_amdgcn_fence(__ATOMIC_RELEASE, "agent");
    asm volatile("s_waitcnt vmcnt(0) lgkmcnt(0)" ::: "memory");
    g.sync();
    __builtin_amdgcn_fence(__ATOMIC_ACQUIRE, "agent");
    asm volatile("s_waitcnt vmcnt(0)" ::: "memory");
}
#define gsync(g) xcd_barrier(xbar)
__global__ void __launch_bounds__(NTHREADS, 2) fwd_megakernel(Params p) {
    extern __shared__ __attribute__((aligned(16))) unsigned char shm[];
    cg::grid_group grid = cg::this_grid();
    LAS unsigned char* shl = (LAS unsigned char*)shm;
    pg8::StaticOrder S;
    volatile LAS unsigned* xst = (volatile LAS unsigned*)(shl + LDS_BYTES - 16);
    if (threadIdx.x == 0) { xst[0] = 0u; xst[1] = 0u; }
    __syncthreads();
    const XcdBarrier xbar = xcd_barrier_post((unsigned*)(p.ws + WS_BAR), xst);

    grid.sync();
    prep_phase(shm, p);
    gsync(grid);
    prepb_phase(p);
    gsync(grid);
#pragma unroll 1
    for (int layer = 0; layer < 4; ++layer) {
        int z = 0; asm volatile("" : "+s"(z));
        unsigned char* ws = p.ws + z; float* yo = p.out + z;
        bf16_t* H = (bf16_t*)(ws + WS_H); bf16_t* P = (bf16_t*)(ws + WS_P);
        const float* mod = (const float*)(ws + WS_MOD);
        float* RS = (float*)(ws + WS_RSS);
        LAS float* RSL = (LAS float*)(shl + 128 * 1024);
        const float* avec = (const float*)(ws + WS_AVEC); const float* cvec = (const float*)(ws + WS_CVEC);
        const int kind = layer % 3, j = layer / 3;
        const float* mod_l = mod + (size_t)layer * 32 * ADA;
        const float* yin_p = layer == 0 ? p.in[0 + z] : yo; const float* yin_s = layer == 0 ? p.in[1 + z] : yo + O_YS;
        const float* cv_mix = cvec + (size_t)32 * stage_cvoff(2 * layer); const float* cv_mlp = cvec + (size_t)32 * stage_cvoff(2 * layer + 1);
        const bf16_t* WoT; int Ko, lda_o; const bf16_t* Ao;
        if (kind == 0) {
            { pg8::Gemm g{H, (const bf16_t*)(ws + WS_GIN) + (size_t)j * GLA_N * D, MP, GLA_N, D, D}; S.init(MP, GLA_N, opaque_nwg(), opaque_bid());
              pg8::EpiBf16 E{P, GLA_N, 0, 3072, p.in[20 + z] + j * 512, RS, cv_mix, RSL}; pg8::rs_stage(S, RS, 0, RSL); pg8::gemm_phase(shl, g, S, E); pg8::gemm_sample(shm, g, E); }
            gsync(grid);
            recur_phase<GLA_DK, GLA_DV, true>(shm, P, GLA_N, 0, 512, 1024, 3072, layer == 0 ? p.in[2 + z] : p.in[6 + z], yo + (layer == 0 ? O_G0P : O_G3P), yo + (layer == 0 ? O_G0S : O_G3S));
            gsync(grid);
            post_phase<GLA_DV, true>(P, GLA_N, 1024, 2048, p.in[22 + z] + j * GLA_DV);
            WoT = (const bf16_t*)(ws + WS_GO) + (size_t)j * D * D; Ko = D; lda_o = GLA_N; Ao = P + 2048;
        } else if (kind == 1) {
            { pg8::Gemm g{H, (const bf16_t*)(ws + WS_RIN), MP, RET_N, D, D}; S.init(MP, RET_N, opaque_nwg(), opaque_bid());
              pg8::EpiBf16 E{P, RET_N, 0, 1 << 30, nullptr, RS, cv_mix, RSL}; pg8::rs_stage(S, RS, 0, RSL); pg8::gemm_phase(shl, g, S, E); pg8::gemm_sample(shm, g, E); }
            gsync(grid);
            recur_phase<RET_DK, RET_DV, false>(shm, P, RET_N, 0, 1024, 2048, 0, p.in[3 + z], yo + O_RP, yo + O_RS);
            gsync(grid);
            post_phase<RET_DV, false>(P, RET_N, 2048, 4096, nullptr);
            WoT = (const bf16_t*)(ws + WS_RO); Ko = 2048; lda_o = RET_N; Ao = P + 4096;
        } else {
            { pg8::Gemm g{H, (const bf16_t*)(ws + WS_SIN), MP, SWA_N, D, D}; S.init(MP, SWA_N, opaque_nwg(), opaque_bid());
              pg8::EpiBf16 E{P, SWA_N, 0, 1 << 30, nullptr, RS, cv_mix, RSL}; pg8::rs_stage(S, RS, 0, RSL); pg8::gemm_phase(shl, g, S, E); pg8::gemm_sample(shm, g, E); }
            gsync(grid);
            swa_phase(shm, p, P, z);
            WoT = (const bf16_t*)(ws + WS_SO); Ko = D; lda_o = SWA_N; Ao = P;
        }
        gsync(grid);
        { pg8::Gemm g{Ao, WoT, MP, D, Ko, lda_o}; S.init(MP, D, opaque_nwg(), opaque_bid());
          pg8::EpiRes E{yin_p, yin_s, yo, mod_l + 2 * D, H, avec + (size_t)(2 * layer + 1) * 32 * D, RS}; pg8::gemm_phase(shl, g, S, E); pg8::gemm_sample(shm, g, E); }
        gsync(grid);
        { pg8::Gemm g{H, (const bf16_t*)(ws + WS_W1T) + (size_t)layer * HID * D, MP, HID, D, D}; S.init(MP, HID, opaque_nwg(), opaque_bid());
          pg8::EpiBf16 E{P, HID, 1, 1 << 30, nullptr, RS, cv_mlp, RSL}; pg8::rs_stage(S, RS, 0, RSL); pg8::gemm_phase(shl, g, S, E); pg8::gemm_sample(shm, g, E); }
        gsync(grid);
        { pg8::Gemm g{P, (const bf16_t*)(ws + WS_W2T) + (size_t)layer * HID * D, MP, D, HID, HID}; S.init(MP, D, opaque_nwg(), opaque_bid());
          pg8::EpiRes E{yo, yo + O_YS, yo, mod_l + 5 * D, layer < 3 ? H : nullptr, avec + (size_t)(layer < 3 ? 2 * layer + 2 : 0) * 32 * D, RS}; pg8::gemm_phase(shl, g, S, E); pg8::gemm_sample(shm, g, E); }
        gsync(grid);
    }
}

extern "C" void kernel_launch(void* const* d_in, const int* in_sizes, int n_in, void* d_out, int out_size, void* d_ws, size_t ws_size, hipStream_t stream) {
    static int grid_blocks = 0;
    if (grid_blocks == 0) {
        if (n_in != 34 || (size_t)out_size != O_END || ws_size < WS_END) { fprintf(stderr, "kernel_launch: unexpected sizes n_in %d out %d ws %zu (need %zu)\n", n_in, out_size, ws_size, (size_t)WS_END); grid_blocks = -1; return; }
        int dev = 0, cus = 0, per_cu = 0;
        hipGetDevice(&dev);
        hipDeviceGetAttribute(&cus, hipDeviceAttributeMultiprocessorCount, dev);
        if (hipFuncSetAttribute((const void*)fwd_megakernel, hipFuncAttributeMaxDynamicSharedMemorySize, LDS_BYTES) != hipSuccess) { fprintf(stderr, "kernel_launch: hipFuncSetAttribute failed\n"); grid_blocks = -1; return; }
        hipOccupancyMaxActiveBlocksPerMultiprocessor(&per_cu, (const void*)fwd_megakernel, NTHREADS, LDS_BYTES);
        if (per_cu < 1) { fprintf(stderr, "kernel_launch: occupancy query says %d blocks per CU\n", per_cu); grid_blocks = -1; return; }
        grid_blocks = cus * per_cu;
    }
    if (grid_blocks < 0) return;
    Params p{};
    for (int i = 0; i < 34; ++i) p.in[i] = (const float*)d_in[i];
    p.out = (float*)d_out; p.ws = (unsigned char*)d_ws;
    unsigned char* ws = (unsigned char*)d_ws;
    int nj = 0, tiles = 0;
    auto add = [&](const float* src, bf16_t* dst, int K, int N, float scale) { TJob& j = p.jobs[nj++]; j.src = src; j.dst = dst; j.K = K; j.N = N; j.tile0 = tiles; j.scale = scale; tiles += (K / 64) * (N / 128); };
    for (int l = 0; l < 4; ++l) {
        add(p.in[13] + (size_t)l * D * HID, (bf16_t*)(ws + WS_W1T) + (size_t)l * HID * D, D, HID, 1.0f);
        add(p.in[14] + (size_t)l * HID * D, (bf16_t*)(ws + WS_W2T) + (size_t)l * HID * D, HID, D, 1.0f);
    }
    for (int j = 0; j < 2; ++j) {
        bf16_t* gin = (bf16_t*)(ws + WS_GIN) + (size_t)j * GLA_N * D;
        add(p.in[15] + (size_t)j * D * 512, gin, D, 512, 0.08838834764831845f);
        add(p.in[16] + (size_t)j * D * 512, gin + (size_t)512 * D, D, 512, 1.0f);
        add(p.in[17] + (size_t)j * D * D, gin + (size_t)1024 * D, D, D, 1.0f);
        add(p.in[21] + (size_t)j * D * D, gin + (size_t)2048 * D, D, D, 1.0f);
        add(p.in[23] + (size_t)j * D * D, (bf16_t*)(ws + WS_GO) + (size_t)j * D * D, D, D, 1.0f);
    }
    {
        bf16_t* rin = (bf16_t*)(ws + WS_RIN);
        add(p.in[24], rin, D, D, 1.0f);
        add(p.in[25], rin + (size_t)1024 * D, D, D, 0.0625f);
        add(p.in[26], rin + (size_t)2048 * D, D, 2048, 1.0f);
        add(p.in[27], rin + (size_t)4096 * D, D, 2048, 1.0f);
        add(p.in[28], (bf16_t*)(ws + WS_RO), 2048, D, 1.0f);
    }
    add(p.in[29], (bf16_t*)(ws + WS_SIN), D, SWA_N, 1.0f);
    add(p.in[33], (bf16_t*)(ws + WS_SO), D, D, 1.0f);
    p.ntiles = tiles;
    if (hipMemsetAsync(ws + WS_BAR, 0, WS_BAR_BYTES, stream) != hipSuccess) { fprintf(stderr, "kernel_launch: memset of barrier words failed\n"); return; }
    void* args[] = {&p};
    hipError_t e = hipLaunchCooperativeKernel((const void*)fwd_megakernel, dim3(grid_blocks), dim3(NTHREADS), args, LDS_BYTES, stream);
    if (e != hipSuccess) fprintf(stderr, "kernel_launch: cooperative launch failed: %s (grid %d)\n", hipGetErrorString(e), grid_blocks);
}
```

```cpp
#include <hip/hip_runtime.h>
#include <hip/hip_cooperative_groups.h>
#include <cstdio>
#include <cstdint>
namespace cg = cooperative_groups;

#define LAS __attribute__((address_space(3)))
typedef unsigned short bf16_t;
typedef short bf16x8 __attribute__((ext_vector_type(8)));
typedef float f32x4 __attribute__((ext_vector_type(4)));
typedef unsigned u32x4 __attribute__((ext_vector_type(4)));
typedef unsigned u32x2 __attribute__((ext_vector_type(2)));

constexpr int D = 1024, NB = 16, SEQ = 4096, DSEQ = 16, MP = NB * SEQ, MS = NB * DSEQ, MT = MP + MS;
constexpr int HID = 4096, ADA = 6 * D;
constexpr int GLA_H = 4, GLA_DK = 128, GLA_DV = 256, GLA_N = 3584;
constexpr int RET_H = 4, RET_DK = 256, RET_DV = 512, RET_N = 6144;
constexpr int SWA_N = 1536;
constexpr int NTHREADS = 512;
constexpr int LDS_BYTES = 160 * 1024;
constexpr int DBG_LAYER_MASK = 0xF; constexpr bool DBG_MIXER = true, DBG_MLP = true; constexpr int DBG_SKIP = 0; constexpr bool DBG_FRESH_O = false; constexpr int PROBE_DUP_MIXER = 0, PROBE_DUP_GEMM = 0, PROBE_DUP_MOD = 0;

constexpr size_t O_YP = 0, O_YS = O_YP + (size_t)MP * D, O_G0P = O_YS + (size_t)MS * D, O_G0S = O_G0P + (size_t)NB * 4 * 128 * 256,
                 O_RP = O_G0S + (size_t)NB * 4 * 128 * 256, O_RS = O_RP + (size_t)NB * 4 * 256 * 512, O_KP = O_RS + (size_t)NB * 4 * 256 * 512,
                 O_VP = O_KP + (size_t)NB * 128 * 256, O_KS = O_VP + (size_t)NB * 128 * 256, O_VS = O_KS + (size_t)NB * 16 * 256,
                 O_G3P = O_VS + (size_t)NB * 16 * 256, O_G3S = O_G3P + (size_t)NB * 4 * 128 * 256, O_END = O_G3S + (size_t)NB * 4 * 128 * 256;

constexpr size_t WS_W1T = 0;
constexpr size_t WS_W2T = WS_W1T + (size_t)4 * HID * D * 2;
constexpr size_t WS_GIN = WS_W2T + (size_t)4 * HID * D * 2;
constexpr size_t WS_GO  = WS_GIN + (size_t)2 * GLA_N * D * 2;
constexpr size_t WS_RIN = WS_GO + (size_t)2 * D * D * 2;
constexpr size_t WS_RO  = WS_RIN + (size_t)RET_N * D * 2;
constexpr size_t WS_SIN = WS_RO + (size_t)D * 2048 * 2;
constexpr size_t WS_SO  = WS_SIN + (size_t)SWA_N * D * 2;
constexpr size_t WS_MOD = WS_SO + (size_t)D * D * 2;
constexpr size_t WS_H   = WS_MOD + (size_t)4 * 32 * ADA * 4;
constexpr size_t WS_P   = WS_H + (size_t)MT * D * 2;
constexpr size_t WS_AVEC = WS_P + (size_t)MT * RET_N * 2;
constexpr size_t WS_CVEC = WS_AVEC + (size_t)8 * 32 * D * 4;
constexpr int CVEC_TOTAL_N = 2 * GLA_N + RET_N + SWA_N + 4 * HID;
constexpr size_t WS_RSS = WS_CVEC + (size_t)32 * CVEC_TOTAL_N * 4;
constexpr size_t WS_BAR = WS_RSS + (size_t)MP * 16 * 4 + (size_t)MS * 64 * 4;
constexpr size_t WS_BAR_BYTES = 16384;
constexpr size_t WS_END = WS_BAR + WS_BAR_BYTES;

struct TJob { const float* src; bf16_t* dst; int K, N, tile0; float scale; };
constexpr int NJOBS = 25;
struct Params {
    const float* in[34];
    float* out;
    unsigned char* ws;
    TJob jobs[NJOBS];
    int ntiles; int pad0;
};

typedef __bf16 bf16x2_t __attribute__((ext_vector_type(2)));
typedef float f32x2_t __attribute__((ext_vector_type(2)));
__device__ __forceinline__ unsigned cvt_pk_bf16(float lo, float hi) { const f32x2_t v = {lo, hi}; const bf16x2_t r = __builtin_convertvector(v, bf16x2_t); return __builtin_bit_cast(unsigned, r); }
__device__ __forceinline__ float bf_lo(unsigned u) { return __uint_as_float(u << 16); }
__device__ __forceinline__ float bf_hi(unsigned u) { return __uint_as_float(u & 0xffff0000u); }
__device__ __forceinline__ float silu_f(float x) { return x / (1.0f + __expf(-x)); }
__device__ __forceinline__ int seq_of_row(int r) { return r < MP ? (r >> 12) : 16 + ((r - MP) >> 4); }
__device__ __forceinline__ int opaque_tid() { int t = threadIdx.x; asm volatile("" : "+v"(t)); return t; }
__device__ __forceinline__ int opaque_bid() { int t = blockIdx.x; asm volatile("" : "+s"(t)); return t; }
__device__ __forceinline__ int opaque_nwg() { int t = gridDim.x; asm volatile("" : "+s"(t)); return t; }
__device__ __forceinline__ float wave_sum(float v) {
#pragma unroll
    for (int o = 32; o > 0; o >>= 1) v += __shfl_xor(v, o);
    return v;
}

namespace pg8 {
constexpr int BM = 256, BK = 64, HALF = 128, HTB = HALF * BK * 2, STAGE_BYTES = 8 * HTB, NXCD = 8, WGM = 8;
__host__ __device__ __forceinline__ int lds_byte(int r, int c) { const int st = (r >> 4) * 2 + (c >> 5), rr = r & 15, cc = c & 31, ob = rr * 64 + cc * 2; return st * 1024 + (ob ^ (((ob >> 9) & 1) << 5)); }
__host__ __device__ __forceinline__ void stage_rc(int b, int& R, int& C) { const int st = b / 1024, sb = b % 1024, swz = sb ^ (((sb >> 9) & 1) << 5); R = (st >> 1) * 16 + swz / 64; C = (st & 1) * 32 + (swz % 64) / 2; }
__host__ __device__ __forceinline__ int perm32(int rho) { const int n = rho >> 4, i = rho & 15; return 8 * (i >> 2) + 4 * n + (i & 3); }
struct Unit { int pm, pn; };
struct Gemm { const bf16_t* A; const bf16_t* Bt; int M, N, K, lda; };
struct StaticOrder {
    int nM, nN, nwg, G, c;
    __device__ void init(int M, int N, int G_, int c_) { nM = M / BM; nN = N / BM; nwg = nM * nN; G = G_; c = c_; }
    __device__ bool next(int i, Unit& u) const {
        const long L = (long)i * G + c; if (L >= nwg) return false;
        int wgid = (int)L; { const int q = nwg / NXCD, r = nwg % NXCD, xcd = wgid % NXCD, off = wgid / NXCD; wgid = (xcd < r ? xcd * (q + 1) : r * (q + 1) + (xcd - r) * q) + off; }
        const int nig = WGM * nN, gid = wgid / nig, fm = gid * WGM, gsz = (nM - fm) < WGM ? (nM - fm) : WGM;
        u.pm = fm + ((wgid % nig) % gsz); u.pn = (wgid % nig) / gsz; return true;
    }
};

template <class Epi, bool ALIGN_EPI = true, bool SP2 = true>
__device__ __forceinline__ void gemm_phase(LAS unsigned char* lds, const Gemm g, const StaticOrder& S, const Epi& E) {
    const int tid = opaque_tid(), wid = __builtin_amdgcn_readfirstlane(tid >> 6), lane = tid & 63, wr = wid >> 2, wc = wid & 3, fr = lane & 15, fq = lane >> 4;
    const int K = g.K, nt = K / BK, lda = g.lda;
    unsigned voffA[2], voffB[2];
#pragma unroll
    for (int i = 0; i < 2; ++i) { int R, C; stage_rc(tid * 16 + i * 8192, R, C); const int Rb = Epi::PERM ? ((R & ~31) + perm32(R & 31)) : R;
        voffA[i] = (unsigned)(R * lda + C) * 2u; voffB[i] = (unsigned)(Rb * K + C) * 2u; }
    const size_t kstep = (size_t)(BK * 2);
    const size_t hstepA = (size_t)HALF * lda * 2, hstepB = (size_t)HALF * K * 2;
    const size_t tstepA = 2 * hstepA, tstepB = 2 * hstepB;
    const unsigned ldsw = (unsigned)wid * 1024u;
    const int aoff = lds_byte(wr * 64 + fr, fq * 8), boff = lds_byte(wc * 32 + fr, fq * 8);
#define PG8_SA(b, h) (((b) * 2 + (h)) * HTB)
#define PG8_SB(b, h) ((4 + (b) * 2 + (h)) * HTB)
#define PG8_STAGE(bufoff, gbase, voff) do { _Pragma("unroll") for (int _i = 0; _i < 2; ++_i) \
        __builtin_amdgcn_global_load_lds((const unsigned*)((const char*)(gbase) + (voff)[_i]), (LAS unsigned*)(lds + (bufoff) + ldsw + _i * 8192), 16, 0, 0); } while (0)
#define PG8_LDA(dst, b, h) do { _Pragma("unroll") for (int m = 0; m < 4; ++m) _Pragma("unroll") for (int k = 0; k < 2; ++k) dst[m][k] = *(const LAS bf16x8*)(lds + PG8_SA(b, h) + aoff + m * 2048 + k * 1024); } while (0)
#define PG8_LDB(dst, b, h) do { _Pragma("unroll") for (int n = 0; n < 2; ++n) _Pragma("unroll") for (int k = 0; k < 2; ++k) dst[n][k] = *(const LAS bf16x8*)(lds + PG8_SB(b, h) + boff + n * 2048 + k * 1024); } while (0)
#define PG8_MMA(ai, bj, At, Bt) do { __builtin_amdgcn_s_setprio(1); _Pragma("unroll") for (int m = 0; m < 4; ++m) _Pragma("unroll") for (int n = 0; n < 2; ++n) _Pragma("unroll") for (int k = 0; k < 2; ++k) \
        acc[ai][bj][m][n] = __builtin_amdgcn_mfma_f32_16x16x32_bf16(Bt[n][k], At[m][k], acc[ai][bj][m][n], 0, 0, 0); __builtin_amdgcn_s_setprio(0); } while (0)
#define PG8_WAIT_V(n) asm volatile("s_waitcnt vmcnt(" #n ")" ::: "memory")
#define PG8_WAIT_L(n) asm volatile("s_waitcnt lgkmcnt(" #n ")" ::: "memory")
#define PG8_BAR __builtin_amdgcn_s_barrier()
#define PG8_SCHED __builtin_amdgcn_sched_barrier(0)
    Unit cur, nxt; int ui = 0;
    if (!S.next(0, cur)) return;
    f32x4 acc[2][2][4][2];
#pragma unroll
    for (int a = 0; a < 2; ++a)
#pragma unroll
        for (int b = 0; b < 2; ++b)
#pragma unroll
            for (int m = 0; m < 4; ++m)
#pragma unroll
                for (int n = 0; n < 2; ++n) acc[a][b][m][n] = (f32x4){0.f, 0.f, 0.f, 0.f};
    bf16x8 At[4][2], B0[2][2], B1[2][2];
    const char* cA = (const char*)g.A + (size_t)cur.pm * tstepA; const char* cB = (const char*)g.Bt + (size_t)cur.pn * tstepB;
    if constexpr (SP2) {
        PG8_STAGE(PG8_SB(0, 0), cB, voffB); PG8_STAGE(PG8_SB(0, 1), cB + hstepB, voffB); PG8_STAGE(PG8_SA(0, 0), cA, voffA); PG8_STAGE(PG8_SA(0, 1), cA + hstepA, voffA);
        if (wr == 1) PG8_BAR;
        PG8_WAIT_V(2); PG8_BAR;
        PG8_STAGE(PG8_SB(1, 0), cB + kstep, voffB); PG8_STAGE(PG8_SA(1, 0), cA + kstep, voffA); PG8_STAGE(PG8_SB(1, 1), cB + hstepB + kstep, voffB);
        PG8_WAIT_V(6); PG8_BAR;
    } else {
        PG8_STAGE(PG8_SB(0, 0), cB, voffB); PG8_STAGE(PG8_SA(0, 0), cA, voffA); PG8_STAGE(PG8_SB(0, 1), cB + hstepB, voffB); PG8_STAGE(PG8_SA(0, 1), cA + hstepA, voffA);
        if (wr == 1) PG8_BAR;
        PG8_WAIT_V(4); PG8_BAR;
        PG8_STAGE(PG8_SB(1, 0), cB + kstep, voffB); PG8_STAGE(PG8_SA(1, 0), cA + kstep, voffA); PG8_STAGE(PG8_SB(1, 1), cB + hstepB + kstep, voffB);
        PG8_WAIT_V(6); PG8_BAR;
    }
    for (;;) {
        const bool has_next = S.next(ui + 1, nxt);
        const char* nA = has_next ? (const char*)g.A + (size_t)nxt.pm * tstepA : cA; const char* nB = has_next ? (const char*)g.Bt + (size_t)nxt.pn * tstepB : cB;
        for (int t = 0; t < nt; t += 2) {
            const bool last = (t == nt - 2);
            const char* a1 = cA + (size_t)(t + 1) * kstep;
            const char* a2 = last ? nA : cA + (size_t)(t + 2) * kstep; const char* b2 = last ? nB : cB + (size_t)(t + 2) * kstep;
            const char* a3 = a2 + kstep; const char* b3 = b2 + kstep;
            if constexpr (SP2) {
            PG8_LDB(B0, 0, 0); PG8_LDB(B1, 0, 1); PG8_SCHED; PG8_LDA(At, 0, 0); PG8_STAGE(PG8_SA(1, 1), a1 + hstepA, voffA);
            PG8_WAIT_V(8); PG8_WAIT_L(0); PG8_BAR; PG8_MMA(0, 0, At, B0); PG8_MMA(0, 1, At, B1); PG8_BAR; PG8_SCHED;
            PG8_LDA(At, 0, 1); PG8_STAGE(PG8_SB(0, 0), b2, voffB); PG8_STAGE(PG8_SB(0, 1), b2 + hstepB, voffB); PG8_STAGE(PG8_SA(0, 0), a2, voffA);
            PG8_WAIT_V(8); PG8_WAIT_L(0); PG8_BAR; PG8_MMA(1, 0, At, B0); PG8_MMA(1, 1, At, B1); PG8_BAR; PG8_SCHED;
            PG8_LDB(B0, 1, 0); PG8_LDB(B1, 1, 1); PG8_SCHED; PG8_LDA(At, 1, 0); PG8_STAGE(PG8_SA(0, 1), a2 + hstepA, voffA);
            PG8_WAIT_V(8); PG8_WAIT_L(0); PG8_BAR; PG8_MMA(0, 0, At, B0); PG8_MMA(0, 1, At, B1); PG8_BAR; PG8_SCHED;
            PG8_LDA(At, 1, 1); PG8_STAGE(PG8_SB(1, 0), b3, voffB); PG8_STAGE(PG8_SB(1, 1), b3 + hstepB, voffB); PG8_STAGE(PG8_SA(1, 0), a3, voffA);
            PG8_WAIT_V(8); PG8_WAIT_L(0); PG8_BAR; PG8_MMA(1, 0, At, B0); PG8_MMA(1, 1, At, B1); PG8_BAR; PG8_SCHED;
            } else {
            PG8_LDB(B0, 0, 0); PG8_SCHED; PG8_LDA(At, 0, 0); PG8_STAGE(PG8_SA(1, 1), a1 + hstepA, voffA);
            PG8_WAIT_L(8); PG8_BAR; PG8_WAIT_L(0); PG8_MMA(0, 0, At, B0); PG8_BAR; PG8_SCHED;
            PG8_LDB(B1, 0, 1); PG8_STAGE(PG8_SB(0, 0), b2, voffB);
            PG8_BAR; PG8_WAIT_L(0); PG8_MMA(0, 1, At, B1); PG8_BAR;
            PG8_LDA(At, 0, 1); PG8_STAGE(PG8_SA(0, 0), a2, voffA);
            PG8_BAR; PG8_WAIT_L(0); PG8_MMA(1, 0, At, B0); PG8_BAR; PG8_SCHED;
            PG8_STAGE(PG8_SB(0, 1), b2 + hstepB, voffB);
            PG8_WAIT_V(6); PG8_BAR; PG8_MMA(1, 1, At, B1); PG8_BAR;
            PG8_LDB(B0, 1, 0); PG8_SCHED; PG8_LDA(At, 1, 0); PG8_STAGE(PG8_SA(0, 1), a2 + hstepA, voffA);
            PG8_WAIT_L(8); PG8_BAR; PG8_WAIT_L(0); PG8_MMA(0, 0, At, B0); PG8_BAR; PG8_SCHED;
            PG8_LDB(B1, 1, 1); PG8_STAGE(PG8_SB(1, 0), b3, voffB);
            PG8_BAR; PG8_WAIT_L(0); PG8_MMA(0, 1, At, B1); PG8_BAR;
            PG8_LDA(At, 1, 1); PG8_STAGE(PG8_SA(1, 0), a3, voffA);
            PG8_BAR; PG8_WAIT_L(0); PG8_MMA(1, 0, At, B0); PG8_BAR; PG8_SCHED;
            PG8_STAGE(PG8_SB(1, 1), b3 + hstepB, voffB);
            PG8_WAIT_V(6); PG8_BAR; PG8_MMA(1, 1, At, B1); PG8_BAR;
            }
        }
        if constexpr (ALIGN_EPI) { if (wr == 0) PG8_BAR; }
        E(acc, cur, wr, wc, fr, fq, ui);
        if (!has_next) break;
#pragma unroll
        for (int a = 0; a < 2; ++a)
#pragma unroll
            for (int b = 0; b < 2; ++b)
#pragma unroll
                for (int m = 0; m < 4; ++m)
#pragma unroll
                    for (int n = 0; n < 2; ++n) acc[a][b][m][n] = (f32x4){0.f, 0.f, 0.f, 0.f};
        cur = nxt; cA = nA; cB = nB; ++ui;
        if constexpr (ALIGN_EPI) { if (wr == 1) PG8_BAR; }
    }
    PG8_WAIT_V(0);
    if constexpr (!ALIGN_EPI) { if (wr == 0) PG8_BAR; }
    PG8_BAR;
#undef PG8_SA
#undef PG8_SB
#undef PG8_STAGE
#undef PG8_LDA
#undef PG8_LDB
#undef PG8_MMA
#undef PG8_WAIT_V
#undef PG8_WAIT_L
#undef PG8_BAR
#undef PG8_SCHED
}

__device__ __forceinline__ float row_rs(const float* rss, int r) {
    float t;
    if (r < MP) { const f32x4* q = (const f32x4*)(rss + (size_t)r * 16); const f32x4 a = q[0] + q[1] + q[2] + q[3]; t = (a[0] + a[1]) + (a[2] + a[3]); }
    else { const f32x4* q = (const f32x4*)(rss + (size_t)MP * 16 + (size_t)(r - MP) * 64); f32x4 a = q[0];
#pragma unroll
        for (int i = 1; i < 16; ++i) a += q[i];
        t = (a[0] + a[1]) + (a[2] + a[3]); }
    return rsqrtf(t * (1.0f / D) + 1e-6f);
}
__device__ __forceinline__ float logsig16(float x) { return (fminf(x, 0.f) - __logf(1.0f + __expf(-fabsf(x)))) * (1.0f / 16.0f); }
__device__ __forceinline__ void rs_stage(const StaticOrder& S, const float* rowss, int rbase, LAS float* rsl) {
    const int tid = opaque_tid();
    int nu = 0; { Unit u; while (nu < 24 && S.next(nu, u)) ++nu; }
    __syncthreads();
    for (int idx = tid; idx < nu * 256; idx += NTHREADS) { Unit u; S.next(idx >> 8, u);
        const f32x4* q = (const f32x4*)(rowss + (size_t)(rbase + u.pm * BM + (idx & 255)) * 16);
        const f32x4 a = (q[0] + q[1]) + (q[2] + q[3]);
        rsl[idx] = rsqrtf(((a[0] + a[1]) + (a[2] + a[3])) * (1.0f / D) + 1e-6f); }
    __syncthreads();
}
struct EpiBf16 {
    static constexpr bool PERM = true;
    bf16_t* O; int ldc; int mode; int gate_lo; const float* bias; const float* rowss; const float* cvec;
    const LAS float* rsl;
    __device__ __forceinline__ void tile4(int r, int c, f32x4 v) const {
        const float rs = row_rs(rowss, r);
        v = v * rs + *(const f32x4*)(cvec + (size_t)seq_of_row(r) * ldc + c);
        if (mode == 1) {
#pragma unroll
            for (int j = 0; j < 4; ++j) { const float a = fmaxf(v[j], 0.f); v[j] = a * a; } }
        if (c >= gate_lo) { const f32x4 b = *(const f32x4*)(bias + (c - gate_lo));
#pragma unroll
            for (int j = 0; j < 4; ++j) v[j] = logsig16(v[j] + b[j]); }
        u32x2 w; w.x = cvt_pk_bf16(v[0], v[1]); w.y = cvt_pk_bf16(v[2], v[3]);
        *(u32x2*)(O + (size_t)r * ldc + c) = w;
    }
    __device__ __forceinline__ void operator()(const f32x4 (&acc)[2][2][4][2], const Unit& u, int wr, int wc, int fr, int fq, int ui) const {
        const int row0 = u.pm * BM + wr * 64 + fr, colt = u.pn * BM, col0 = colt + wc * 32 + 8 * fq;
        const bool gate = colt >= gate_lo;
        const float* cvp = cvec + (size_t)seq_of_row(u.pm * BM) * ldc + col0;
        f32x4 bv[2][2];
#pragma unroll
        for (int bj = 0; bj < 2; ++bj)
#pragma unroll
            for (int n = 0; n < 2; ++n) { bv[bj][n] = *(const f32x4*)(cvp + bj * HALF + 4 * n); if (gate) bv[bj][n] += *(const f32x4*)(bias + (col0 - gate_lo) + bj * HALF + 4 * n); }
#pragma unroll
        for (int ai = 0; ai < 2; ++ai) {
#pragma unroll
            for (int m = 0; m < 4; ++m) { const int r = row0 + ai * HALF + m * 16; bf16_t* rowp = O + (size_t)r * ldc + col0;
                const float rs = rsl[ui * 256 + wr * 64 + fr + ai * HALF + m * 16];
#pragma unroll
                for (int bj = 0; bj < 2; ++bj) { f32x4 v0 = acc[ai][bj][m][0] * rs + bv[bj][0], v1 = acc[ai][bj][m][1] * rs + bv[bj][1];
                    if (mode == 1) {
#pragma unroll
                        for (int j = 0; j < 4; ++j) { const float a = fmaxf(v0[j], 0.f), b = fmaxf(v1[j], 0.f); v0[j] = a * a; v1[j] = b * b; } }
                    if (gate) {
#pragma unroll
                        for (int j = 0; j < 4; ++j) { v0[j] = logsig16(v0[j]); v1[j] = logsig16(v1[j]); } }
                    u32x4 w; w.x = cvt_pk_bf16(v0[0], v0[1]); w.y = cvt_pk_bf16(v0[2], v0[3]); w.z = cvt_pk_bf16(v1[0], v1[1]); w.w = cvt_pk_bf16(v1[2], v1[3]);
                    *(u32x4*)(rowp + bj * HALF) = w; } } }
    }
};
struct EpiRes {
    static constexpr bool PERM = false;
    const float* yin_p; const float* yin_s; float* yout; const float* gate;
    bf16_t* Hn; const float* av; float* rowss_next;
    __device__ __forceinline__ void tile4(int r, int c, f32x4 v) const {
        const int sq = seq_of_row(r);
        const f32x4 gv = *(const f32x4*)(gate + (size_t)sq * ADA + c), iv = *(const f32x4*)((r < MP ? yin_p + (size_t)r * D : yin_s + (size_t)(r - MP) * D) + c);
        const f32x4 y = iv + gv * v;
        *(f32x4*)(yout + (size_t)r * D + c) = y;
        if (Hn) {
            const f32x4 a = *(const f32x4*)(av + (size_t)sq * D + c);
            u32x2 w; w.x = cvt_pk_bf16(y[0] * a[0], y[1] * a[1]); w.y = cvt_pk_bf16(y[2] * a[2], y[3] * a[3]);
            *(u32x2*)(Hn + (size_t)r * D + c) = w;
            float ss = y[0] * y[0] + y[1] * y[1] + y[2] * y[2] + y[3] * y[3];
            ss += __shfl_xor(ss, 16); ss += __shfl_xor(ss, 32);
            if ((threadIdx.x & 48) == 0) rowss_next[(size_t)MP * 16 + (size_t)(r - MP) * 64 + (c >> 4)] = ss;
        }
    }
    __device__ __forceinline__ void operator()(const f32x4 (&acc)[2][2][4][2], const Unit& u, int wr, int wc, int fr, int fq, int ui) const {
        const int row0 = u.pm * BM + wr * 64 + fr, col0 = u.pn * BM + wc * 32 + 4 * fq;
        const int sq = seq_of_row(u.pm * BM);
        const float* gp = gate + (size_t)sq * ADA + col0;
        const float* avp = av + (size_t)sq * D + col0;
#pragma unroll
        for (int ai = 0; ai < 2; ++ai) {
            f32x4 yv[4][2][2];
#pragma unroll
            for (int m = 0; m < 4; ++m) { const float* ip = yin_p + (size_t)(row0 + ai * HALF + m * 16) * D + col0;
#pragma unroll
                for (int bj = 0; bj < 2; ++bj)
#pragma unroll
                    for (int n = 0; n < 2; ++n) yv[m][bj][n] = *(const f32x4*)(ip + bj * HALF + n * 16); }
            float ss[4] = {0.f, 0.f, 0.f, 0.f};
#pragma unroll
            for (int bj = 0; bj < 2; ++bj)
#pragma unroll
                for (int n = 0; n < 2; ++n) { const int co = bj * HALF + n * 16;
                    const f32x4 gv = *(const f32x4*)(gp + co), a = Hn ? *(const f32x4*)(avp + co) : (f32x4){0.f, 0.f, 0.f, 0.f};
#pragma unroll
                    for (int m = 0; m < 4; ++m) { const int r = row0 + ai * HALF + m * 16;
                        const f32x4 y = yv[m][bj][n] + gv * acc[ai][bj][m][n];
                        *(f32x4*)(yout + (size_t)r * D + col0 + co) = y;
                        if (Hn) { u32x2 w; w.x = cvt_pk_bf16(y[0] * a[0], y[1] * a[1]); w.y = cvt_pk_bf16(y[2] * a[2], y[3] * a[3]);
                            *(u32x2*)(Hn + (size_t)r * D + col0 + co) = w;
                            ss[m] += y[0] * y[0] + y[1] * y[1] + y[2] * y[2] + y[3] * y[3]; } } }
            if (Hn) {
#pragma unroll
                for (int m = 0; m < 4; ++m) { float t = ss[m]; t += __shfl_xor(t, 16); t += __shfl_xor(t, 32); if (fq == 0) rowss_next[(size_t)(row0 + ai * HALF + m * 16) * 16 + u.pn * 4 + wc] = t; } } }
    }
};

template <class Epi>
__device__ __forceinline__ void gemm_sample(unsigned char* lds, const Gemm g, const Epi& E) {
    const int tid = opaque_tid(), wid = tid >> 6, lane = tid & 63, g4 = lane >> 4, r16 = lane & 15;
    const int K = g.K, CT = g.N >> 8;
    f32x4* red = (f32x4*)lds;
    for (int v = opaque_bid(); v < 256; v += opaque_nwg()) {
        const int row = MP + (v & 15) * 16 + r16, colbase = (v >> 4) * (g.N >> 4);
        const bf16_t* ap = g.A + (size_t)row * g.lda + g4 * 8;
        if (CT == 4) {
            const int ct = wid & 3, kh = wid >> 2, k0 = kh * (K >> 1), k1 = k0 + (K >> 1);
            const bf16_t* bp = g.Bt + (size_t)(colbase + ct * 16 + r16) * K + g4 * 8;
            f32x4 acc = (f32x4){0.f, 0.f, 0.f, 0.f};
#pragma unroll 16
            for (int k = k0; k < k1; k += 32) acc = __builtin_amdgcn_mfma_f32_16x16x32_bf16(*(const bf16x8*)(bp + k), *(const bf16x8*)(ap + k), acc, 0, 0, 0);
            __syncthreads();
            if (kh == 1) red[ct * 64 + lane] = acc;
            __syncthreads();
            if (kh == 0) { acc += red[ct * 64 + lane]; E.tile4(row, colbase + ct * 16 + g4 * 4, acc); }
        } else {
            const int c0 = wid, c1 = wid + 8, c2 = wid + 16;
            const bool h1 = c1 < CT, h2 = c2 < CT;
            if (c0 < CT) {
                const bf16_t* bp0 = g.Bt + (size_t)(colbase + c0 * 16 + r16) * K + g4 * 8;
                const bf16_t* bp1 = g.Bt + (size_t)(colbase + (h1 ? c1 : c0) * 16 + r16) * K + g4 * 8;
                const bf16_t* bp2 = g.Bt + (size_t)(colbase + (h2 ? c2 : c0) * 16 + r16) * K + g4 * 8;
                f32x4 a0 = (f32x4){0.f, 0.f, 0.f, 0.f}, a1 = a0, a2 = a0;
#pragma unroll 8
                for (int k = 0; k < K; k += 32) { const bf16x8 av = *(const bf16x8*)(ap + k);
                    a0 = __builtin_amdgcn_mfma_f32_16x16x32_bf16(*(const bf16x8*)(bp0 + k), av, a0, 0, 0, 0);
                    a1 = __builtin_amdgcn_mfma_f32_16x16x32_bf16(*(const bf16x8*)(bp1 + k), av, a1, 0, 0, 0);
                    a2 = __builtin_amdgcn_mfma_f32_16x16x32_bf16(*(const bf16x8*)(bp2 + k), av, a2, 0, 0, 0); }
                E.tile4(row, colbase + c0 * 16 + g4 * 4, a0);
                if (h1) E.tile4(row, colbase + c1 * 16 + g4 * 4, a1);
                if (h2) E.tile4(row, colbase + c2 * 16 + g4 * 4, a2);
            }
        }
    }
}
}

#define MFMA16(a, b, c) __builtin_amdgcn_mfma_f32_16x16x32_bf16((a), (b), (c), 0, 0, 0)

__device__ __forceinline__ void prep_phase(unsigned char* lds, const Params& p) {
    const int tid = opaque_tid();
    {
        float* sc = (float*)lds;
        float* red = sc + 32 * 512;
        for (int u = opaque_bid(); u < 4 * 48; u += opaque_nwg()) {
            const int l = u / 48, cb = u % 48, col = cb * 128 + (tid & 127), kq = tid >> 7;
            const float* w = p.in[11] + (size_t)l * D * ADA + col;
            float a[32];
#pragma unroll
            for (int s = 0; s < 32; ++s) a[s] = 0.f;
#pragma unroll 1
            for (int half = 0; half < 2; ++half) {
                __syncthreads();
                for (int i = tid; i < 32 * 512; i += NTHREADS) { const int s = i >> 9, k = half * 512 + (i & 511); const float c = s < 16 ? p.in[7][s * D + k] : p.in[8][(s - 16) * D + k]; sc[i] = silu_f(c); }
                __syncthreads();
#pragma unroll 2
                for (int kl = kq * 128; kl < kq * 128 + 128; kl += 4) {
                    const int k = half * 512 + kl;
                    const float w0 = w[(size_t)k * ADA], w1 = w[(size_t)(k + 1) * ADA], w2 = w[(size_t)(k + 2) * ADA], w3 = w[(size_t)(k + 3) * ADA];
#pragma unroll
                    for (int s = 0; s < 32; ++s) { const f32x4 c4 = *(const f32x4*)(sc + s * 512 + kl); a[s] += c4[0] * w0 + c4[1] * w1 + c4[2] * w2 + c4[3] * w3; }
                }
            }
            if (kq > 0) {
#pragma unroll
                for (int s = 0; s < 32; ++s) red[((kq - 1) * 32 + s) * 128 + (tid & 127)] = a[s];
            }
            __syncthreads();
            if (kq == 0) {
                float* mo = (float*)(p.ws + WS_MOD) + (size_t)l * 32 * ADA + col;
                const float bias = p.in[12][(size_t)l * ADA + col];
#pragma unroll
                for (int s = 0; s < 32; ++s) { const int c = tid & 127; mo[(size_t)s * ADA] = a[s] + red[(0 * 32 + s) * 128 + c] + red[(1 * 32 + s) * 128 + c] + red[(2 * 32 + s) * 128 + c] + bias; }
            }
        }
        __syncthreads();
    }
    {
        const int gt = opaque_bid() * NTHREADS + tid, gn = opaque_nwg() * NTHREADS;
        for (int i = gt; i < 2 * 512 * 512; i += gn) {
            const int k2 = (i & 511) * 2, n = (i >> 9) & 511, j = i >> 18;
            const float* w1 = p.in[18] + (size_t)j * D * 16 + (size_t)k2 * 16; const float* w2 = p.in[19] + (size_t)j * 16 * 512 + n;
            float a0 = 0.f, a1 = 0.f;
#pragma unroll
            for (int r = 0; r < 16; ++r) { const float b = w2[r * 512]; a0 += w1[r] * b; a1 += w1[16 + r] * b; }
            bf16_t* dst = (bf16_t*)(p.ws + WS_GIN) + (size_t)j * GLA_N * D + (size_t)(3072 + n) * D + k2;
            *(unsigned*)dst = cvt_pk_bf16(a0, a1);
        }
    }
    {
        float* tl = (float*)lds;
        const int nwgs = opaque_nwg();
        float rv[16];
#define TR_JOB(T, JB, K0, N0) do { int j_ = 0; _Pragma("unroll 1") for (int q = 1; q < NJOBS; ++q) if ((T) >= p.jobs[q].tile0) j_ = q; JB = p.jobs[j_]; \
        const int lt_ = (T) - JB.tile0, ntn_ = JB.N >> 7; K0 = (lt_ / ntn_) << 6; N0 = (lt_ % ntn_) << 7; } while (0)
#define TR_LOAD(JB, K0, N0) do { _Pragma("unroll") for (int i = 0; i < 16; ++i) { const int idx = tid + NTHREADS * i, r = idx >> 7, c = idx & 127; rv[i] = JB.src[(size_t)((K0) + r) * JB.N + (N0) + c]; } } while (0)
        int t = opaque_bid();
        TJob jb; int k0 = 0, n0 = 0;
        if (t < p.ntiles) { TR_JOB(t, jb, k0, n0); TR_LOAD(jb, k0, n0); }
        for (; t < p.ntiles; t += nwgs) {
            __syncthreads();
#pragma unroll
            for (int i = 0; i < 16; ++i) { const int idx = tid + NTHREADS * i, r = idx >> 7, c = idx & 127; tl[c * 65 + r] = rv[i]; }
            __syncthreads();
            const TJob cj = jb; const int ck0 = k0, cn0 = n0;
            if (t + nwgs < p.ntiles) { TR_JOB(t + nwgs, jb, k0, n0); TR_LOAD(jb, k0, n0); }
#pragma unroll
            for (int i = 0; i < 8; ++i) { const int pi = tid + NTHREADS * i, n = pi >> 5, k2 = (pi & 31) * 2;
                *(unsigned*)(cj.dst + (size_t)(cn0 + n) * cj.K + ck0 + k2) = cvt_pk_bf16(tl[n * 65 + k2] * cj.scale, tl[n * 65 + k2 + 1] * cj.scale); }
        }
#undef TR_JOB
#undef TR_LOAD
    }
}

__device__ __forceinline__ int stage_N(int s) { return (s & 1) ? HID : (s == 2) ? RET_N : (s == 4) ? SWA_N : GLA_N; }
__device__ __forceinline__ int stage_cvoff(int s) { return s == 0 ? 0 : s == 1 ? 3584 : s == 2 ? 7680 : s == 3 ? 13824 : s == 4 ? 17920 : s == 5 ? 19456 : s == 6 ? 23552 : 27136; }
__device__ __forceinline__ const bf16_t* stage_W(const unsigned char* ws, int s) {
    const int layer = s >> 1;
    if (s & 1) return (const bf16_t*)(ws + WS_W1T) + (size_t)layer * HID * D;
    return s == 2 ? (const bf16_t*)(ws + WS_RIN) : s == 4 ? (const bf16_t*)(ws + WS_SIN) : (const bf16_t*)(ws + WS_GIN) + (size_t)(layer / 3) * GLA_N * D;
}
__device__ __forceinline__ void prepb_phase(const Params& p) {
    const int tid = opaque_tid(), lane = tid & 63, wid = tid >> 6, g4 = lane >> 4, r16 = lane & 15;
    const float* mod = (const float*)(p.ws + WS_MOD);
    float* av = (float*)(p.ws + WS_AVEC);
    for (int i = opaque_bid() * NTHREADS + tid; i < 8 * 32 * D; i += opaque_nwg() * NTHREADS) { const int st = i >> 15, sq = (i >> 10) & 31, c = i & 1023, layer = st >> 1;
        const float g = ((st & 1) ? p.in[10] : p.in[9])[layer * D + c];
        av[i] = g * (1.0f + mod[((size_t)layer * 32 + sq) * ADA + ((st & 1) ? 4 : 1) * D + c]); }
    float* cvec = (float*)(p.ws + WS_CVEC);
    for (int it = opaque_bid() * 8 + wid; it < CVEC_TOTAL_N / 16; it += opaque_nwg() * 8) {
        const int ng = it * 16; int st = 0;
#pragma unroll
        for (int q = 1; q < 8; ++q) if (ng >= stage_cvoff(q)) st = q;
        const int n0 = ng - stage_cvoff(st), N = stage_N(st), layer = st >> 1;
        const bf16_t* wp = stage_W(p.ws, st) + (size_t)(n0 + r16) * D + g4 * 8;
        const float* sh0 = mod + ((size_t)layer * 32 + r16) * ADA + ((st & 1) ? 3 : 0) * D + g4 * 8; const float* sh1 = sh0 + (size_t)16 * ADA;
        f32x4 acc0 = (f32x4){0.f, 0.f, 0.f, 0.f}, acc1 = acc0;
#pragma unroll 4
        for (int k = 0; k < D; k += 32) {
            const bf16x8 bw = *(const bf16x8*)(wp + k);
            const f32x4 x0 = *(const f32x4*)(sh0 + k), x1 = *(const f32x4*)(sh0 + k + 4), y0 = *(const f32x4*)(sh1 + k), y1 = *(const f32x4*)(sh1 + k + 4);
            u32x4 a0, a1; a0.x = cvt_pk_bf16(x0[0], x0[1]); a0.y = cvt_pk_bf16(x0[2], x0[3]); a0.z = cvt_pk_bf16(x1[0], x1[1]); a0.w = cvt_pk_bf16(x1[2], x1[3]);
            a1.x = cvt_pk_bf16(y0[0], y0[1]); a1.y = cvt_pk_bf16(y0[2], y0[3]); a1.z = cvt_pk_bf16(y1[0], y1[1]); a1.w = cvt_pk_bf16(y1[2], y1[3]);
            acc0 = MFMA16(bw, __builtin_bit_cast(bf16x8, a0), acc0); acc1 = MFMA16(bw, __builtin_bit_cast(bf16x8, a1), acc1);
        }
        float* cp = cvec + (size_t)32 * stage_cvoff(st) + (size_t)r16 * N + n0 + g4 * 4;
        *(f32x4*)cp = acc0; *(f32x4*)(cp + (size_t)16 * N) = acc1;
    }
    bf16_t* H = (bf16_t*)(p.ws + WS_H); float* rss = (float*)(p.ws + WS_RSS);
    for (int r = opaque_bid() * 8 + wid; r < MT; r += opaque_nwg() * 8) {
        const float* src = r < MP ? p.in[0] + (size_t)r * D : p.in[1] + (size_t)(r - MP) * D;
        const float* mrow = mod + (size_t)seq_of_row(r) * ADA + D;
        float ss = 0.f;
#pragma unroll
        for (int i = 0; i < 4; ++i) { const int c = i * 256 + lane * 4;
            const f32x4 v = *(const f32x4*)(src + c), gv = *(const f32x4*)(p.in[9] + c), sc = *(const f32x4*)(mrow + c);
            ss += v[0] * v[0] + v[1] * v[1] + v[2] * v[2] + v[3] * v[3];
            u32x2 w; w.x = cvt_pk_bf16(v[0] * gv[0] * (1.0f + sc[0]), v[1] * gv[1] * (1.0f + sc[1])); w.y = cvt_pk_bf16(v[2] * gv[2] * (1.0f + sc[2]), v[3] * gv[3] * (1.0f + sc[3]));
            *(u32x2*)(H + (size_t)r * D + c) = w; }
        ss = wave_sum(ss);
        if (r < MP) { if (lane < 16) rss[(size_t)r * 16 + lane] = lane == 0 ? ss : 0.f; } else rss[(size_t)MP * 16 + (size_t)(r - MP) * 64 + lane] = lane == 0 ? ss : 0.f;
    }
}

template <int DK, int DV, bool GLA>
__device__ __forceinline__ void recur_phase(unsigned char* lds, bf16_t* P, int ldp, int qoff, int koff, int voff, int goff, const float* S0s, float* outSp, float* outSs, bool live = true, bf16_t* PO = nullptr, int ldo = 0) {
    constexpr int VS = 64, NVS = DV / VS, NH = 4;
    constexpr int QS = DK + 8, TS = 64 + 8;
    constexpr int CP = DK / 2, NSEG = NTHREADS / CP, RPS = 64 / NSEG, NDT = DK / 128, NKK = DK / 32;
    bf16_t* QD = (bf16_t*)lds;
    bf16_t* KD = QD + 64 * QS;
    bf16_t* KDT = KD + 64 * QS;
    bf16_t* VT = KDT + DK * TS;
    bf16_t* ATT = VT + VS * TS;
    bf16_t* ST = ATT + 64 * TS;
    float* SEG = (float*)(ST + VS * QS);
    float* EBL = SEG + (GLA ? NSEG * DK : 0);
    static_assert((size_t)(64 * QS * 2 + DK * TS + VS * TS + 64 * TS + VS * QS) * 2 + (GLA ? (NSEG + 1) * DK * 4 : 0) <= LDS_BYTES, "recurrence LDS");
    const int tid = opaque_tid(), lane = tid & 63, wid = tid >> 6, g4 = lane >> 4, r16 = lane & 15;
    const int cp = tid % CP, sgm = tid / CP, vcp = tid & 31, vsg = tid >> 5;
    constexpr int NIP = NB * NH * NVS;
    for (int item = opaque_bid(); item < 2 * NIP; item += opaque_nwg()) {
        const bool smp = item >= NIP; const int it = smp ? item - NIP : item;
        const int vs = it % NVS, h = (it / NVS) % NH, b = it / (NVS * NH);
        const int row0 = smp ? MP + b * DSEQ : b * SEQ, nch = smp ? 1 : SEQ / 64, Lc = smp ? DSEQ : 64;
        const float lgam = GLA ? 0.f : __logf(1.0f - exp2f(-5.0f - (float)h));
        f32x4 sacc[NDT][4];
        __syncthreads();
#pragma unroll
        for (int dl = 0; dl < NDT; ++dl)
#pragma unroll
            for (int vt = 0; vt < 4; ++vt) {
                f32x4 s = (f32x4){0.f, 0.f, 0.f, 0.f};
                const int d0 = (wid * NDT + dl) * 16 + g4 * 4, v = vt * 16 + r16;
                if (smp) {
#pragma unroll
                    for (int j = 0; j < 4; ++j) s[j] = S0s[(((size_t)b * NH + h) * DK + d0 + j) * DV + vs * VS + v];
                }
                sacc[dl][vt] = s;
                u32x2 w; w.x = cvt_pk_bf16(s[0], s[1]); w.y = cvt_pk_bf16(s[2], s[3]);
                *(u32x2*)(ST + v * QS + d0) = w;
            }
        unsigned rq[RPS], rk[RPS], rg[RPS], rv[4];
        const bf16_t* Pq = P + qoff + h * DK + 2 * cp; const bf16_t* Pk = P + koff + h * DK + 2 * cp; const bf16_t* Pg = P + goff + h * DK + 2 * cp;
        bf16_t* Pv = P + voff + h * DV + vs * VS;
#define RC_LOAD(c) do { \
        _Pragma("unroll") for (int i = 0; i < RPS; ++i) { const int row = sgm * RPS + i; const size_t go = (size_t)(row0 + (c) * 64 + row) * ldp; const bool ok = row < Lc; \
            rq[i] = ok ? *(const unsigned*)(Pq + go) : 0u; rk[i] = ok ? *(const unsigned*)(Pk + go) : 0u; if (GLA) rg[i] = ok ? *(const unsigned*)(Pg + go) : 0u; } \
        _Pragma("unroll") for (int i = 0; i < 4; ++i) { const int row = vsg * 4 + i; rv[i] = row < Lc ? *(const unsigned*)(Pv + (size_t)(row0 + (c) * 64 + row) * ldp + 2 * vcp) : 0u; } } while (0)
        RC_LOAD(0);
        for (int c = 0; c < nch; ++c) {
            float off0 = 0.f, off1 = 0.f, tot0 = 0.f, tot1 = 0.f;
            float pre0[RPS], pre1[RPS];
            if (GLA) {
                float a0 = 0.f, a1 = 0.f;
#pragma unroll
                for (int i = 0; i < RPS; ++i) { a0 += bf_lo(rg[i]); a1 += bf_hi(rg[i]); pre0[i] = a0; pre1[i] = a1; }
                SEG[sgm * DK + 2 * cp] = a0; SEG[sgm * DK + 2 * cp + 1] = a1;
                __syncthreads();
#pragma unroll
                for (int s = 0; s < NSEG; ++s) { const float t0 = SEG[s * DK + 2 * cp], t1 = SEG[s * DK + 2 * cp + 1]; if (s < sgm) { off0 += t0; off1 += t1; } tot0 += t0; tot1 += t1; }
                if (sgm == 0) { EBL[2 * cp] = __expf(tot0); EBL[2 * cp + 1] = __expf(tot1); }
            }
            {
                float kt0[RPS], kt1[RPS];
#pragma unroll
                for (int i = 0; i < RPS; ++i) { const int row = sgm * RPS + i;
                    const float q0 = bf_lo(rq[i]), q1 = bf_hi(rq[i]), k0 = bf_lo(rk[i]), k1 = bf_hi(rk[i]);
                    if (GLA) {
                        const float b0 = off0 + pre0[i], b1 = off1 + pre1[i];
                        const float e0 = __expf(b0), e1 = __expf(b1);
                        *(unsigned*)(QD + row * QS + 2 * cp) = cvt_pk_bf16(q0 * e0, q1 * e1);
                        *(unsigned*)(KD + row * QS + 2 * cp) = cvt_pk_bf16(k0 * __expf(-b0), k1 * __expf(-b1));
                        kt0[i] = k0 * __expf(tot0 - b0); kt1[i] = k1 * __expf(tot1 - b1);
                    } else {
                        *(unsigned*)(QD + row * QS + 2 * cp) = rq[i];
                        *(unsigned*)(KD + row * QS + 2 * cp) = rk[i];
                        const float dk = __expf(lgam * (float)(Lc - 1 - row));
                        kt0[i] = k0 * dk; kt1[i] = k1 * dk;
                    } }
#pragma unroll
                for (int i = 0; i < RPS; i += 8) {
                    u32x4 w0, w1;
                    w0.x = cvt_pk_bf16(kt0[i], kt0[i + 1]); w0.y = cvt_pk_bf16(kt0[i + 2], kt0[i + 3]); w0.z = cvt_pk_bf16(kt0[i + 4], kt0[i + 5]); w0.w = cvt_pk_bf16(kt0[i + 6], kt0[i + 7]);
                    w1.x = cvt_pk_bf16(kt1[i], kt1[i + 1]); w1.y = cvt_pk_bf16(kt1[i + 2], kt1[i + 3]); w1.z = cvt_pk_bf16(kt1[i + 4], kt1[i + 5]); w1.w = cvt_pk_bf16(kt1[i + 6], kt1[i + 7]);
                    *(u32x4*)(KDT + (2 * cp) * TS + sgm * RPS + i) = w0; *(u32x4*)(KDT + (2 * cp + 1) * TS + sgm * RPS + i) = w1;
                }
                u32x2 v0, v1;
                v0.x = (rv[0] & 0xffffu) | (rv[1] << 16); v0.y = (rv[2] & 0xffffu) | (rv[3] << 16);
                v1.x = (rv[0] >> 16) | (rv[1] & 0xffff0000u); v1.y = (rv[2] >> 16) | (rv[3] & 0xffff0000u);
                *(u32x2*)(VT + (2 * vcp) * TS + vsg * 4) = v0; *(u32x2*)(VT + (2 * vcp + 1) * TS + vsg * 4) = v1;
            }
            __syncthreads();
            if (c + 1 < nch) RC_LOAD(c + 1);
#pragma unroll
            for (int tt = 0; tt < 2; ++tt) { const int t = wid * 2 + tt, lt = t >> 2, st = t & 3;
                f32x4 acc = (f32x4){0.f, 0.f, 0.f, 0.f};
                if (st <= lt) {
#pragma unroll
                    for (int kk = 0; kk < NKK; ++kk) { const bf16x8 a = *(const bf16x8*)(QD + (lt * 16 + r16) * QS + kk * 32 + g4 * 8), bb = *(const bf16x8*)(KD + (st * 16 + r16) * QS + kk * 32 + g4 * 8);
                        acc = MFMA16(bb, a, acc); }
                }
                const int l = lt * 16 + r16, s0 = st * 16 + g4 * 4;
#pragma unroll
                for (int j = 0; j < 4; ++j) { const int s = s0 + j; float v = acc[j]; if (!GLA) v *= __expf(lgam * (float)(l - s)); acc[j] = (s <= l) ? v : 0.f; }
                u32x2 w; w.x = cvt_pk_bf16(acc[0], acc[1]); w.y = cvt_pk_bf16(acc[2], acc[3]);
                *(u32x2*)(ATT + l * TS + s0) = w; }
            __syncthreads();
#pragma unroll
            for (int tt = 0; tt < 2; ++tt) { const int t = wid * 2 + tt, lt = t >> 2, vt = t & 3;
                f32x4 a1 = (f32x4){0.f, 0.f, 0.f, 0.f}, a2 = (f32x4){0.f, 0.f, 0.f, 0.f};
#pragma unroll
                for (int kk = 0; kk < 2; ++kk) { if (kk * 32 <= lt * 16 + 15) { const bf16x8 a = *(const bf16x8*)(ATT + (lt * 16 + r16) * TS + kk * 32 + g4 * 8), bb = *(const bf16x8*)(VT + (vt * 16 + r16) * TS + kk * 32 + g4 * 8);
                        a1 = MFMA16(bb, a, a1); } }
#pragma unroll
                for (int kk = 0; kk < NKK; ++kk) { const bf16x8 a = *(const bf16x8*)(QD + (lt * 16 + r16) * QS + kk * 32 + g4 * 8), bb = *(const bf16x8*)(ST + (vt * 16 + r16) * QS + kk * 32 + g4 * 8);
                    a2 = MFMA16(bb, a, a2); }
                const int l = lt * 16 + r16;
                const float dq = GLA ? 1.0f : __expf(lgam * (float)(l + 1));
                if (l < Lc && live) { u32x2 w; w.x = cvt_pk_bf16(a1[0] + a2[0] * dq, a1[1] + a2[1] * dq); w.y = cvt_pk_bf16(a1[2] + a2[2] * dq, a1[3] + a2[3] * dq);
                    if (PO) *(u32x2*)(PO + (size_t)(row0 + c * 64 + l) * ldo + h * DV + vs * VS + vt * 16 + g4 * 4) = w;
                    else *(u32x2*)(Pv + (size_t)(row0 + c * 64 + l) * ldp + vt * 16 + g4 * 4) = w; } }
            __syncthreads();
#pragma unroll
            for (int dl = 0; dl < NDT; ++dl) { const int dt = wid * NDT + dl;
                f32x4 dec;
                if (GLA) dec = *(const f32x4*)(EBL + dt * 16 + g4 * 4); else { const float dc = __expf(lgam * (float)Lc); dec = (f32x4){dc, dc, dc, dc}; }
                const bf16x8 ka0 = *(const bf16x8*)(KDT + (dt * 16 + r16) * TS + g4 * 8), ka1 = *(const bf16x8*)(KDT + (dt * 16 + r16) * TS + 32 + g4 * 8);
#pragma unroll
                for (int vt = 0; vt < 4; ++vt) {
                    f32x4 acc = sacc[dl][vt] * dec;
                    acc = MFMA16(ka0, *(const bf16x8*)(VT + (vt * 16 + r16) * TS + g4 * 8), acc);
                    acc = MFMA16(ka1, *(const bf16x8*)(VT + (vt * 16 + r16) * TS + 32 + g4 * 8), acc);
                    sacc[dl][vt] = acc;
                    u32x2 w; w.x = cvt_pk_bf16(acc[0], acc[1]); w.y = cvt_pk_bf16(acc[2], acc[3]);
                    *(u32x2*)(ST + (vt * 16 + r16) * QS + dt * 16 + g4 * 4) = w;
                } }
            __syncthreads();
        }
#undef RC_LOAD
        float* So = smp ? outSs : outSp;
#pragma unroll
        for (int dl = 0; dl < NDT; ++dl)
#pragma unroll
            for (int vt = 0; vt < 4; ++vt) { const int d0 = (wid * NDT + dl) * 16 + g4 * 4, v = vt * 16 + r16;
#pragma unroll
                for (int j = 0; j < 4; ++j) if (live) So[(((size_t)b * NH + h) * DK + d0 + j) * DV + vs * VS + v] = sacc[dl][vt][j]; }
    }
}

template <int DV, bool GLA>
__device__ __forceinline__ void post_phase(bf16_t* P, int ldp, int ooff, int goff, const float* normg) {
    constexpr int EPL = DV / 16;
    const int tid = opaque_tid(), lane = tid & 63, wid = tid >> 6;
    float ng[EPL];
#pragma unroll
    for (int i = 0; i < EPL; ++i) ng[i] = GLA ? normg[(lane & 15) * EPL + i] : 1.0f;
    for (int r0 = (opaque_bid() * 8 + wid) * 2; r0 < MT; r0 += opaque_nwg() * 16) {
        float o[2][EPL]; u32x4 gw[2][EPL / 8];
#pragma unroll
        for (int rr = 0; rr < 2; ++rr) { const bf16_t* po = P + (size_t)(r0 + rr) * ldp + ooff + lane * EPL; const bf16_t* pg = P + (size_t)(r0 + rr) * ldp + goff + lane * EPL;
#pragma unroll
            for (int i = 0; i < EPL; i += 8) { const u32x4 w = *(const u32x4*)(po + i); gw[rr][i / 8] = *(const u32x4*)(pg + i);
#pragma unroll
                for (int j = 0; j < 4; ++j) { o[rr][i + 2 * j] = bf_lo(w[j]); o[rr][i + 2 * j + 1] = bf_hi(w[j]); } } }
#pragma unroll
        for (int rr = 0; rr < 2; ++rr) {
            float s1 = 0.f, s2 = 0.f;
#pragma unroll
            for (int i = 0; i < EPL; ++i) { s1 += o[rr][i]; s2 += o[rr][i] * o[rr][i]; }
#pragma unroll
            for (int m = 1; m < 16; m <<= 1) { s1 += __shfl_xor(s1, m); s2 += __shfl_xor(s2, m); }
            float mu = 0.f, rs;
            if (GLA) rs = rsqrtf(s2 * (1.0f / DV) + 1e-6f);
            else { mu = s1 * (1.0f / DV); rs = rsqrtf(fmaxf(s2 * (1.0f / DV) - mu * mu, 0.f) + 1e-5f); }
            bf16_t* pg = P + (size_t)(r0 + rr) * ldp + goff + lane * EPL;
#pragma unroll
            for (int i = 0; i < EPL; i += 8) { const u32x4 g = gw[rr][i / 8]; u32x4 w;
#pragma unroll
                for (int j = 0; j < 4; ++j) { float x0 = (o[rr][i + 2 * j] - mu) * rs, x1 = (o[rr][i + 2 * j + 1] - mu) * rs;
                    if (GLA) { x0 *= ng[i + 2 * j]; x1 *= ng[i + 2 * j + 1]; }
                    w[j] = cvt_pk_bf16(x0 * silu_f(bf_lo(g[j])), x1 * silu_f(bf_hi(g[j]))); }
                *(u32x4*)(pg + i) = w; }
        }
    }
}

__device__ __forceinline__ void swa_phase(unsigned char* lds, const Params& p, bf16_t* P, int z) {
    const bool live = true;
    constexpr int KS_S = 72, VT_S = 200, PW_S = 200;
    bf16_t* KS = (bf16_t*)lds;
    bf16_t* VT = KS + 192 * KS_S;
    bf16_t* PW = VT + 64 * VT_S;
    const int tid = opaque_tid(), lane = tid & 63, wid = tid >> 6, g4 = lane >> 4, r16 = lane & 15;
    const float* qn = p.in[30 + z]; const float* kn = p.in[31 + z]; const float* sinks = p.in[32 + z];
    const float* cache_k = p.in[4 + z]; const float* cache_v = p.in[5 + z];
    float* out = p.out + z;
    constexpr int NPI = NB * 64 * 4, NSI = NB * 4;
    for (int item = opaque_bid(); item < NPI + NSI; item += opaque_nwg()) {
        const bool smp = item >= NPI; const int it = smp ? item - NPI : item;
        const int kv = it & 3, c = smp ? 0 : (it >> 2) & 63, b = smp ? it >> 2 : it >> 8;
        const int Lq = smp ? DSEQ : 64;
        __syncthreads();
        const int d0 = (tid & 7) * 8;
        f32x4 kn0 = *(const f32x4*)(kn + d0), kn1 = *(const f32x4*)(kn + d0 + 4);
#pragma unroll
        for (int i = 0; i < 3; ++i) { const int s = (tid >> 3) + 64 * i;
            float kf[8], vf[8]; bool valid, donorm = true; long prow = 0;
            if (!smp) { const int tok = (c - 2) * 64 + s; valid = tok >= 0; prow = (long)b * SEQ + tok; }
            else { valid = s < 128 + DSEQ; donorm = s >= 128; prow = (long)MP + b * DSEQ + (s - 128); }
            if (valid && (!smp || s >= 128)) {
                const u32x4 kw = *(const u32x4*)(P + (size_t)prow * SWA_N + 1024 + kv * 64 + d0), vw = *(const u32x4*)(P + (size_t)prow * SWA_N + 1280 + kv * 64 + d0);
#pragma unroll
                for (int j = 0; j < 4; ++j) { kf[2 * j] = bf_lo(kw[j]); kf[2 * j + 1] = bf_hi(kw[j]); vf[2 * j] = bf_lo(vw[j]); vf[2 * j + 1] = bf_hi(vw[j]); }
            } else if (valid) {
                const float* ck = cache_k + (((size_t)b * 128 + s) * 4 + kv) * 64 + d0; const float* cv = cache_v + (((size_t)b * 128 + s) * 4 + kv) * 64 + d0;
                const f32x4 a0 = *(const f32x4*)ck, a1 = *(const f32x4*)(ck + 4), c0 = *(const f32x4*)cv, c1 = *(const f32x4*)(cv + 4);
#pragma unroll
                for (int j = 0; j < 4; ++j) { kf[j] = a0[j]; kf[4 + j] = a1[j]; vf[j] = c0[j]; vf[4 + j] = c1[j]; }
            } else {
#pragma unroll
                for (int j = 0; j < 8; ++j) { kf[j] = 0.f; vf[j] = 0.f; }
            }
            float ss = 0.f;
#pragma unroll
            for (int j = 0; j < 8; ++j) ss += kf[j] * kf[j];
            ss += __shfl_xor(ss, 1); ss += __shfl_xor(ss, 2); ss += __shfl_xor(ss, 4);
            if (donorm) { const float rs = rsqrtf(ss * (1.0f / 64) + 1e-6f);
#pragma unroll
                for (int j = 0; j < 4; ++j) { kf[j] *= rs * kn0[j]; kf[4 + j] *= rs * kn1[j]; } }
            u32x4 w; w.x = cvt_pk_bf16(kf[0], kf[1]); w.y = cvt_pk_bf16(kf[2], kf[3]); w.z = cvt_pk_bf16(kf[4], kf[5]); w.w = cvt_pk_bf16(kf[6], kf[7]);
            *(u32x4*)(KS + s * KS_S + d0) = w;
#pragma unroll
            for (int j = 0; j < 8; ++j) VT[(d0 + j) * VT_S + s] = (bf16_t)(cvt_pk_bf16(vf[j], 0.f) & 0xffffu);
            float* ko = nullptr; float* vo = nullptr;
            if (!smp && c >= 62 && s >= 128) { const int w_ = (c - 62) * 64 + (s - 128); ko = out + O_KP + (((size_t)b * 128 + w_) * 4 + kv) * 64 + d0; vo = out + O_VP + (((size_t)b * 128 + w_) * 4 + kv) * 64 + d0; }
            if (smp && s >= 128 && s < 128 + DSEQ) { ko = out + O_KS + (((size_t)b * DSEQ + (s - 128)) * 4 + kv) * 64 + d0; vo = out + O_VS + (((size_t)b * DSEQ + (s - 128)) * 4 + kv) * 64 + d0; }
            if (ko && live) { *(f32x4*)ko = (f32x4){kf[0], kf[1], kf[2], kf[3]}; *(f32x4*)(ko + 4) = (f32x4){kf[4], kf[5], kf[6], kf[7]};
                      *(f32x4*)vo = (f32x4){vf[0], vf[1], vf[2], vf[3]}; *(f32x4*)(vo + 4) = (f32x4){vf[4], vf[5], vf[6], vf[7]}; }
        }
        __syncthreads();
        const int gq = wid >> 1, hh = kv * 4 + gq;
        const float slope = exp2f(-0.5f * (float)(hh + 1)), sink = sinks[hh];
        bf16_t* pw = PW + wid * 16 * PW_S;
        for (int rt = 0; rt < 2; ++rt) {
            const int l = (wid & 1) * 32 + rt * 16 + r16;
            if ((wid & 1) * 32 + rt * 16 >= Lq) break;
            const bool lvalid = l < Lq;
            const size_t prow = smp ? (size_t)MP + b * DSEQ + (lvalid ? l : 0) : (size_t)b * SEQ + c * 64 + l;
            bf16_t* qp = P + prow * SWA_N + kv * 256 + gq * 64;
            bf16x8 qa[2];
            {
                float qf[2][8]; float ss = 0.f;
#pragma unroll
                for (int kk = 0; kk < 2; ++kk) { const u32x4 w = *(const u32x4*)(qp + kk * 32 + g4 * 8);
#pragma unroll
                    for (int j = 0; j < 4; ++j) { qf[kk][2 * j] = bf_lo(w[j]); qf[kk][2 * j + 1] = bf_hi(w[j]); } }
#pragma unroll
                for (int kk = 0; kk < 2; ++kk)
#pragma unroll
                    for (int j = 0; j < 8; ++j) ss += qf[kk][j] * qf[kk][j];
                ss += __shfl_xor(ss, 16); ss += __shfl_xor(ss, 32);
                const float rs = rsqrtf(ss * (1.0f / 64) + 1e-6f) * 0.125f;
#pragma unroll
                for (int kk = 0; kk < 2; ++kk) { u32x4 w;
#pragma unroll
                    for (int j = 0; j < 4; ++j) { const int d = kk * 32 + g4 * 8 + 2 * j; w[j] = cvt_pk_bf16(qf[kk][2 * j] * rs * qn[d], qf[kk][2 * j + 1] * rs * qn[d + 1]); }
                    qa[kk] = __builtin_bit_cast(bf16x8, w); }
            }
            f32x4 sc[12]; float mx = sink;
#pragma unroll
            for (int st = 0; st < 12; ++st) { f32x4 acc = (f32x4){0.f, 0.f, 0.f, 0.f};
#pragma unroll
                for (int kk = 0; kk < 2; ++kk) acc = MFMA16(*(const bf16x8*)(KS + (st * 16 + r16) * KS_S + kk * 32 + g4 * 8), qa[kk], acc);
#pragma unroll
                for (int j = 0; j < 4; ++j) { const int s = st * 16 + g4 * 4 + j; const bool kvalid = smp ? (s < 128 + DSEQ) : ((c - 2) * 64 + s >= 0);
                    const float v = kvalid ? acc[j] - slope * fabsf((float)(128 + l - s)) : -1e30f; acc[j] = v; mx = fmaxf(mx, v); }
                sc[st] = acc; }
            mx = fmaxf(mx, __shfl_xor(mx, 16)); mx = fmaxf(mx, __shfl_xor(mx, 32));
            float sum = 0.f;
#pragma unroll
            for (int st = 0; st < 12; ++st)
#pragma unroll
                for (int j = 0; j < 4; ++j) { const float e = __expf(sc[st][j] - mx); sc[st][j] = e; sum += e; }
            sum += __shfl_xor(sum, 16); sum += __shfl_xor(sum, 32);
            const float inv = 1.0f / (sum + __expf(sink - mx));
#pragma unroll
            for (int st = 0; st < 12; ++st) { u32x2 w; w.x = cvt_pk_bf16(sc[st][0] * inv, sc[st][1] * inv); w.y = cvt_pk_bf16(sc[st][2] * inv, sc[st][3] * inv);
                *(u32x2*)(pw + r16 * PW_S + st * 16 + g4 * 4) = w; }
            __builtin_amdgcn_fence(__ATOMIC_RELEASE, "wavefront"); __builtin_amdgcn_wave_barrier(); __builtin_amdgcn_fence(__ATOMIC_ACQUIRE, "wavefront");
#pragma unroll
            for (int dt = 0; dt < 4; ++dt) { f32x4 acc = (f32x4){0.f, 0.f, 0.f, 0.f};
#pragma unroll
                for (int kk = 0; kk < 6; ++kk) acc = MFMA16(*(const bf16x8*)(VT + (dt * 16 + r16) * VT_S + kk * 32 + g4 * 8), *(const bf16x8*)(pw + r16 * PW_S + kk * 32 + g4 * 8), acc);
                if (lvalid && live) { u32x2 w; w.x = cvt_pk_bf16(acc[0], acc[1]); w.y = cvt_pk_bf16(acc[2], acc[3]); *(u32x2*)(qp + dt * 16 + g4 * 4) = w; } }
            __builtin_amdgcn_fence(__ATOMIC_RELEASE, "wavefront"); __builtin_amdgcn_wave_barrier(); __builtin_amdgcn_fence(__ATOMIC_ACQUIRE, "wavefront");
        }
    }
}

#define XB_TMO      128
#define XB_XCNT(j)  (256  + 64 * (j))
#define XB_XSUB(j)  (1280 + 64 * (j))
#define XB_XGEN(j)  (2304 + 64 * (j))
#define XB_TOP      3328
#define XB_TOPGEN   3392
#define XCD_BAR_WORDS 3456
#define XB_SPIN_CAP (1u << 22)
static_assert(XCD_BAR_WORDS * 4 <= WS_BAR_BYTES, "barrier words");
__device__ __forceinline__ unsigned xb_ld(unsigned* p)              { return __hip_atomic_load(p, __ATOMIC_RELAXED, __HIP_MEMORY_SCOPE_AGENT); }
__device__ __forceinline__ unsigned xb_add(unsigned* p, unsigned v) { return __hip_atomic_fetch_add(p, v, __ATOMIC_RELAXED, __HIP_MEMORY_SCOPE_AGENT); }
__device__ __forceinline__ unsigned xb_xcc_id() { return (unsigned)__builtin_amdgcn_s_getreg((3 << 11) | 20) & 0xFu; }
#define XB_SPIN(cond, bar) do { unsigned _sp = 0; while (cond) { __builtin_amdgcn_s_sleep(1); \
    if ((++_sp & 255u) == 0u) { if (xb_ld(&(bar)[XB_TMO])) break; if (_sp > XB_SPIN_CAP) { atomicAdd(&(bar)[XB_TMO], 1u); break; } } } } while (0)
struct XcdBarrier { unsigned* bar; unsigned x; volatile LAS unsigned* st; };
__device__ __forceinline__ XcdBarrier xcd_barrier_post(unsigned* bar, volatile LAS unsigned* st) {
    XcdBarrier b; b.bar = bar; b.x = xb_xcc_id(); b.st = st;
    if (threadIdx.x == 0) (void)xb_add(&bar[XB_XCNT(b.x)], 1u);
    return b;
}
__device__ __forceinline__ void xcd_barrier_complete(unsigned* bar, unsigned x, unsigned& nloc, unsigned& nx) {
    const unsigned G = gridDim.x * gridDim.y * gridDim.z;
    unsigned sum, cnt, mine, sp = 0u;
    for (;;) {
        sum = 0u; cnt = 0u; mine = 0u;
#pragma unroll
        for (unsigned j = 0; j < 16; ++j) { const unsigned c = xb_ld(&bar[XB_XCNT(j)]); sum += c; cnt += (c > 0u) ? 1u : 0u; mine = (j == x) ? c : mine; }
        if (sum == G) break;
        __builtin_amdgcn_s_sleep(1);
        if ((++sp & 255u) == 0u) { if (xb_ld(&bar[XB_TMO])) break; if (sp > XB_SPIN_CAP) { atomicAdd(&bar[XB_TMO], 1u); break; } }
    }
    nloc = mine > 0u ? mine : 1u; nx = cnt > 0u ? cnt : 1u;
}
__device__ __forceinline__ void xcd_barrier(const XcdBarrier& b) {
    asm volatile("s_waitcnt vmcnt(0)" ::: "memory");
    __syncthreads();
    if (opaque_tid() == 0) {
        unsigned* bar = b.bar; asm volatile("" : "+s"(bar));
        __builtin_amdgcn_s_waitcnt(0);
        const unsigned bx = xb_xcc_id();
        unsigned nloc = b.st[0], nx = b.st[1];
        if (nloc == 0u) { xcd_barrier_complete(bar, bx, nloc, nx); b.st[0] = nloc; b.st[1] = nx; }
        const unsigned old = xb_add(&bar[XB_XSUB(bx)], 1u);
        const unsigned gen = old / nloc;
        if (old + 1u == (gen + 1u) * nloc) {
            __builtin_amdgcn_fence(__ATOMIC_RELEASE, "agent");
            asm volatile("s_waitcnt vmcnt(0)" ::: "memory");
            const unsigned og = xb_add(&bar[XB_TOP], 1u);
            const unsigned tg = og / nx;
            if (og + 1u == (tg + 1u) * nx) xb_add(&bar[XB_TOPGEN], 1u);
            else XB_SPIN(xb_ld(&bar[XB_TOPGEN]) == tg, bar);
            __builtin_amdgcn_fence(__ATOMIC_ACQUIRE, "agent");
            xb_add(&bar[XB_XGEN(bx)], 1u);
            asm volatile("s_waitcnt vmcnt(0)" ::: "memory");
        } else {
            XB_SPIN(xb_ld(&bar[XB_XGEN(bx)]) == gen, bar);
            __builtin_amdgcn_fence(__ATOMIC_ACQUIRE, "agent");
            asm volatile("s_waitcnt vmcnt(0)" ::: "memory");
        }
    }
    __syncthreads();
}
__device__ __forceinline__ void gsync_cg(cg::grid_group& g) {
    __builtin_amdgcn_fence(__ATOMIC_RELEASE, "agent");
    asm volatile("s_waitcnt vmcnt(0) lgkmcnt(0)" ::: "memory");
    g.sync();
    __builtin_amdgcn_fence(__ATOMIC_ACQUIRE, "agent");
    asm volatile("s_waitcnt vmcnt(0)" ::: "memory");
}
#define gsync(g) xcd_barrier(xbar)
__global__ void __launch_bounds__(NTHREADS, 2) fwd_megakernel(Params p) {
    extern __shared__ __attribute__((aligned(16))) unsigned char shm[];
    cg::grid_group grid = cg::this_grid();
    LAS unsigned char* shl = (LAS unsigned char*)shm;
    pg8::StaticOrder S;
    volatile LAS unsigned* xst = (volatile LAS unsigned*)(shl + LDS_BYTES - 16);
    if (threadIdx.x == 0) { xst[0] = 0u; xst[1] = 0u; }
    __syncthreads();
    const XcdBarrier xbar = xcd_barrier_post((unsigned*)(p.ws + WS_BAR), xst);

    grid.sync();
    prep_phase(shm, p);
    gsync(grid);
    prepb_phase(p);
    gsync(grid);
#pragma unroll 1
    for (int layer = 0; layer < 4; ++layer) {
        int z = 0; asm volatile("" : "+s"(z));
        unsigned char* ws = p.ws + z; float* yo = p.out + z;
        bf16_t* H = (bf16_t*)(ws + WS_H); bf16_t* P = (bf16_t*)(ws + WS_P);
        const float* mod = (const float*)(ws + WS_MOD);
        float* RS = (float*)(ws + WS_RSS);
        LAS float* RSL = (LAS float*)(shl + 128 * 1024);
        const float* avec = (const float*)(ws + WS_AVEC); const float* cvec = (const float*)(ws + WS_CVEC);
        const int kind = layer % 3, j = layer / 3;
        const float* mod_l = mod + (size_t)layer * 32 * ADA;
        const float* yin_p = layer == 0 ? p.in[0 + z] : yo; const float* yin_s = layer == 0 ? p.in[1 + z] : yo + O_YS;
        const float* cv_mix = cvec + (size_t)32 * stage_cvoff(2 * layer); const float* cv_mlp = cvec + (size_t)32 * stage_cvoff(2 * layer + 1);
        const bf16_t* WoT; int Ko, lda_o; const bf16_t* Ao;
        if (kind == 0) {
            { pg8::Gemm g{H, (const bf16_t*)(ws + WS_GIN) + (size_t)j * GLA_N * D, MP, GLA_N, D, D}; S.init(MP, GLA_N, opaque_nwg(), opaque_bid());
              pg8::EpiBf16 E{P, GLA_N, 0, 3072, p.in[20 + z] + j * 512, RS, cv_mix, RSL}; pg8::rs_stage(S, RS, 0, RSL); pg8::gemm_phase(shl, g, S, E); pg8::gemm_sample(shm, g, E); }
            gsync(grid);
            recur_phase<GLA_DK, GLA_DV, true>(shm, P, GLA_N, 0, 512, 1024, 3072, layer == 0 ? p.in[2 + z] : p.in[6 + z], yo + (layer == 0 ? O_G0P : O_G3P), yo + (layer == 0 ? O_G0S : O_G3S));
            gsync(grid);
            post_phase<GLA_DV, true>(P, GLA_N, 1024, 2048, p.in[22 + z] + j * GLA_DV);
            WoT = (const bf16_t*)(ws + WS_GO) + (size_t)j * D * D; Ko = D; lda_o = GLA_N; Ao = P + 2048;
        } else if (kind == 1) {
            { pg8::Gemm g{H, (const bf16_t*)(ws + WS_RIN), MP, RET_N, D, D}; S.init(MP, RET_N, opaque_nwg(), opaque_bid());
              pg8::EpiBf16 E{P, RET_N, 0, 1 << 30, nullptr, RS, cv_mix, RSL}; pg8::rs_stage(S, RS, 0, RSL); pg8::gemm_phase(shl, g, S, E); pg8::gemm_sample(shm, g, E); }
            gsync(grid);
            recur_phase<RET_DK, RET_DV, false>(shm, P, RET_N, 0, 1024, 2048, 0, p.in[3 + z], yo + O_RP, yo + O_RS);
            gsync(grid);
            post_phase<RET_DV, false>(P, RET_N, 2048, 4096, nullptr);
            WoT = (const bf16_t*)(ws + WS_RO); Ko = 2048; lda_o = RET_N; Ao = P + 4096;
        } else {
            { pg8::Gemm g{H, (const bf16_t*)(ws + WS_SIN), MP, SWA_N, D, D}; S.init(MP, SWA_N, opaque_nwg(), opaque_bid());
              pg8::EpiBf16 E{P, SWA_N, 0, 1 << 30, nullptr, RS, cv_mix, RSL}; pg8::rs_stage(S, RS, 0, RSL); pg8::gemm_phase(shl, g, S, E); pg8::gemm_sample(shm, g, E); }
            gsync(grid);
            swa_phase(shm, p, P, z);
            WoT = (const bf16_t*)(ws + WS_SO); Ko = D; lda_o = SWA_N; Ao = P;
        }
        gsync(grid);
        { pg8::Gemm g{Ao, WoT, MP, D, Ko, lda_o}; S.init(MP, D, opaque_nwg(), opaque_bid());
          pg8::EpiRes E{yin_p, yin_s, yo, mod_l + 2 * D, H, avec + (size_t)(2 * layer + 1) * 32 * D, RS}; pg8::gemm_phase(shl, g, S, E); pg8::gemm_sample(shm, g, E); }
        gsync(grid);
        { pg8::Gemm g{H, (const bf16_t*)(ws + WS_W1T) + (size_t)layer * HID * D, MP, HID, D, D}; S.init(MP, HID, opaque_nwg(), opaque_bid());
          pg8::EpiBf16 E{P, HID, 1, 1 << 30, nullptr, RS, cv_mlp, RSL}; pg8::rs_stage(S, RS, 0, RSL); pg8::gemm_phase(shl, g, S, E); pg8::gemm_sample(shm, g, E); }
        gsync(grid);
        { pg8::Gemm g{P, (const bf16_t*)(ws + WS_W2T) + (size_t)layer * HID * D, MP, D, HID, HID}; S.init(MP, D, opaque_nwg(), opaque_bid());
          pg8::EpiRes E{yo, yo + O_YS, yo, mod_l + 5 * D, layer < 3 ? H : nullptr, avec + (size_t)(layer < 3 ? 2 * layer + 2 : 0) * 32 * D, RS}; pg8::gemm_phase(shl, g, S, E); pg8::gemm_sample(shm, g, E); }
        gsync(grid);
    }
}

extern "C" void kernel_launch(void* const* d_in, const int* in_sizes, int n_in, void* d_out, int out_size, void* d_ws, size_t ws_size, hipStream_t stream) {
    static int grid_blocks = 0;
    if (grid_blocks == 0) {
        if (n_in != 34 || (size_t)out_size != O_END || ws_size < WS_END) { fprintf(stderr, "kernel_launch: unexpected sizes n_in %d out %d ws %zu (need %zu)\n", n_in, out_size, ws_size, (size_t)WS_END); grid_blocks = -1; return; }
        int dev = 0, cus = 0, per_cu = 0;
        hipGetDevice(&dev);
        hipDeviceGetAttribute(&cus, hipDeviceAttributeMultiprocessorCount, dev);
        if (hipFuncSetAttribute((const void*)fwd_megakernel, hipFuncAttributeMaxDynamicSharedMemorySize, LDS_BYTES) != hipSuccess) { fprintf(stderr, "kernel_launch: hipFuncSetAttribute failed\n"); grid_blocks = -1; return; }
        hipOccupancyMaxActiveBlocksPerMultiprocessor(&per_cu, (const void*)fwd_megakernel, NTHREADS, LDS_BYTES);
        if (per_cu < 1) { fprintf(stderr, "kernel_launch: occupancy query says %d blocks per CU\n", per_cu); grid_blocks = -1; return; }
        grid_blocks = cus * per_cu;
    }
    if (grid_blocks < 0) return;
    Params p{};
    for (int i = 0; i < 34; ++i) p.in[i] = (const float*)d_in[i];
    p.out = (float*)d_out; p.ws = (unsigned char*)d_ws;
    unsigned char* ws = (unsigned char*)d_ws;
    int nj = 0, tiles = 0;
    auto add = [&](const float* src, bf16_t* dst, int K, int N, float scale) { TJob& j = p.jobs[nj++]; j.src = src; j.dst = dst; j.K = K; j.N = N; j.tile0 = tiles; j.scale = scale; tiles += (K / 64) * (N / 128); };
    for (int l = 0; l < 4; ++l) {
        add(p.in[13] + (size_t)l * D * HID, (bf16_t*)(ws + WS_W1T) + (size_t)l * HID * D, D, HID, 1.0f);
        add(p.in[14] + (size_t)l * HID * D, (bf16_t*)(ws + WS_W2T) + (size_t)l * HID * D, HID, D, 1.0f);
    }
    for (int j = 0; j < 2; ++j) {
        bf16_t* gin = (bf16_t*)(ws + WS_GIN) + (size_t)j * GLA_N * D;
        add(p.in[15] + (size_t)j * D * 512, gin, D, 512, 0.08838834764831845f);
        add(p.in[16] + (size_t)j * D * 512, gin + (size_t)512 * D, D, 512, 1.0f);
        add(p.in[17] + (size_t)j * D * D, gin + (size_t)1024 * D, D, D, 1.0f);
        add(p.in[21] + (size_t)j * D * D, gin + (size_t)2048 * D, D, D, 1.0f);
        add(p.in[23] + (size_t)j * D * D, (bf16_t*)(ws + WS_GO) + (size_t)j * D * D, D, D, 1.0f);
    }
    {
        bf16_t* rin = (bf16_t*)(ws + WS_RIN);
        add(p.in[24], rin, D, D, 1.0f);
        add(p.in[25], rin + (size_t)1024 * D, D, D, 0.0625f);
        add(p.in[26], rin + (size_t)2048 * D, D, 2048, 1.0f);
        add(p.in[27], rin + (size_t)4096 * D, D, 2048, 1.0f);
        add(p.in[28], (bf16_t*)(ws + WS_RO), 2048, D, 1.0f);
    }
    add(p.in[29], (bf16_t*)(ws + WS_SIN), D, SWA_N, 1.0f);
    add(p.in[33], (bf16_t*)(ws + WS_SO), D, D, 1.0f);
    p.ntiles = tiles;
    if (hipMemsetAsync(ws + WS_BAR, 0, WS_BAR_BYTES, stream) != hipSuccess) { fprintf(stderr, "kernel_launch: memset of barrier words failed\n"); return; }
    void* args[] = {&p};
    hipError_t e = hipLaunchCooperativeKernel((const void*)fwd_megakernel, dim3(grid_blocks), dim3(NTHREADS), args, LDS_BYTES, stream);
    if (e != hipSuccess) fprintf(stderr, "kernel_launch: cooperative launch failed: %s (grid %d)\n", hipGetErrorString(e), grid_blocks);
}
```

```cpp
#include <hip/hip_runtime.h>
#include <hip/hip_cooperative_groups.h>
#include <cstdio>
#include <cstdint>
namespace cg = cooperative_groups;

#define LAS __attribute__((address_space(3)))
typedef unsigned short bf16_t;
typedef short bf16x8 __attribute__((ext_vector_type(8)));
typedef float f32x4 __attribute__((ext_vector_type(4)));
typedef unsigned u32x4 __attribute__((ext_vector_type(4)));
typedef unsigned u32x2 __attribute__((ext_vector_type(2)));

constexpr int D = 1024, NB = 16, SEQ = 4096, DSEQ = 16, MP = NB * SEQ, MS = NB * DSEQ, MT = MP + MS;
constexpr int HID = 4096, ADA = 6 * D;
constexpr int GLA_H = 4, GLA_DK = 128, GLA_DV = 256, GLA_N = 3584;
constexpr int RET_H = 4, RET_DK = 256, RET_DV = 512, RET_N = 6144;
constexpr int SWA_N = 1536;
constexpr int NTHREADS = 512;
constexpr int LDS_BYTES = 160 * 1024;
constexpr int DBG_LAYER_MASK = 0xF; constexpr bool DBG_MIXER = true, DBG_MLP = true; constexpr int DBG_SKIP = 0; constexpr bool DBG_FRESH_O = false; constexpr int PROBE_DUP_MIXER = 0, PROBE_DUP_GEMM = 0, PROBE_DUP_MOD = 0;

constexpr size_t O_YP = 0, O_YS = O_YP + (size_t)MP * D, O_G0P = O_YS + (size_t)MS * D, O_G0S = O_G0P + (size_t)NB * 4 * 128 * 256,
                 O_RP = O_G0S + (size_t)NB * 4 * 128 * 256, O_RS = O_RP + (size_t)NB * 4 * 256 * 512, O_KP = O_RS + (size_t)NB * 4 * 256 * 512,
                 O_VP = O_KP + (size_t)NB * 128 * 256, O_KS = O_VP + (size_t)NB * 128 * 256, O_VS = O_KS + (size_t)NB * 16 * 256,
                 O_G3P = O_VS + (size_t)NB * 16 * 256, O_G3S = O_G3P + (size_t)NB * 4 * 128 * 256, O_END = O_G3S + (size_t)NB * 4 * 128 * 256;

constexpr size_t WS_W1T = 0;
constexpr size_t WS_W2T = WS_W1T + (size_t)4 * HID * D * 2;
constexpr size_t WS_GIN = WS_W2T + (size_t)4 * HID * D * 2;
constexpr size_t WS_GO  = WS_GIN + (size_t)2 * GLA_N * D * 2;
constexpr size_t WS_RIN = WS_GO + (size_t)2 * D * D * 2;
constexpr size_t WS_RO  = WS_RIN + (size_t)RET_N * D * 2;
constexpr size_t WS_SIN = WS_RO + (size_t)D * 2048 * 2;
constexpr size_t WS_SO  = WS_SIN + (size_t)SWA_N * D * 2;
constexpr size_t WS_MOD = WS_SO + (size_t)D * D * 2;
constexpr size_t WS_H   = WS_MOD + (size_t)4 * 32 * ADA * 4;
constexpr size_t WS_P   = WS_H + (size_t)MT * D * 2;
constexpr size_t WS_AVEC = WS_P + (size_t)MT * RET_N * 2;
constexpr size_t WS_CVEC = WS_AVEC + (size_t)8 * 32 * D * 4;
constexpr int CVEC_TOTAL_N = 2 * GLA_N + RET_N + SWA_N + 4 * HID;
constexpr size_t WS_RSS = WS_CVEC + (size_t)32 * CVEC_TOTAL_N * 4;
constexpr size_t WS_BAR = WS_RSS + (size_t)MP * 16 * 4 + (size_t)MS * 64 * 4;
constexpr size_t WS_BAR_BYTES = 16384;
constexpr size_t WS_END = WS_BAR + WS_BAR_BYTES;

struct TJob { const float* src; bf16_t* dst; int K, N, tile0; float scale; };
constexpr int NJOBS = 25;
struct Params {
    const float* in[34];
    float* out;
    unsigned char* ws;
    TJob jobs[NJOBS];
    int ntiles; int pad0;
};

typedef __bf16 bf16x2_t __attribute__((ext_vector_type(2)));
typedef float f32x2_t __attribute__((ext_vector_type(2)));
__device__ __forceinline__ unsigned cvt_pk_bf16(float lo, float hi) { const f32x2_t v = {lo, hi}; const bf16x2_t r = __builtin_convertvector(v, bf16x2_t); return __builtin_bit_cast(unsigned, r); }
__device__ __forceinline__ float bf_lo(unsigned u) { return __uint_as_float(u << 16); }
__device__ __forceinline__ float bf_hi(unsigned u) { return __uint_as_float(u & 0xffff0000u); }
__device__ __forceinline__ float silu_f(float x) { return x / (1.0f + __expf(-x)); }
__device__ __forceinline__ int seq_of_row(int r) { return r < MP ? (r >> 12) : 16 + ((r - MP) >> 4); }
__device__ __forceinline__ int opaque_tid() { int t = threadIdx.x; asm volatile("" : "+v"(t)); return t; }
__device__ __forceinline__ int opaque_bid() { int t = blockIdx.x; asm volatile("" : "+s"(t)); return t; }
__device__ __forceinline__ int opaque_nwg() { int t = gridDim.x; asm volatile("" : "+s"(t)); return t; }
__device__ __forceinline__ float wave_sum(float v) {
#pragma unroll
    for (int o = 32; o > 0; o >>= 1) v += __shfl_xor(v, o);
    return v;
}

namespace pg8 {
constexpr int BM = 256, BK = 64, HALF = 128, HTB = HALF * BK * 2, STAGE_BYTES = 8 * HTB, NXCD = 8, WGM = 8;
__host__ __device__ __forceinline__ int lds_byte(int r, int c) { const int st = (r >> 4) * 2 + (c >> 5), rr = r & 15, cc = c & 31, ob = rr * 64 + cc * 2; return st * 1024 + (ob ^ (((ob >> 9) & 1) << 5)); }
__host__ __device__ __forceinline__ void stage_rc(int b, int& R, int& C) { const int st = b / 1024, sb = b % 1024, swz = sb ^ (((sb >> 9) & 1) << 5); R = (st >> 1) * 16 + swz / 64; C = (st & 1) * 32 + (swz % 64) / 2; }
__host__ __device__ __forceinline__ int perm32(int rho) { const int n = rho >> 4, i = rho & 15; return 8 * (i >> 2) + 4 * n + (i & 3); }
struct Unit { int pm, pn; };
struct Gemm { const bf16_t* A; const bf16_t* Bt; int M, N, K, lda; };
struct StaticOrder {
    int nM, nN, nwg, G, c;
    __device__ void init(int M, int N, int G_, int c_) { nM = M / BM; nN = N / BM; nwg = nM * nN; G = G_; c = c_; }
    __device__ bool next(int i, Unit& u) const {
        const long L = (long)i * G + c; if (L >= nwg) return false;
        int wgid = (int)L; { const int q = nwg / NXCD, r = nwg % NXCD, xcd = wgid % NXCD, off = wgid / NXCD; wgid = (xcd < r ? xcd * (q + 1) : r * (q + 1) + (xcd - r) * q) + off; }
        const int nig = WGM * nN, gid = wgid / nig, fm = gid * WGM, gsz = (nM - fm) < WGM ? (nM - fm) : WGM;
        u.pm = fm + ((wgid % nig) % gsz); u.pn = (wgid % nig) / gsz; return true;
    }
};

template <class Epi, bool ALIGN_EPI = true, bool SP2 = true>
__device__ __forceinline__ void gemm_phase(LAS unsigned char* lds, const Gemm g, const StaticOrder& S, const Epi& E) {
    const int tid = opaque_tid(), wid = __builtin_amdgcn_readfirstlane(tid >> 6), lane = tid & 63, wr = wid >> 2, wc = wid & 3, fr = lane & 15, fq = lane >> 4;
    const int K = g.K, nt = K / BK, lda = g.lda;
    unsigned voffA[2], voffB[2];
#pragma unroll
    for (int i = 0; i < 2; ++i) { int R, C; stage_rc(tid * 16 + i * 8192, R, C); const int Rb = Epi::PERM ? ((R & ~31) + perm32(R & 31)) : R;
        voffA[i] = (unsigned)(R * lda + C) * 2u; voffB[i] = (unsigned)(Rb * K + C) * 2u; }
    const size_t kstep = (size_t)(BK * 2);
    const size_t hstepA = (size_t)HALF * lda * 2, hstepB = (size_t)HALF * K * 2;
    const size_t tstepA = 2 * hstepA, tstepB = 2 * hstepB;
    const unsigned ldsw = (unsigned)wid * 1024u;
    const int aoff = lds_byte(wr * 64 + fr, fq * 8), boff = lds_byte(wc * 32 + fr, fq * 8);
#define PG8_SA(b, h) (((b) * 2 + (h)) * HTB)
#define PG8_SB(b, h) ((4 + (b) * 2 + (h)) * HTB)
#define PG8_STAGE(bufoff, gbase, voff) do { _Pragma("unroll") for (int _i = 0; _i < 2; ++_i) \
        __builtin_amdgcn_global_load_lds((const unsigned*)((const char*)(gbase) + (voff)[_i]), (LAS unsigned*)(lds + (bufoff) + ldsw + _i * 8192), 16, 0, 0); } while (0)
#define PG8_LDA(dst, b, h) do { _Pragma("unroll") for (int m = 0; m < 4; ++m) _Pragma("unroll") for (int k = 0; k < 2; ++k) dst[m][k] = *(const LAS bf16x8*)(lds + PG8_SA(b, h) + aoff + m * 2048 + k * 1024); } while (0)
#define PG8_LDB(dst, b, h) do { _Pragma("unroll") for (int n = 0; n < 2; ++n) _Pragma("unroll") for (int k = 0; k < 2; ++k) dst[n][k] = *(const LAS bf16x8*)(lds + PG8_SB(b, h) + boff + n * 2048 + k * 1024); } while (0)
#define PG8_MMA(ai, bj, At, Bt) do { __builtin_amdgcn_s_setprio(1); _Pragma("unroll") for (int m = 0; m < 4; ++m) _Pragma("unroll") for (int n = 0; n < 2; ++n) _Pragma("unroll") for (int k = 0; k < 2; ++k) \
        acc[ai][bj][m][n] = __builtin_amdgcn_mfma_f32_16x16x32_bf16(Bt[n][k], At[m][k], acc[ai][bj][m][n], 0, 0, 0); __builtin_amdgcn_s_setprio(0); } while (0)
#define PG8_WAIT_V(n) asm volatile("s_waitcnt vmcnt(" #n ")" ::: "memory")
#define PG8_WAIT_L(n) asm volatile("s_waitcnt lgkmcnt(" #n ")" ::: "memory")
#define PG8_BAR __builtin_amdgcn_s_barrier()
#define PG8_SCHED __builtin_amdgcn_sched_barrier(0)
    Unit cur, nxt; int ui = 0;
    if (!S.next(0, cur)) return;
    f32x4 acc[2][2][4][2];
#pragma unroll
    for (int a = 0; a < 2; ++a)
#pragma unroll
        for (int b = 0; b < 2; ++b)
#pragma unroll
            for (int m = 0; m < 4; ++m)
#pragma unroll
                for (int n = 0; n < 2; ++n) acc[a][b][m][n] = (f32x4){0.f, 0.f, 0.f, 0.f};
    bf16x8 At[4][2], B0[2][2], B1[2][2];
    const char* cA = (const char*)g.A + (size_t)cur.pm * tstepA; const char* cB = (const char*)g.Bt + (size_t)cur.pn * tstepB;
    if constexpr (SP2) {
        PG8_STAGE(PG8_SB(0, 0), cB, voffB); PG8_STAGE(PG8_SB(0, 1), cB + hstepB, voffB); PG8_STAGE(PG8_SA(0, 0), cA, voffA); PG8_STAGE(PG8_SA(0, 1), cA + hstepA, voffA);
        if (wr == 1) PG8_BAR;
        PG8_WAIT_V(2); PG8_BAR;
        PG8_STAGE(PG8_SB(1, 0), cB + kstep, voffB); PG8_STAGE(PG8_SA(1, 0), cA + kstep, voffA); PG8_STAGE(PG8_SB(1, 1), cB + hstepB + kstep, voffB);
        PG8_WAIT_V(6); PG8_BAR;
    } else {
        PG8_STAGE(PG8_SB(0, 0), cB, voffB); PG8_STAGE(PG8_SA(0, 0), cA, voffA); PG8_STAGE(PG8_SB(0, 1), cB + hstepB, voffB); PG8_STAGE(PG8_SA(0, 1), cA + hstepA, voffA);
        if (wr == 1) PG8_BAR;
        PG8_WAIT_V(4); PG8_BAR;
        PG8_STAGE(PG8_SB(1, 0), cB + kstep, voffB); PG8_STAGE(PG8_SA(1, 0), cA + kstep, voffA); PG8_STAGE(PG8_SB(1, 1), cB + hstepB + kstep, voffB);
        PG8_WAIT_V(6); PG8_BAR;
    }
    for (;;) {
        const bool has_next = S.next(ui + 1, nxt);
        const char* nA = has_next ? (const char*)g.A + (size_t)nxt.pm * tstepA : cA; const char* nB = has_next ? (const char*)g.Bt + (size_t)nxt.pn * tstepB : cB;
        for (int t = 0; t < nt; t += 2) {
            const bool last = (t == nt - 2);
            const char* a1 = cA + (size_t)(t + 1) * kstep;
            const char* a2 = last ? nA : cA + (size_t)(t + 2) * kstep; const char* b2 = last ? nB : cB + (size_t)(t + 2) * kstep;
            const char* a3 = a2 + kstep; const char* b3 = b2 + kstep;
            if constexpr (SP2) {
            PG8_LDB(B0, 0, 0); PG8_LDB(B1, 0, 1); PG8_SCHED; PG8_LDA(At, 0, 0); PG8_STAGE(PG8_SA(1, 1), a1 + hstepA, voffA);
            PG8_WAIT_V(8); PG8_WAIT_L(0); PG8_BAR; PG8_MMA(0, 0, At, B0); PG8_MMA(0, 1, At, B1); PG8_BAR; PG8_SCHED;
            PG8_LDA(At, 0, 1); PG8_STAGE(PG8_SB(0, 0), b2, voffB); PG8_STAGE(PG8_SB(0, 1), b2 + hstepB, voffB); PG8_STAGE(PG8_SA(0, 0), a2, voffA);
            PG8_WAIT_V(8); PG8_WAIT_L(0); PG8_BAR; PG8_MMA(1, 0, At, B0); PG8_MMA(1, 1, At, B1); PG8_BAR; PG8_SCHED;
            PG8_LDB(B0, 1, 0); PG8_LDB(B1, 1, 1); PG8_SCHED; PG8_LDA(At, 1, 0); PG8_STAGE(PG8_SA(0, 1), a2 + hstepA, voffA);
            PG8_WAIT_V(8); PG8_WAIT_L(0); PG8_BAR; PG8_MMA(0, 0, At, B0); PG8_MMA(0, 1, At, B1); PG8_BAR; PG8_SCHED;
            PG8_LDA(At, 1, 1); PG8_STAGE(PG8_SB(1, 0), b3, voffB); PG8_STAGE(PG8_SB(1, 1), b3 + hstepB, voffB); PG8_STAGE(PG8_SA(1, 0), a3, voffA);
            PG8_WAIT_V(8); PG8_WAIT_L(0); PG8_BAR; PG8_MMA(1, 0, At, B0); PG8_MMA(1, 1, At, B1); PG8_BAR; PG8_SCHED;
            } else {
            PG8_LDB(B0, 0, 0); PG8_SCHED; PG8_LDA(At, 0, 0); PG8_STAGE(PG8_SA(1, 1), a1 + hstepA, voffA);
            PG8_WAIT_L(8); PG8_BAR; PG8_WAIT_L(0); PG8_MMA(0, 0, At, B0); PG8_BAR; PG8_SCHED;
            PG8_LDB(B1, 0, 1); PG8_STAGE(PG8_SB(0, 0), b2, voffB);
            PG8_BAR; PG8_WAIT_L(0); PG8_MMA(0, 1, At, B1); PG8_BAR;
            PG8_LDA(At, 0, 1); PG8_STAGE(PG8_SA(0, 0), a2, voffA);
            PG8_BAR; PG8_WAIT_L(0); PG8_MMA(1, 0, At, B0); PG8_BAR; PG8_SCHED;
            PG8_STAGE(PG8_SB(0, 1), b2 + hstepB, voffB);
            PG8_WAIT_V(6); PG8_BAR; PG8_MMA(1, 1, At, B1); PG8_BAR;
            PG8_LDB(B0, 1, 0); PG8_SCHED; PG8_LDA(At, 1, 0); PG8_STAGE(PG8_SA(0, 1), a2 + hstepA, voffA);
            PG8_WAIT_L(8); PG8_BAR; PG8_WAIT_L(0); PG8_MMA(0, 0, At, B0); PG8_BAR; PG8_SCHED;
            PG8_LDB(B1, 1, 1); PG8_STAGE(PG8_SB(1, 0), b3, voffB);
            PG8_BAR; PG8_WAIT_L(0); PG8_MMA(0, 1, At, B1); PG8_BAR;
            PG8_LDA(At, 1, 1); PG8_STAGE(PG8_SA(1, 0), a3, voffA);
            PG8_BAR; PG8_WAIT_L(0); PG8_MMA(1, 0, At, B0); PG8_BAR; PG8_SCHED;
            PG8_STAGE(PG8_SB(1, 1), b3 + hstepB, voffB);
            PG8_WAIT_V(6); PG8_BAR; PG8_MMA(1, 1, At, B1); PG8_BAR;
            }
        }
        if constexpr (ALIGN_EPI) { if (wr == 0) PG8_BAR; }
        E(acc, cur, wr, wc, fr, fq, ui);
        if (!has_next) break;
#pragma unroll
        for (int a = 0; a < 2; ++a)
#pragma unroll
            for (int b = 0; b < 2; ++b)
#pragma unroll
                for (int m = 0; m < 4; ++m)
#pragma unroll
                    for (int n = 0; n < 2; ++n) acc[a][b][m][n] = (f32x4){0.f, 0.f, 0.f, 0.f};
        cur = nxt; cA = nA; cB = nB; ++ui;
        if constexpr (ALIGN_EPI) { if (wr == 1) PG8_BAR; }
    }
    PG8_WAIT_V(0);
    if constexpr (!ALIGN_EPI) { if (wr == 0) PG8_BAR; }
    PG8_BAR;
#undef PG8_SA
#undef PG8_SB
#undef PG8_STAGE
#undef PG8_LDA
#undef PG8_LDB
#undef PG8_MMA
#undef PG8_WAIT_V
#undef PG8_WAIT_L
#undef PG8_BAR
#undef PG8_SCHED
}

__device__ __forceinline__ float row_rs(const float* rss, int r) {
    float t;
    if (r < MP) { const f32x4* q = (const f32x4*)(rss + (size_t)r * 16); const f32x4 a = q[0] + q[1] + q[2] + q[3]; t = (a[0] + a[1]) + (a[2] + a[3]); }
    else { const f32x4* q = (const f32x4*)(rss + (size_t)MP * 16 + (size_t)(r - MP) * 64); f32x4 a = q[0];
#pragma unroll
        for (int i = 1; i < 16; ++i) a += q[i];
        t = (a[0] + a[1]) + (a[2] + a[3]); }
    return rsqrtf(t * (1.0f / D) + 1e-6f);
}
__device__ __forceinline__ float logsig16(float x) { return (fminf(x, 0.f) - __logf(1.0f + __expf(-fabsf(x)))) * (1.0f / 16.0f); }
__device__ __forceinline__ void rs_stage(const StaticOrder& S, const float* rowss, int rbase, LAS float* rsl) {
    const int tid = opaque_tid();
    int nu = 0; { Unit u; while (nu < 24 && S.next(nu, u)) ++nu; }
    __syncthreads();
    for (int idx = tid; idx < nu * 256; idx += NTHREADS) { Unit u; S.next(idx >> 8, u);
        const f32x4* q = (const f32x4*)(rowss + (size_t)(rbase + u.pm * BM + (idx & 255)) * 16);
        const f32x4 a = (q[0] + q[1]) + (q[2] + q[3]);
        rsl[idx] = rsqrtf(((a[0] + a[1]) + (a[2] + a[3])) * (1.0f / D) + 1e-6f); }
    __syncthreads();
}
struct EpiBf16 {
    static constexpr bool PERM = true;
    bf16_t* O; int ldc; int mode; int gate_lo; const float* bias; const float* rowss; const float* cvec;
    const LAS float* rsl;
    __device__ __forceinline__ void tile4(int r, int c, f32x4 v) const {
        const float rs = row_rs(rowss, r);
        v = v * rs + *(const f32x4*)(cvec + (size_t)seq_of_row(r) * ldc + c);
        if (mode == 1) {
#pragma unroll
            for (int j = 0; j < 4; ++j) { const float a = fmaxf(v[j], 0.f); v[j] = a * a; } }
        if (c >= gate_lo) { const f32x4 b = *(const f32x4*)(bias + (c - gate_lo));
#pragma unroll
            for (int j = 0; j < 4; ++j) v[j] = logsig16(v[j] + b[j]); }
        u32x2 w; w.x = cvt_pk_bf16(v[0], v[1]); w.y = cvt_pk_bf16(v[2], v[3]);
        *(u32x2*)(O + (size_t)r * ldc + c) = w;
    }
    __device__ __forceinline__ void operator()(const f32x4 (&acc)[2][2][4][2], const Unit& u, int wr, int wc, int fr, int fq, int ui) const {
        const int row0 = u.pm * BM + wr * 64 + fr, colt = u.pn * BM, col0 = colt + wc * 32 + 8 * fq;
        const bool gate = colt >= gate_lo;
        const float* cvp = cvec + (size_t)seq_of_row(u.pm * BM) * ldc + col0;
        f32x4 bv[2][2];
#pragma unroll
        for (int bj = 0; bj < 2; ++bj)
#pragma unroll
            for (int n = 0; n < 2; ++n) { bv[bj][n] = *(const f32x4*)(cvp + bj * HALF + 4 * n); if (gate) bv[bj][n] += *(const f32x4*)(bias + (col0 - gate_lo) + bj * HALF + 4 * n); }
#pragma unroll
        for (int ai = 0; ai < 2; ++ai) {
#pragma unroll
            for (int m = 0; m < 4; ++m) { const int r = row0 + ai * HALF + m * 16; bf16_t* rowp = O + (size_t)r * ldc + col0;
                const float rs = rsl[ui * 256 + wr * 64 + fr + ai * HALF + m * 16];
#pragma unroll
                for (int bj = 0; bj < 2; ++bj) { f32x4 v0 = acc[ai][bj][m][0] * rs + bv[bj][0], v1 = acc[ai][bj][m][1] * rs + bv[bj][1];
                    if (mode == 1) {
#pragma unroll
                        for (int j = 0; j < 4; ++j) { const float a = fmaxf(v0[j], 0.f), b = fmaxf(v1[j], 0.f); v0[j] = a * a; v1[j] = b * b; } }
                    if (gate) {
#pragma unroll
                        for (int j = 0; j < 4; ++j) { v0[j] = logsig16(v0[j]); v1[j] = logsig16(v1[j]); } }
                    u32x4 w; w.x = cvt_pk_bf16(v0[0], v0[1]); w.y = cvt_pk_bf16(v0[2], v0[3]); w.z = cvt_pk_bf16(v1[0], v1[1]); w.w = cvt_pk_bf16(v1[2], v1[3]);
                    *(u32x4*)(rowp + bj * HALF) = w; } } }
    }
};
struct EpiRes {
    static constexpr bool PERM = false;
    const float* yin_p; const float* yin_s; float* yout; const float* gate;
    bf16_t* Hn; const float* av; float* rowss_next;
    __device__ __forceinline__ void tile4(int r, int c, f32x4 v) const {
        const int sq = seq_of_row(r);
        const f32x4 gv = *(const f32x4*)(gate + (size_t)sq * ADA + c), iv = *(const f32x4*)((r < MP ? yin_p + (size_t)r * D : yin_s + (size_t)(r - MP) * D) + c);
        const f32x4 y = iv + gv * v;
        *(f32x4*)(yout + (size_t)r * D + c) = y;
        if (Hn) {
            const f32x4 a = *(const f32x4*)(av + (size_t)sq * D + c);
            u32x2 w; w.x = cvt_pk_bf16(y[0] * a[0], y[1] * a[1]); w.y = cvt_pk_bf16(y[2] * a[2], y[3] * a[3]);
            *(u32x2*)(Hn + (size_t)r * D + c) = w;
            float ss = y[0] * y[0] + y[1] * y[1] + y[2] * y[2] + y[3] * y[3];
            ss += __shfl_xor(ss, 16); ss += __shfl_xor(ss, 32);
            if ((threadIdx.x & 48) == 0) rowss_next[(size_t)MP * 16 + (size_t)(r - MP) * 64 + (c >> 4)] = ss;
        }
    }
    __device__ __forceinline__ void operator()(const f32x4 (&acc)[2][2][4][2], const Unit& u, int wr, int wc, int fr, int fq, int ui) const {
        const int row0 = u.pm * BM + wr * 64 + fr, col0 = u.pn * BM + wc * 32 + 4 * fq;
        const int sq = seq_of_row(u.pm * BM);
        const float* gp = gate + (size_t)sq * ADA + col0;
        const float* avp = av + (size_t)sq * D + col0;
#pragma unroll
        for (int ai = 0; ai < 2; ++ai) {
            f32x4 yv[4][2][2];
#pragma unroll
            for (int m = 0; m < 4; ++m) { const float* ip = yin_p + (size_t)(row0 + ai * HALF + m * 16) * D + col0;
#pragma unroll
                for (int bj = 0; bj < 2; ++bj)
#pragma unroll
                    for (int n = 0; n < 2; ++n) yv[m][bj][n] = *(const f32x4*)(ip + bj * HALF + n * 16); }
            float ss[4] = {0.f, 0.f, 0.f, 0.f};
#pragma unroll
            for (int bj = 0; bj < 2; ++bj)
#pragma unroll
                for (int n = 0; n < 2; ++n) { const int co = bj * HALF + n * 16;
                    const f32x4 gv = *(const f32x4*)(gp + co), a = Hn ? *(const f32x4*)(avp + co) : (f32x4){0.f, 0.f, 0.f, 0.f};
#pragma unroll
                    for (int m = 0; m < 4; ++m) { const int r = row0 + ai * HALF + m * 16;
                        const f32x4 y = yv[m][bj][n] + gv * acc[ai][bj][m][n];
                        *(f32x4*)(yout + (size_t)r * D + col0 + co) = y;
                        if (Hn) { u32x2 w; w.x = cvt_pk_bf16(y[0] * a[0], y[1] * a[1]); w.y = cvt_pk_bf16(y[2] * a[2], y[3] * a[3]);
                            *(u32x2*)(Hn + (size_t)r * D + col0 + co) = w;
                            ss[m] += y[0] * y[0] + y[1] * y[1] + y[2] * y[2] + y[3] * y[3]; } } }
            if (Hn) {
#pragma unroll
                for (int m = 0; m < 4; ++m) { float t = ss[m]; t += __shfl_xor(t, 16); t += __shfl_xor(t, 32); if (fq == 0) rowss_next[(size_t)(row0 + ai * HALF + m * 16) * 16 + u.pn * 4 + wc] = t; } } }
    }
};

template <class Epi>
__device__ __forceinline__ void gemm_sample(unsigned char* lds, const Gemm g, const Epi& E) {
    const int tid = opaque_tid(), wid = tid >> 6, lane = tid & 63, g4 = lane >> 4, r16 = lane & 15;
    const int K = g.K, CT = g.N >> 8;
    f32x4* red = (f32x4*)lds;
    for (int v = opaque_bid(); v < 256; v += opaque_nwg()) {
        const int row = MP + (v & 15) * 16 + r16, colbase = (v >> 4) * (g.N >> 4);
        const bf16_t* ap = g.A + (size_t)row * g.lda + g4 * 8;
        if (CT == 4) {
            const int ct = wid & 3, kh = wid >> 2, k0 = kh * (K >> 1), k1 = k0 + (K >> 1);
            const bf16_t* bp = g.Bt + (size_t)(colbase + ct * 16 + r16) * K + g4 * 8;
            f32x4 acc = (f32x4){0.f, 0.f, 0.f, 0.f};
#pragma unroll 16
            for (int k = k0; k < k1; k += 32) acc = __builtin_amdgcn_mfma_f32_16x16x32_bf16(*(const bf16x8*)(bp + k), *(const bf16x8*)(ap + k), acc, 0, 0, 0);
            __syncthreads();
            if (kh == 1) red[ct * 64 + lane] = acc;
            __syncthreads();
            if (kh == 0) { acc += red[ct * 64 + lane]; E.tile4(row, colbase + ct * 16 + g4 * 4, acc); }
        } else {
            const int c0 = wid, c1 = wid + 8, c2 = wid + 16;
            const bool h1 = c1 < CT, h2 = c2 < CT;
            if (c0 < CT) {
                const bf16_t* bp0 = g.Bt + (size_t)(colbase + c0 * 16 + r16) * K + g4 * 8;
                const bf16_t* bp1 = g.Bt + (size_t)(colbase + (h1 ? c1 : c0) * 16 + r16) * K + g4 * 8;
                const bf16_t* bp2 = g.Bt + (size_t)(colbase + (h2 ? c2 : c0) * 16 + r16) * K + g4 * 8;
                f32x4 a0 = (f32x4){0.f, 0.f, 0.f, 0.f}, a1 = a0, a2 = a0;
#pragma unroll 8
                for (int k = 0; k < K; k += 32) { const bf16x8 av = *(const bf16x8*)(ap + k);
                    a0 = __builtin_amdgcn_mfma_f32_16x16x32_bf16(*(const bf16x8*)(bp0 + k), av, a0, 0, 0, 0);
                    a1 = __builtin_amdgcn_mfma_f32_16x16x32_bf16(*(const bf16x8*)(bp1 + k), av, a1, 0, 0, 0);
                    a2 = __builtin_amdgcn_mfma_f32_16x16x32_bf16(*(const bf16x8*)(bp2 + k), av, a2, 0, 0, 0); }
                E.tile4(row, colbase + c0 * 16 + g4 * 4, a0);
                if (h1) E.tile4(row, colbase + c1 * 16 + g4 * 4, a1);
                if (h2) E.tile4(row, colbase + c2 * 16 + g4 * 4, a2);
            }
        }
    }
}
}

#define MFMA16(a, b, c) __builtin_amdgcn_mfma_f32_16x16x32_bf16((a), (b), (c), 0, 0, 0)

__device__ __forceinline__ void prep_phase(unsigned char* lds, const Params& p) {
    const int tid = opaque_tid();
    {
        float* sc = (float*)lds;
        float* red = sc + 32 * 512;
        for (int u = opaque_bid(); u < 4 * 48; u += opaque_nwg()) {
            const int l = u / 48, cb = u % 48, col = cb * 128 + (tid & 127), kq = tid >> 7;
            const float* w = p.in[11] + (size_t)l * D * ADA + col;
            float a[32];
#pragma unroll
            for (int s = 0; s < 32; ++s) a[s] = 0.f;
#pragma unroll 1
            for (int half = 0; half < 2; ++half) {
                __syncthreads();
                for (int i = tid; i < 32 * 512; i += NTHREADS) { const int s = i >> 9, k = half * 512 + (i & 511); const float c = s < 16 ? p.in[7][s * D + k] : p.in[8][(s - 16) * D + k]; sc[i] = silu_f(c); }
                __syncthreads();
#pragma unroll 2
                for (int kl = kq * 128; kl < kq * 128 + 128; kl += 4) {
                    const int k = half * 512 + kl;
                    const float w0 = w[(size_t)k * ADA], w1 = w[(size_t)(k + 1) * ADA], w2 = w[(size_t)(k + 2) * ADA], w3 = w[(size_t)(k + 3) * ADA];
#pragma unroll
                    for (int s = 0; s < 32; ++s) { const f32x4 c4 = *(const f32x4*)(sc + s * 512 + kl); a[s] += c4[0] * w0 + c4[1] * w1 + c4[2] * w2 + c4[3] * w3; }
                }
            }
            if (kq > 0) {
#pragma unroll
                for (int s = 0; s < 32; ++s) red[((kq - 1) * 32 + s) * 128 + (tid & 127)] = a[s];
            }
            __syncthreads();
            if (kq == 0) {
                float* mo = (float*)(p.ws + WS_MOD) + (size_t)l * 32 * ADA + col;
                const float bias = p.in[12][(size_t)l * ADA + col];
#pragma unroll
                for (int s = 0; s < 32; ++s) { const int c = tid & 127; mo[(size_t)s * ADA] = a[s] + red[(0 * 32 + s) * 128 + c] + red[(1 * 32 + s) * 128 + c] + red[(2 * 32 + s) * 128 + c] + bias; }
            }
        }
        __syncthreads();
    }
    {
        const int gt = opaque_bid() * NTHREADS + tid, gn = opaque_nwg() * NTHREADS;
        for (int i = gt; i < 2 * 512 * 512; i += gn) {
            const int k2 = (i & 511) * 2, n = (i >> 9) & 511, j = i >> 18;
            const float* w1 = p.in[18] + (size_t)j * D * 16 + (size_t)k2 * 16; const float* w2 = p.in[19] + (size_t)j * 16 * 512 + n;
            float a0 = 0.f, a1 = 0.f;
#pragma unroll
            for (int r = 0; r < 16; ++r) { const float b = w2[r * 512]; a0 += w1[r] * b; a1 += w1[16 + r] * b; }
            bf16_t* dst = (bf16_t*)(p.ws + WS_GIN) + (size_t)j * GLA_N * D + (size_t)(3072 + n) * D + k2;
            *(unsigned*)dst = cvt_pk_bf16(a0, a1);
        }
    }
    {
        float* tl = (float*)lds;
        const int nwgs = opaque_nwg();
        float rv[16];
#define TR_JOB(T, JB, K0, N0) do { int j_ = 0; _Pragma("unroll 1") for (int q = 1; q < NJOBS; ++q) if ((T) >= p.jobs[q].tile0) j_ = q; JB = p.jobs[j_]; \
        const int lt_ = (T) - JB.tile0, ntn_ = JB.N >> 7; K0 = (lt_ / ntn_) << 6; N0 = (lt_ % ntn_) << 7; } while (0)
#define TR_LOAD(JB, K0, N0) do { _Pragma("unroll") for (int i = 0; i < 16; ++i) { const int idx = tid + NTHREADS * i, r = idx >> 7, c = idx & 127; rv[i] = JB.src[(size_t)((K0) + r) * JB.N + (N0) + c]; } } while (0)
        int t = opaque_bid();
        TJob jb; int k0 = 0, n0 = 0;
        if (t < p.ntiles) { TR_JOB(t, jb, k0, n0); TR_LOAD(jb, k0, n0); }
        for (; t < p.ntiles; t += nwgs) {
            __syncthreads();
#pragma unroll
            for (int i = 0; i < 16; ++i) { const int idx = tid + NTHREADS * i, r = idx >> 7, c = idx & 127; tl[c * 65 + r] = rv[i]; }
            __syncthreads();
            const TJob cj = jb; const int ck0 = k0, cn0 = n0;
            if (t + nwgs < p.ntiles) { TR_JOB(t + nwgs, jb, k0, n0); TR_LOAD(jb, k0, n0); }
#pragma unroll
            for (int i = 0; i < 8; ++i) { const int pi = tid + NTHREADS * i, n = pi >> 5, k2 = (pi & 31) * 2;
                *(unsigned*)(cj.dst + (size_t)(cn0 + n) * cj.K + ck0 + k2) = cvt_pk_bf16(tl[n * 65 + k2] * cj.scale, tl[n * 65 + k2 + 1] * cj.scale); }
        }
#undef TR_JOB
#undef TR_LOAD
    }
}

__device__ __forceinline__ int stage_N(int s) { return (s & 1) ? HID : (s == 2) ? RET_N : (s == 4) ? SWA_N : GLA_N; }
__device__ __forceinline__ int stage_cvoff(int s) { return s == 0 ? 0 : s == 1 ? 3584 : s == 2 ? 7680 : s == 3 ? 13824 : s == 4 ? 17920 : s == 5 ? 19456 : s == 6 ? 23552 : 27136; }
__device__ __forceinline__ const bf16_t* stage_W(const unsigned char* ws, int s) {
    const int layer = s >> 1;
    if (s & 1) return (const bf16_t*)(ws + WS_W1T) + (size_t)layer * HID * D;
    return s == 2 ? (const bf16_t*)(ws + WS_RIN) : s == 4 ? (const bf16_t*)(ws + WS_SIN) : (const bf16_t*)(ws + WS_GIN) + (size_t)(layer / 3) * GLA_N * D;
}
__device__ __forceinline__ void prepb_phase(const Params& p) {
    const int tid = opaque_tid(), lane = tid & 63, wid = tid >> 6, g4 = lane >> 4, r16 = lane & 15;
    const float* mod = (const float*)(p.ws + WS_MOD);
    float* av = (float*)(p.ws + WS_AVEC);
    for (int i = opaque_bid() * NTHREADS + tid; i < 8 * 32 * D; i += opaque_nwg() * NTHREADS) { const int st = i >> 15, sq = (i >> 10) & 31, c = i & 1023, layer = st >> 1;
        const float g = ((st & 1) ? p.in[10] : p.in[9])[layer * D + c];
        av[i] = g * (1.0f + mod[((size_t)layer * 32 + sq) * ADA + ((st & 1) ? 4 : 1) * D + c]); }
    float* cvec = (float*)(p.ws + WS_CVEC);
    for (int it = opaque_bid() * 8 + wid; it < CVEC_TOTAL_N / 16; it += opaque_nwg() * 8) {
        const int ng = it * 16; int st = 0;
#pragma unroll
        for (int q = 1; q < 8; ++q) if (ng >= stage_cvoff(q)) st = q;
        const int n0 = ng - stage_cvoff(st), N = stage_N(st), layer = st >> 1;
        const bf16_t* wp = stage_W(p.ws, st) + (size_t)(n0 + r16) * D + g4 * 8;
        const float* sh0 = mod + ((size_t)layer * 32 + r16) * ADA + ((st & 1) ? 3 : 0) * D + g4 * 8; const float* sh1 = sh0 + (size_t)16 * ADA;
        f32x4 acc0 = (f32x4){0.f, 0.f, 0.f, 0.f}, acc1 = acc0;
#pragma unroll 4
        for (int k = 0; k < D; k += 32) {
            const bf16x8 bw = *(const bf16x8*)(wp + k);
            const f32x4 x0 = *(const f32x4*)(sh0 + k), x1 = *(const f32x4*)(sh0 + k + 4), y0 = *(const f32x4*)(sh1 + k), y1 = *(const f32x4*)(sh1 + k + 4);
            u32x4 a0, a1; a0.x = cvt_pk_bf16(x0[0], x0[1]); a0.y = cvt_pk_bf16(x0[2], x0[3]); a0.z = cvt_pk_bf16(x1[0], x1[1]); a0.w = cvt_pk_bf16(x1[2], x1[3]);
            a1.x = cvt_pk_bf16(y0[0], y0[1]); a1.y = cvt_pk_bf16(y0[2], y0[3]); a1.z = cvt_pk_bf16(y1[0], y1[1]); a1.w = cvt_pk_bf16(y1[2], y1[3]);
            acc0 = MFMA16(bw, __builtin_bit_cast(bf16x8, a0), acc0); acc1 = MFMA16(bw, __builtin_bit_cast(bf16x8, a1), acc1);
        }
        float* cp = cvec + (size_t)32 * stage_cvoff(st) + (size_t)r16 * N + n0 + g4 * 4;
        *(f32x4*)cp = acc0; *(f32x4*)(cp + (size_t)16 * N) = acc1;
    }
    bf16_t* H = (bf16_t*)(p.ws + WS_H); float* rss = (float*)(p.ws + WS_RSS);
    for (int r = opaque_bid() * 8 + wid; r < MT; r += opaque_nwg() * 8) {
        const float* src = r < MP ? p.in[0] + (size_t)r * D : p.in[1] + (size_t)(r - MP) * D;
        const float* mrow = mod + (size_t)seq_of_row(r) * ADA + D;
        float ss = 0.f;
#pragma unroll
        for (int i = 0; i < 4; ++i) { const int c = i * 256 + lane * 4;
            const f32x4 v = *(const f32x4*)(src + c), gv = *(const f32x4*)(p.in[9] + c), sc = *(const f32x4*)(mrow + c);
            ss += v[0] * v[0] + v[1] * v[1] + v[2] * v[2] + v[3] * v[3];
            u32x2 w; w.x = cvt_pk_bf16(v[0] * gv[0] * (1.0f + sc[0]), v[1] * gv[1] * (1.0f + sc[1])); w.y = cvt_pk_bf16(v[2] * gv[2] * (1.0f + sc[2]), v[3] * gv[3] * (1.0f + sc[3]));
            *(u32x2*)(H + (size_t)r * D + c) = w; }
        ss = wave_sum(ss);
        if (r < MP) { if (lane < 16) rss[(size_t)r * 16 + lane] = lane == 0 ? ss : 0.f; } else rss[(size_t)MP * 16 + (size_t)(r - MP) * 64 + lane] = lane == 0 ? ss : 0.f;
    }
}

template <int DK, int DV, bool GLA>
__device__ __forceinline__ void recur_phase(unsigned char* lds, bf16_t* P, int ldp, int qoff, int koff, int voff, int goff, const float* S0s, float* outSp, float* outSs, bool live = true, bf16_t* PO = nullptr, int ldo = 0) {
    constexpr int VS = 64, NVS = DV / VS, NH = 4;
    constexpr int QS = DK + 8, TS = 64 + 8;
    constexpr int CP = DK / 2, NSEG = NTHREADS / CP, RPS = 64 / NSEG, NDT = DK / 128, NKK = DK / 32;
    bf16_t* QD = (bf16_t*)lds;
    bf16_t* KD = QD + 64 * QS;
    bf16_t* KDT = KD + 64 * QS;
    bf16_t* VT = KDT + DK * TS;
    bf16_t* ATT = VT + VS * TS;
    bf16_t* ST = ATT + 64 * TS;
    float* SEG = (float*)(ST + VS * QS);
    float* EBL = SEG + (GLA ? NSEG * DK : 0);
    static_assert((size_t)(64 * QS * 2 + DK * TS + VS * TS + 64 * TS + VS * QS) * 2 + (GLA ? (NSEG + 1) * DK * 4 : 0) <= LDS_BYTES, "recurrence LDS");
    const int tid = opaque_tid(), lane = tid & 63, wid = tid >> 6, g4 = lane >> 4, r16 = lane & 15;
    const int cp = tid % CP, sgm = tid / CP, vcp = tid & 31, vsg = tid >> 5;
    constexpr int NIP = NB * NH * NVS;
    for (int item = opaque_bid(); item < 2 * NIP; item += opaque_nwg()) {
        const bool smp = item >= NIP; const int it = smp ? item - NIP : item;
        const int vs = it % NVS, h = (it / NVS) % NH, b = it / (NVS * NH);
        const int row0 = smp ? MP + b * DSEQ : b * SEQ, nch = smp ? 1 : SEQ / 64, Lc = smp ? DSEQ : 64;
        const float lgam = GLA ? 0.f : __logf(1.0f - exp2f(-5.0f - (float)h));
        f32x4 sacc[NDT][4];
        __syncthreads();
#pragma unroll
        for (int dl = 0; dl < NDT; ++dl)
#pragma unroll
            for (int vt = 0; vt < 4; ++vt) {
                f32x4 s = (f32x4){0.f, 0.f, 0.f, 0.f};
                const int d0 = (wid * NDT + dl) * 16 + g4 * 4, v = vt * 16 + r16;
                if (smp) {
#pragma unroll
                    for (int j = 0; j < 4; ++j) s[j] = S0s[(((size_t)b * NH + h) * DK + d0 + j) * DV + vs * VS + v];
                }
                sacc[dl][vt] = s;
                u32x2 w; w.x = cvt_pk_bf16(s[0], s[1]); w.y = cvt_pk_bf16(s[2], s[3]);
                *(u32x2*)(ST + v * QS + d0) = w;
            }
        unsigned rq[RPS], rk[RPS], rg[RPS], rv[4];
        const bf16_t* Pq = P + qoff + h * DK + 2 * cp; const bf16_t* Pk = P + koff + h * DK + 2 * cp; const bf16_t* Pg = P + goff + h * DK + 2 * cp;
        bf16_t* Pv = P + voff + h * DV + vs * VS;
#define RC_LOAD(c) do { \
        _Pragma("unroll") for (int i = 0; i < RPS; ++i) { const int row = sgm * RPS + i; const size_t go = (size_t)(row0 + (c) * 64 + row) * ldp; const bool ok = row < Lc; \
            rq[i] = ok ? *(const unsigned*)(Pq + go) : 0u; rk[i] = ok ? *(const unsigned*)(Pk + go) : 0u; if (GLA) rg[i] = ok ? *(const unsigned*)(Pg + go) : 0u; } \
        _Pragma("unroll") for (int i = 0; i < 4; ++i) { const int row = vsg * 4 + i; rv[i] = row < Lc ? *(const unsigned*)(Pv + (size_t)(row0 + (c) * 64 + row) * ldp + 2 * vcp) : 0u; } } while (0)
        RC_LOAD(0);
        for (int c = 0; c < nch; ++c) {
            float off0 = 0.f, off1 = 0.f, tot0 = 0.f, tot1 = 0.f;
            float pre0[RPS], pre1[RPS];
            if (GLA) {
                float a0 = 0.f, a1 = 0.f;
#pragma unroll
                for (int i = 0; i < RPS; ++i) { a0 += bf_lo(rg[i]); a1 += bf_hi(rg[i]); pre0[i] = a0; pre1[i] = a1; }
                SEG[sgm * DK + 2 * cp] = a0; SEG[sgm * DK + 2 * cp + 1] = a1;
                __syncthreads();
#pragma unroll
                for (int s = 0; s < NSEG; ++s) { const float t0 = SEG[s * DK + 2 * cp], t1 = SEG[s * DK + 2 * cp + 1]; if (s < sgm) { off0 += t0; off1 += t1; } tot0 += t0; tot1 += t1; }
                if (sgm == 0) { EBL[2 * cp] = __expf(tot0); EBL[2 * cp + 1] = __expf(tot1); }
            }
            {
                float kt0[RPS], kt1[RPS];
#pragma unroll
                for (int i = 0; i < RPS; ++i) { const int row = sgm * RPS + i;
                    const float q0 = bf_lo(rq[i]), q1 = bf_hi(rq[i]), k0 = bf_lo(rk[i]), k1 = bf_hi(rk[i]);
                    if (GLA) {
                        const float b0 = off0 + pre0[i], b1 = off1 + pre1[i];
                        const float e0 = __expf(b0), e1 = __expf(b1);
                        *(unsigned*)(QD + row * QS + 2 * cp) = cvt_pk_bf16(q0 * e0, q1 * e1);
                        *(unsigned*)(KD + row * QS + 2 * cp) = cvt_pk_bf16(k0 * __expf(-b0), k1 * __expf(-b1));
                        kt0[i] = k0 * __expf(tot0 - b0); kt1[i] = k1 * __expf(tot1 - b1);
                    } else {
                        *(unsigned*)(QD + row * QS + 2 * cp) = rq[i];
                        *(unsigned*)(KD + row * QS + 2 * cp) = rk[i];
                        const float dk = __expf(lgam * (float)(Lc - 1 - row));
                        kt0[i] = k0 * dk; kt1[i] = k1 * dk;
                    } }
#pragma unroll
                for (int i = 0; i < RPS; i += 8) {
                    u32x4 w0, w1;
                    w0.x = cvt_pk_bf16(kt0[i], kt0[i + 1]); w0.y = cvt_pk_bf16(kt0[i + 2], kt0[i + 3]); w0.z = cvt_pk_bf16(kt0[i + 4], kt0[i + 5]); w0.w = cvt_pk_bf16(kt0[i + 6], kt0[i + 7]);
                    w1.x = cvt_pk_bf16(kt1[i], kt1[i + 1]); w1.y = cvt_pk_bf16(kt1[i + 2], kt1[i + 3]); w1.z = cvt_pk_bf16(kt1[i + 4], kt1[i + 5]); w1.w = cvt_pk_bf16(kt1[i + 6], kt1[i + 7]);
                    *(u32x4*)(KDT + (2 * cp) * TS + sgm * RPS + i) = w0; *(u32x4*)(KDT + (2 * cp + 1) * TS + sgm * RPS + i) = w1;
                }
                u32x2 v0, v1;
                v0.x = (rv[0] & 0xffffu) | (rv[1] << 16); v0.y = (rv[2] & 0xffffu) | (rv[3] << 16);
                v1.x = (rv[0] >> 16) | (rv[1] & 0xffff0000u); v1.y = (rv[2] >> 16) | (rv[3] & 0xffff0000u);
                *(u32x2*)(VT + (2 * vcp) * TS + vsg * 4) = v0; *(u32x2*)(VT + (2 * vcp + 1) * TS + vsg * 4) = v1;
            }
            __syncthreads();
            if (c + 1 < nch) RC_LOAD(c + 1);
#pragma unroll
            for (int tt = 0; tt < 2; ++tt) { const int t = wid * 2 + tt, lt = t >> 2, st = t & 3;
                f32x4 acc = (f32x4){0.f, 0.f, 0.f, 0.f};
                if (st <= lt) {
#pragma unroll
                    for (int kk = 0; kk < NKK; ++kk) { const bf16x8 a = *(const bf16x8*)(QD + (lt * 16 + r16) * QS + kk * 32 + g4 * 8), bb = *(const bf16x8*)(KD + (st * 16 + r16) * QS + kk * 32 + g4 * 8);
                        acc = MFMA16(bb, a, acc); }
                }
                const int l = lt * 16 + r16, s0 = st * 16 + g4 * 4;
#pragma unroll
                for (int j = 0; j < 4; ++j) { const int s = s0 + j; float v = acc[j]; if (!GLA) v *= __expf(lgam * (float)(l - s)); acc[j] = (s <= l) ? v : 0.f; }
                u32x2 w; w.x = cvt_pk_bf16(acc[0], acc[1]); w.y = cvt_pk_bf16(acc[2], acc[3]);
                *(u32x2*)(ATT + l * TS + s0) = w; }
            __syncthreads();
#pragma unroll
            for (int tt = 0; tt < 2; ++tt) { const int t = wid * 2 + tt, lt = t >> 2, vt = t & 3;
                f32x4 a1 = (f32x4){0.f, 0.f, 0.f, 0.f}, a2 = (f32x4){0.f, 0.f, 0.f, 0.f};
#pragma unroll
                for (int kk = 0; kk < 2; ++kk) { if (kk * 32 <= lt * 16 + 15) { const bf16x8 a = *(const bf16x8*)(ATT + (lt * 16 + r16) * TS + kk * 32 + g4 * 8), bb = *(const bf16x8*)(VT + (vt * 16 + r16) * TS + kk * 32 + g4 * 8);
                        a1 = MFMA16(bb, a, a1); } }
#pragma unroll
                for (int kk = 0; kk < NKK; ++kk) { const bf16x8 a = *(const bf16x8*)(QD + (lt * 16 + r16) * QS + kk * 32 + g4 * 8), bb = *(const bf16x8*)(ST + (vt * 16 + r16) * QS + kk * 32 + g4 * 8);
                    a2 = MFMA16(bb, a, a2); }
                const int l = lt * 16 + r16;
                const float dq = GLA ? 1.0f : __expf(lgam * (float)(l + 1));
                if (l < Lc && live) { u32x2 w; w.x = cvt_pk_bf16(a1[0] + a2[0] * dq, a1[1] + a2[1] * dq); w.y = cvt_pk_bf16(a1[2] + a2[2] * dq, a1[3] + a2[3] * dq);
                    if (PO) *(u32x2*)(PO + (size_t)(row0 + c * 64 + l) * ldo + h * DV + vs * VS + vt * 16 + g4 * 4) = w;
                    else *(u32x2*)(Pv + (size_t)(row0 + c * 64 + l) * ldp + vt * 16 + g4 * 4) = w; } }
            __syncthreads();
#pragma unroll
            for (int dl = 0; dl < NDT; ++dl) { const int dt = wid * NDT + dl;
                f32x4 dec;
                if (GLA) dec = *(const f32x4*)(EBL + dt * 16 + g4 * 4); else { const float dc = __expf(lgam * (float)Lc); dec = (f32x4){dc, dc, dc, dc}; }
                const bf16x8 ka0 = *(const bf16x8*)(KDT + (dt * 16 + r16) * TS + g4 * 8), ka1 = *(const bf16x8*)(KDT + (dt * 16 + r16) * TS + 32 + g4 * 8);
#pragma unroll
                for (int vt = 0; vt < 4; ++vt) {
                    f32x4 acc = sacc[dl][vt] * dec;
                    acc = MFMA16(ka0, *(const bf16x8*)(VT + (vt * 16 + r16) * TS + g4 * 8), acc);
                    acc = MFMA16(ka1, *(const bf16x8*)(VT + (vt * 16 + r16) * TS + 32 + g4 * 8), acc);
                    sacc[dl][vt] = acc;
                    u32x2 w; w.x = cvt_pk_bf16(acc[0], acc[1]); w.y = cvt_pk_bf16(acc[2], acc[3]);
                    *(u32x2*)(ST + (vt * 16 + r16) * QS + dt * 16 + g4 * 4) = w;
                } }
            __syncthreads();
        }
#undef RC_LOAD
        float* So = smp ? outSs : outSp;
#pragma unroll
        for (int dl = 0; dl < NDT; ++dl)
#pragma unroll
            for (int vt = 0; vt < 4; ++vt) { const int d0 = (wid * NDT + dl) * 16 + g4 * 4, v = vt * 16 + r16;
#pragma unroll
                for (int j = 0; j < 4; ++j) if (live) So[(((size_t)b * NH + h) * DK + d0 + j) * DV + vs * VS + v] = sacc[dl][vt][j]; }
    }
}

template <int DV, bool GLA>
__device__ __forceinline__ void post_phase(bf16_t* P, int ldp, int ooff, int goff, const float* normg) {
    constexpr int EPL = DV / 16;
    const int tid = opaque_tid(), lane = tid & 63, wid = tid >> 6;
    float ng[EPL];
#pragma unroll
    for (int i = 0; i < EPL; ++i) ng[i] = GLA ? normg[(lane & 15) * EPL + i] : 1.0f;
    for (int r0 = (opaque_bid() * 8 + wid) * 2; r0 < MT; r0 += opaque_nwg() * 16) {
        float o[2][EPL]; u32x4 gw[2][EPL / 8];
#pragma unroll
        for (int rr = 0; rr < 2; ++rr) { const bf16_t* po = P + (size_t)(r0 + rr) * ldp + ooff + lane * EPL; const bf16_t* pg = P + (size_t)(r0 + rr) * ldp + goff + lane * EPL;
#pragma unroll
            for (int i = 0; i < EPL; i += 8) { const u32x4 w = *(const u32x4*)(po + i); gw[rr][i / 8] = *(const u32x4*)(pg + i);
#pragma unroll
                for (int j = 0; j < 4; ++j) { o[rr][i + 2 * j] = bf_lo(w[j]); o[rr][i + 2 * j + 1] = bf_hi(w[j]); } } }
#pragma unroll
        for (int rr = 0; rr < 2; ++rr) {
            float s1 = 0.f, s2 = 0.f;
#pragma unroll
            for (int i = 0; i < EPL; ++i) { s1 += o[rr][i]; s2 += o[rr][i] * o[rr][i]; }
#pragma unroll
            for (int m = 1; m < 16; m <<= 1) { s1 += __shfl_xor(s1, m); s2 += __shfl_xor(s2, m); }
            float mu = 0.f, rs;
            if (GLA) rs = rsqrtf(s2 * (1.0f / DV) + 1e-6f);
            else { mu = s1 * (1.0f / DV); rs = rsqrtf(fmaxf(s2 * (1.0f / DV) - mu * mu, 0.f) + 1e-5f); }
            bf16_t* pg = P + (size_t)(r0 + rr) * ldp + goff + lane * EPL;
#pragma unroll
            for (int i = 0; i < EPL; i += 8) { const u32x4 g = gw[rr][i / 8]; u32x4 w;
#pragma unroll
                for (int j = 0; j < 4; ++j) { float x0 = (o[rr][i + 2 * j] - mu) * rs, x1 = (o[rr][i + 2 * j + 1] - mu) * rs;
                    if (GLA) { x0 *= ng[i + 2 * j]; x1 *= ng[i + 2 * j + 1]; }
                    w[j] = cvt_pk_bf16(x0 * silu_f(bf_lo(g[j])), x1 * silu_f(bf_hi(g[j]))); }
                *(u32x4*)(pg + i) = w; }
        }
    }
}

__device__ __forceinline__ void swa_phase(unsigned char* lds, const Params& p, bf16_t* P, int z) {
    const bool live = true;
    constexpr int KS_S = 72, VT_S = 200, PW_S = 200;
    bf16_t* KS = (bf16_t*)lds;
    bf16_t* VT = KS + 192 * KS_S;
    bf16_t* PW = VT + 64 * VT_S;
    const int tid = opaque_tid(), lane = tid & 63, wid = tid >> 6, g4 = lane >> 4, r16 = lane & 15;
    const float* qn = p.in[30 + z]; const float* kn = p.in[31 + z]; const float* sinks = p.in[32 + z];
    const float* cache_k = p.in[4 + z]; const float* cache_v = p.in[5 + z];
    float* out = p.out + z;
    constexpr int NPI = NB * 64 * 4, NSI = NB * 4;
    for (int item = opaque_bid(); item < NPI + NSI; item += opaque_nwg()) {
        const bool smp = item >= NPI; const int it = smp ? item - NPI : item;
        const int kv = it & 3, c = smp ? 0 : (it >> 2) & 63, b = smp ? it >> 2 : it >> 8;
        const int Lq = smp ? DSEQ : 64;
        __syncthreads();
        const int d0 = (tid & 7) * 8;
        f32x4 kn0 = *(const f32x4*)(kn + d0), kn1 = *(const f32x4*)(kn + d0 + 4);
#pragma unroll
        for (int i = 0; i < 3; ++i) { const int s = (tid >> 3) + 64 * i;
            float kf[8], vf[8]; bool valid, donorm = true; long prow = 0;
            if (!smp) { const int tok = (c - 2) * 64 + s; valid = tok >= 0; prow = (long)b * SEQ + tok; }
            else { valid = s < 128 + DSEQ; donorm = s >= 128; prow = (long)MP + b * DSEQ + (s - 128); }
            if (valid && (!smp || s >= 128)) {
                const u32x4 kw = *(const u32x4*)(P + (size_t)prow * SWA_N + 1024 + kv * 64 + d0), vw = *(const u32x4*)(P + (size_t)prow * SWA_N + 1280 + kv * 64 + d0);
#pragma unroll
                for (int j = 0; j < 4; ++j) { kf[2 * j] = bf_lo(kw[j]); kf[2 * j + 1] = bf_hi(kw[j]); vf[2 * j] = bf_lo(vw[j]); vf[2 * j + 1] = bf_hi(vw[j]); }
            } else if (valid) {
                const float* ck = cache_k + (((size_t)b * 128 + s) * 4 + kv) * 64 + d0; const float* cv = cache_v + (((size_t)b * 128 + s) * 4 + kv) * 64 + d0;
                const f32x4 a0 = *(const f32x4*)ck, a1 = *(const f32x4*)(ck + 4), c0 = *(const f32x4*)cv, c1 = *(const f32x4*)(cv + 4);
#pragma unroll
                for (int j = 0; j < 4; ++j) { kf[j] = a0[j]; kf[4 + j] = a1[j]; vf[j] = c0[j]; vf[4 + j] = c1[j]; }
            } else {
#pragma unroll
                for (int j = 0; j < 8; ++j) { kf[j] = 0.f; vf[j] = 0.f; }
            }
            float ss = 0.f;
#pragma unroll
            for (int j = 0; j < 8; ++j) ss += kf[j] * kf[j];
            ss += __shfl_xor(ss, 1); ss += __shfl_xor(ss, 2); ss += __shfl_xor(ss, 4);
            if (donorm) { const float rs = rsqrtf(ss * (1.0f / 64) + 1e-6f);
#pragma unroll
                for (int j = 0; j < 4; ++j) { kf[j] *= rs * kn0[j]; kf[4 + j] *= rs * kn1[j]; } }
            u32x4 w; w.x = cvt_pk_bf16(kf[0], kf[1]); w.y = cvt_pk_bf16(kf[2], kf[3]); w.z = cvt_pk_bf16(kf[4], kf[5]); w.w = cvt_pk_bf16(kf[6], kf[7]);
            *(u32x4*)(KS + s * KS_S + d0) = w;
#pragma unroll
            for (int j = 0; j < 8; ++j) VT[(d0 + j) * VT_S + s] = (bf16_t)(cvt_pk_bf16(vf[j], 0.f) & 0xffffu);
            float* ko = nullptr; float* vo = nullptr;
            if (!smp && c >= 62 && s >= 128) { const int w_ = (c - 62) * 64 + (s - 128); ko = out + O_KP + (((size_t)b * 128 + w_) * 4 + kv) * 64 + d0; vo = out + O_VP + (((size_t)b * 128 + w_) * 4 + kv) * 64 + d0; }
            if (smp && s >= 128 && s < 128 + DSEQ) { ko = out + O_KS + (((size_t)b * DSEQ + (s - 128)) * 4 + kv) * 64 + d0; vo = out + O_VS + (((size_t)b * DSEQ + (s - 128)) * 4 + kv) * 64 + d0; }
            if (ko && live) { *(f32x4*)ko = (f32x4){kf[0], kf[1], kf[2], kf[3]}; *(f32x4*)(ko + 4) = (f32x4){kf[4], kf[5], kf[6], kf[7]};
                      *(f32x4*)vo = (f32x4){vf[0], vf[1], vf[2], vf[3]}; *(f32x4*)(vo + 4) = (f32x4){vf[4], vf[5], vf[6], vf[7]}; }
        }
        __syncthreads();
        const int gq = wid >> 1, hh = kv * 4 + gq;
        const float slope = exp2f(-0.5f * (float)(hh + 1)), sink = sinks[hh];
        bf16_t* pw = PW + wid * 16 * PW_S;
        for (int rt = 0; rt < 2; ++rt) {
            const int l = (wid & 1) * 32 + rt * 16 + r16;
            if ((wid & 1) * 32 + rt * 16 >= Lq) break;
            const bool lvalid = l < Lq;
            const size_t prow = smp ? (size_t)MP + b * DSEQ + (lvalid ? l : 0) : (size_t)b * SEQ + c * 64 + l;
            bf16_t* qp = P + prow * SWA_N + kv * 256 + gq * 64;
            bf16x8 qa[2];
            {
                float qf[2][8]; float ss = 0.f;
#pragma unroll
                for (int kk = 0; kk < 2; ++kk) { const u32x4 w = *(const u32x4*)(qp + kk * 32 + g4 * 8);
#pragma unroll
                    for (int j = 0; j < 4; ++j) { qf[kk][2 * j] = bf_lo(w[j]); qf[kk][2 * j + 1] = bf_hi(w[j]); } }
#pragma unroll
                for (int kk = 0; kk < 2; ++kk)
#pragma unroll
                    for (int j = 0; j < 8; ++j) ss += qf[kk][j] * qf[kk][j];
                ss += __shfl_xor(ss, 16); ss += __shfl_xor(ss, 32);
                const float rs = rsqrtf(ss * (1.0f / 64) + 1e-6f) * 0.125f;
#pragma unroll
                for (int kk = 0; kk < 2; ++kk) { u32x4 w;
#pragma unroll
                    for (int j = 0; j < 4; ++j) { const int d = kk * 32 + g4 * 8 + 2 * j; w[j] = cvt_pk_bf16(qf[kk][2 * j] * rs * qn[d], qf[kk][2 * j + 1] * rs * qn[d + 1]); }
                    qa[kk] = __builtin_bit_cast(bf16x8, w); }
            }
            f32x4 sc[12]; float mx = sink;
#pragma unroll
            for (int st = 0; st < 12; ++st) { f32x4 acc = (f32x4){0.f, 0.f, 0.f, 0.f};
#pragma unroll
                for (int kk = 0; kk < 2; ++kk) acc = MFMA16(*(const bf16x8*)(KS + (st * 16 + r16) * KS_S + kk * 32 + g4 * 8), qa[kk], acc);
#pragma unroll
                for (int j = 0; j < 4; ++j) { const int s = st * 16 + g4 * 4 + j; const bool kvalid = smp ? (s < 128 + DSEQ) : ((c - 2) * 64 + s >= 0);
                    const float v = kvalid ? acc[j] - slope * fabsf((float)(128 + l - s)) : -1e30f; acc[j] = v; mx = fmaxf(mx, v); }
                sc[st] = acc; }
            mx = fmaxf(mx, __shfl_xor(mx, 16)); mx = fmaxf(mx, __shfl_xor(mx, 32));
            float sum = 0.f;
#pragma unroll
            for (int st = 0; st < 12; ++st)
#pragma unroll
                for (int j = 0; j < 4; ++j) { const float e = __expf(sc[st][j] - mx); sc[st][j] = e; sum += e; }
            sum += __shfl_xor(sum, 16); sum += __shfl_xor(sum, 32);
            const float inv = 1.0f / (sum + __expf(sink - mx));
#pragma unroll
            for (int st = 0; st < 12; ++st) { u32x2 w; w.x = cvt_pk_bf16(sc[st][0] * inv, sc[st][1] * inv); w.y = cvt_pk_bf16(sc[st][2] * inv, sc[st][3] * inv);
                *(u32x2*)(pw + r16 * PW_S + st * 16 + g4 * 4) = w; }
            __builtin_amdgcn_fence(__ATOMIC_RELEASE, "wavefront"); __builtin_amdgcn_wave_barrier(); __builtin_amdgcn_fence(__ATOMIC_ACQUIRE, "wavefront");
#pragma unroll
            for (int dt = 0; dt < 4; ++dt) { f32x4 acc = (f32x4){0.f, 0.f, 0.f, 0.f};
#pragma unroll
                for (int kk = 0; kk < 6; ++kk) acc = MFMA16(*(const bf16x8*)(VT + (dt * 16 + r16) * VT_S + kk * 32 + g4 * 8), *(const bf16x8*)(pw + r16 * PW_S + kk * 32 + g4 * 8), acc);
                if (lvalid && live) { u32x2 w; w.x = cvt_pk_bf16(acc[0], acc[1]); w.y = cvt_pk_bf16(acc[2], acc[3]); *(u32x2*)(qp + dt * 16 + g4 * 4) = w; } }
            __builtin_amdgcn_fence(__ATOMIC_RELEASE, "wavefront"); __builtin_amdgcn_wave_barrier(); __builtin_amdgcn_fence(__ATOMIC_ACQUIRE, "wavefront");
        }
    }
}

#define XB_TMO      128
#define XB_XCNT(j)  (256  + 64 * (j))
#define XB_XSUB(j)  (1280 + 64 * (j))
#define XB_XGEN(j)  (2304 + 64 * (j))
#define XB_TOP      3328
#define XB_TOPGEN   3392
#define XCD_BAR_WORDS 3456
#define XB_SPIN_CAP (1u << 22)
static_assert(XCD_BAR_WORDS * 4 <= WS_BAR_BYTES, "barrier words");
__device__ __forceinline__ unsigned xb_ld(unsigned* p)              { return __hip_atomic_load(p, __ATOMIC_RELAXED, __HIP_MEMORY_SCOPE_AGENT); }
__device__ __forceinline__ unsigned xb_add(unsigned* p, unsigned v) { return __hip_atomic_fetch_add(p, v, __ATOMIC_RELAXED, __HIP_MEMORY_SCOPE_AGENT); }
__device__ __forceinline__ unsigned xb_xcc_id() { return (unsigned)__builtin_amdgcn_s_getreg((3 << 11) | 20) & 0xFu; }
#define XB_SPIN(cond, bar) do { unsigned _sp = 0; while (cond) { __builtin_amdgcn_s_sleep(1); \
    if ((++_sp & 255u) == 0u) { if (xb_ld(&(bar)[XB_TMO])) break; if (_sp > XB_SPIN_CAP) { atomicAdd(&(bar)[XB_TMO], 1u); break; } } } } while (0)
struct XcdBarrier { unsigned* bar; unsigned x; volatile LAS unsigned* st; };
__device__ __forceinline__ XcdBarrier xcd_barrier_post(unsigned* bar, volatile LAS unsigned* st) {
    XcdBarrier b; b.bar = bar; b.x = xb_xcc_id(); b.st = st;
    if (threadIdx.x == 0) (void)xb_add(&bar[XB_XCNT(b.x)], 1u);
    return b;
}
__device__ __forceinline__ void xcd_barrier_complete(unsigned* bar, unsigned x, unsigned& nloc, unsigned& nx) {
    const unsigned G = gridDim.x * gridDim.y * gridDim.z;
    unsigned sum, cnt, mine, sp = 0u;
    for (;;) {
        sum = 0u; cnt = 0u; mine = 0u;
#pragma unroll
        for (unsigned j = 0; j < 16; ++j) { const unsigned c = xb_ld(&bar[XB_XCNT(j)]); sum += c; cnt += (c > 0u) ? 1u : 0u; mine = (j == x) ? c : mine; }
        if (sum == G) break;
        __builtin_amdgcn_s_sleep(1);
        if ((++sp & 255u) == 0u) { if (xb_ld(&bar[XB_TMO])) break; if (sp > XB_SPIN_CAP) { atomicAdd(&bar[XB_TMO], 1u); break; } }
    }
    nloc = mine > 0u ? mine : 1u; nx = cnt > 0u ? cnt : 1u;
}
__device__ __forceinline__ void xcd_barrier(const XcdBarrier& b) {
    asm volatile("s_waitcnt vmcnt(0)" ::: "memory");
    __syncthreads();
    if (opaque_tid() == 0) {
        unsigned* bar = b.bar; asm volatile("" : "+s"(bar));
        __builtin_amdgcn_s_waitcnt(0);
        const unsigned bx = xb_xcc_id();
        unsigned nloc = b.st[0], nx = b.st[1];
        if (nloc == 0u) { xcd_barrier_complete(bar, bx, nloc, nx); b.st[0] = nloc; b.st[1] = nx; }
        const unsigned old = xb_add(&bar[XB_XSUB(bx)], 1u);
        const unsigned gen = old / nloc;
        if (old + 1u == (gen + 1u) * nloc) {
            __builtin_amdgcn_fence(__ATOMIC_RELEASE, "agent");
            asm volatile("s_waitcnt vmcnt(0)" ::: "memory");
            const unsigned og = xb_add(&bar[XB_TOP], 1u);
            const unsigned tg = og / nx;
            if (og + 1u == (tg + 1u) * nx) xb_add(&bar[XB_TOPGEN], 1u);
            else XB_SPIN(xb_ld(&bar[XB_TOPGEN]) == tg, bar);
            __builtin_amdgcn_fence(__ATOMIC_ACQUIRE, "agent");
            xb_add(&bar[XB_XGEN(bx)], 1u);
            asm volatile("s_waitcnt vmcnt(0)" ::: "memory");
        } else {
            XB_SPIN(xb_ld(&bar[XB_XGEN(bx)]) == gen, bar);
            __builtin_amdgcn_fence(__ATOMIC_ACQUIRE, "agent");
            asm volatile("s_waitcnt vmcnt(0)" ::: "memory");
        }
    }
    __syncthreads();
}
__device__ __forceinline__ void gsync_cg(cg::grid_group& g) {
    __builtin_amdgcn_fence(__ATOMIC_RELEASE, "agent");
    asm volatile("s_waitcnt vmcnt(0) lgkmcnt(0)" ::: "memory");
    g.sync();
    __builtin_amdgcn_fence(__ATOMIC_ACQUIRE, "agent");
    asm volatile("s_waitcnt vmcnt(0)" ::: "memory");
}
#define gsync(g) xcd_barrier(xbar)
__global__ void __launch_bounds__(NTHREADS, 2) fwd_megakernel(Params p) {
    extern __shared__ __attribute__((aligned(16))) unsigned char shm[];
    cg::grid_group grid = cg::this_grid();
    LAS unsigned char* shl = (LAS unsigned char*)shm;
    pg8::StaticOrder S;
    volatile LAS unsigned* xst = (volatile LAS unsigned*)(shl + LDS_BYTES - 16);
    if (threadIdx.x == 0) { xst[0] = 0u; xst[1] = 0u; }
    __syncthreads();
    const XcdBarrier xbar = xcd_barrier_post((unsigned*)(p.ws + WS_BAR), xst);

    grid.sync();
    prep_phase(shm, p);
    gsync(grid);
    prepb_phase(p);
    gsync(grid);
#pragma unroll 1
    for (int layer = 0; layer < 4; ++layer) {
        int z = 0; asm volatile("" : "+s"(z));
        unsigned char* ws = p.ws + z; float* yo = p.out + z;
        bf16_t* H = (bf16_t*)(ws + WS_H); bf16_t* P = (bf16_t*)(ws + WS_P);
        const float* mod = (const float*)(ws + WS_MOD);
        float* RS = (float*)(ws + WS_RSS);
        LAS float* RSL = (LAS float*)(shl + 128 * 1024);
        const float* avec = (const float*)(ws + WS_AVEC); const float* cvec = (const float*)(ws + WS_CVEC);
        const int kind = layer % 3, j = layer / 3;
        const float* mod_l = mod + (size_t)layer * 32 * ADA;
        const float* yin_p = layer == 0 ? p.in[0 + z] : yo; const float* yin_s = layer == 0 ? p.in[1 + z] : yo + O_YS;
        const float* cv_mix = cvec + (size_t)32 * stage_cvoff(2 * layer); const float* cv_mlp = cvec + (size_t)32 * stage_cvoff(2 * layer + 1);
        const bf16_t* WoT; int Ko, lda_o; const bf16_t* Ao;
        if (kind == 0) {
            { pg8::Gemm g{H, (const bf16_t*)(ws + WS_GIN) + (size_t)j * GLA_N * D, MP, GLA_N, D, D}; S.init(MP, GLA_N, opaque_nwg(), opaque_bid());
              pg8::EpiBf16 E{P, GLA_N, 0, 3072, p.in[20 + z] + j * 512, RS, cv_mix, RSL}; pg8::rs_stage(S, RS, 0, RSL); pg8::gemm_phase(shl, g, S, E); pg8::gemm_sample(shm, g, E); }
            gsync(grid);
            recur_phase<GLA_DK, GLA_DV, true>(shm, P, GLA_N, 0, 512, 1024, 3072, layer == 0 ? p.in[2 + z] : p.in[6 + z], yo + (layer == 0 ? O_G0P : O_G3P), yo + (layer == 0 ? O_G0S : O_G3S));
            gsync(grid);
            post_phase<GLA_DV, true>(P, GLA_N, 1024, 2048, p.in[22 + z] + j * GLA_DV);
            WoT = (const bf16_t*)(ws + WS_GO) + (size_t)j * D * D; Ko = D; lda_o = GLA_N; Ao = P + 2048;
        } else if (kind == 1) {
            { pg8::Gemm g{H, (const bf16_t*)(ws + WS_RIN), MP, RET_N, D, D}; S.init(MP, RET_N, opaque_nwg(), opaque_bid());
              pg8::EpiBf16 E{P, RET_N, 0, 1 << 30, nullptr, RS, cv_mix, RSL}; pg8::rs_stage(S, RS, 0, RSL); pg8::gemm_phase(shl, g, S, E); pg8::gemm_sample(shm, g, E); }
            gsync(grid);
            recur_phase<RET_DK, RET_DV, false>(shm, P, RET_N, 0, 1024, 2048, 0, p.in[3 + z], yo + O_RP, yo + O_RS);
            gsync(grid);
            post_phase<RET_DV, false>(P, RET_N, 2048, 4096, nullptr);
            WoT = (const bf16_t*)(ws + WS_RO); Ko = 2048; lda_o = RET_N; Ao = P + 4096;
        } else {
            { pg8::Gemm g{H, (const bf16_t*)(ws + WS_SIN), MP, SWA_N, D, D}; S.init(MP, SWA_N, opaque_nwg(), opaque_bid());
              pg8::EpiBf16 E{P, SWA_N, 0, 1 << 30, nullptr, RS, cv_mix, RSL}; pg8::rs_stage(S, RS, 0, RSL); pg8::gemm_phase(shl, g, S, E); pg8::gemm_sample(shm, g, E); }
            gsync(grid);
            swa_phase(shm, p, P, z);
            WoT = (const bf16_t*)(ws + WS_SO); Ko = D; lda_o = SWA_N; Ao = P;
        }
        gsync(grid);
        { pg8::Gemm g{Ao, WoT, MP, D, Ko, lda_o}; S.init(MP, D, opaque_nwg(), opaque_bid());
          pg8::EpiRes E{yin_p, yin_s, yo, mod_l + 2 * D, H, avec + (size_t)(2 * layer + 1) * 32 * D, RS}; pg8::gemm_phase<pg8::EpiRes, false, true>(shl, g, S, E); pg8::gemm_sample(shm, g, E); }
        gsync(grid);
        { pg8::Gemm g{H, (const bf16_t*)(ws + WS_W1T) + (size_t)layer * HID * D, MP, HID, D, D}; S.init(MP, HID, opaque_nwg(), opaque_bid());
          pg8::EpiBf16 E{P, HID, 1, 1 << 30, nullptr, RS, cv_mlp, RSL}; pg8::rs_stage(S, RS, 0, RSL); pg8::gemm_phase(shl, g, S, E); pg8::gemm_sample(shm, g, E); }
        gsync(grid);
        { pg8::Gemm g{P, (const bf16_t*)(ws + WS_W2T) + (size_t)layer * HID * D, MP, D, HID, HID}; S.init(MP, D, opaque_nwg(), opaque_bid());
          pg8::EpiRes E{yo, yo + O_YS, yo, mod_l + 5 * D, layer < 3 ? H : nullptr, avec + (size_t)(layer < 3 ? 2 * layer + 2 : 0) * 32 * D, RS}; pg8::gemm_phase<pg8::EpiRes, false, true>(shl, g, S, E); pg8::gemm_sample(shm, g, E); }
        gsync(grid);
    }
}

extern "C" void kernel_launch(void* const* d_in, const int* in_sizes, int n_in, void* d_out, int out_size, void* d_ws, size_t ws_size, hipStream_t stream) {
    static int grid_blocks = 0;
    if (grid_blocks == 0) {
        if (n_in != 34 || (size_t)out_size != O_END || ws_size < WS_END) { fprintf(stderr, "kernel_launch: unexpected sizes n_in %d out %d ws %zu (need %zu)\n", n_in, out_size, ws_size, (size_t)WS_END); grid_blocks = -1; return; }
        int dev = 0, cus = 0, per_cu = 0;
        hipGetDevice(&dev);
        hipDeviceGetAttribute(&cus, hipDeviceAttributeMultiprocessorCount, dev);
        if (hipFuncSetAttribute((const void*)fwd_megakernel, hipFuncAttributeMaxDynamicSharedMemorySize, LDS_BYTES) != hipSuccess) { fprintf(stderr, "kernel_launch: hipFuncSetAttribute failed\n"); grid_blocks = -1; return; }
        hipOccupancyMaxActiveBlocksPerMultiprocessor(&per_cu, (const void*)fwd_megakernel, NTHREADS, LDS_BYTES);
        if (per_cu < 1) { fprintf(stderr, "kernel_launch: occupancy query says %d blocks per CU\n", per_cu); grid_blocks = -1; return; }
        grid_blocks = cus * per_cu;
    }
    if (grid_blocks < 0) return;
    Params p{};
    for (int i = 0; i < 34; ++i) p.in[i] = (const float*)d_in[i];
    p.out = (float*)d_out; p.ws = (unsigned char*)d_ws;
    unsigned char* ws = (unsigned char*)d_ws;
    int nj = 0, tiles = 0;
    auto add = [&](const float* src, bf16_t* dst, int K, int N, float scale) { TJob& j = p.jobs[nj++]; j.src = src; j.dst = dst; j.K = K; j.N = N; j.tile0 = tiles; j.scale = scale; tiles += (K / 64) * (N / 128); };
    for (int l = 0; l < 4; ++l) {
        add(p.in[13] + (size_t)l * D * HID, (bf16_t*)(ws + WS_W1T) + (size_t)l * HID * D, D, HID, 1.0f);
        add(p.in[14] + (size_t)l * HID * D, (bf16_t*)(ws + WS_W2T) + (size_t)l * HID * D, HID, D, 1.0f);
    }
    for (int j = 0; j < 2; ++j) {
        bf16_t* gin = (bf16_t*)(ws + WS_GIN) + (size_t)j * GLA_N * D;
        add(p.in[15] + (size_t)j * D * 512, gin, D, 512, 0.08838834764831845f);
        add(p.in[16] + (size_t)j * D * 512, gin + (size_t)512 * D, D, 512, 1.0f);
        add(p.in[17] + (size_t)j * D * D, gin + (size_t)1024 * D, D, D, 1.0f);
        add(p.in[21] + (size_t)j * D * D, gin + (size_t)2048 * D, D, D, 1.0f);
        add(p.in[23] + (size_t)j * D * D, (bf16_t*)(ws + WS_GO) + (size_t)j * D * D, D, D, 1.0f);
    }
    {
        bf16_t* rin = (bf16_t*)(ws + WS_RIN);
        add(p.in[24], rin, D, D, 1.0f);
        add(p.in[25], rin + (size_t)1024 * D, D, D, 0.0625f);
        add(p.in[26], rin + (size_t)2048 * D, D, 2048, 1.0f);
        add(p.in[27], rin + (size_t)4096 * D, D, 2048, 1.0f);
        add(p.in[28], (bf16_t*)(ws + WS_RO), 2048, D, 1.0f);
    }
    add(p.in[29], (bf16_t*)(ws + WS_SIN), D, SWA_N, 1.0f);
    add(p.in[33], (bf16_t*)(ws + WS_SO), D, D, 1.0f);
    p.ntiles = tiles;
    if (hipMemsetAsync(ws + WS_BAR, 0, WS_BAR_BYTES, stream) != hipSuccess) { fprintf(stderr, "kernel_launch: memset of barrier words failed\n"); return; }
    void* args[] = {&p};
    hipError_t e = hipLaunchCooperativeKernel((const void*)fwd_megakernel, dim3(grid_blocks), dim3(NTHREADS), args, LDS_BYTES, stream);
    if (e != hipSuccess) fprintf(stderr, "kernel_launch: cooperative launch failed: %s (grid %d)\n", hipGetErrorString(e), grid_blocks);
}
```
